# Optimizing an MI355X kernel written in HIP

```python
import math
import jax, jax.numpy as jnp
from jax import lax
import numpy as np

D_MODEL = 1024
BATCH = 8
SEQ = 4096
DEPTH = 1

CHUNK = 64
Q_BLOCK = 128
SPARSE_Q_BLOCK = 64
D_MIX = D_MODEL

A_HEADS = 4
A_QK_DIM = 64
A_V_DIM = 2 * A_QK_DIM
A_WIDTH = A_HEADS * A_V_DIM
A_QK_WIDTH = A_HEADS * 2 * A_QK_DIM

B_HEADS = 8
B_HEAD_DIM = 64
B_WIDTH = B_HEADS * B_HEAD_DIM
IDX_HEADS = 4
IDX_DIM = 64
TOPK_MAX = 256

N_BUCKETS = 32
MAX_DISTANCE = 128
N_BIAS_HEADS = A_HEADS + B_HEADS

EPS = 1e-6

SPLIT_SIZES = (A_QK_WIDTH, A_QK_WIDTH, A_WIDTH, A_WIDTH,
               B_WIDTH, B_WIDTH, B_WIDTH, B_WIDTH,
               IDX_HEADS * IDX_DIM, IDX_DIM, IDX_HEADS)
D_IN_PROJ = sum(SPLIT_SIZES)

kernel_name = "hybrid_diffattn_dsa_streaming_block"


def rmsnorm(x, w):
    xf = x.astype(jnp.float32)
    y = xf * lax.rsqrt(jnp.mean(xf * xf, axis=-1, keepdims=True) + EPS)
    return (y * w.astype(jnp.float32)).astype(x.dtype)


def t5_bucket(rel):
    nb = N_BUCKETS // 2
    ret = jnp.where(rel > 0, nb, 0)
    n = jnp.abs(rel)
    max_exact = nb // 2
    nf = jnp.maximum(n, 1).astype(jnp.float32)
    large = max_exact + (jnp.log(nf / max_exact) / math.log(MAX_DISTANCE / max_exact)
                         * (nb - max_exact)).astype(jnp.int32)
    large = jnp.minimum(large, nb - 1)
    return ret + jnp.where(n < max_exact, n, large)


def diff_attention(q1, q2, k1, k2, v, lam, bias_table):
    B, S, H, dv = v.shape
    pos = jnp.arange(S, dtype=jnp.int32)
    scale = A_QK_DIM ** -0.5

    def block(i):
        start = i * Q_BLOCK
        qb1 = lax.dynamic_slice_in_dim(q1, start, Q_BLOCK, axis=1)
        qb2 = lax.dynamic_slice_in_dim(q2, start, Q_BLOCK, axis=1)
        qpos = start + jnp.arange(Q_BLOCK, dtype=jnp.int32)
        rel = pos[None, :] - qpos[:, None]
        bias = jnp.transpose(bias_table[t5_bucket(rel)], (2, 0, 1)).astype(jnp.float32)
        allowed = (pos[None, :] // CHUNK) <= (qpos[:, None] // CHUNK)

        def probs(qb, k):
            s = jnp.einsum('bqhd,bkhd->bhqk', qb, k).astype(jnp.float32) * scale + bias
            s = jnp.where(allowed, s, -jnp.inf)
            return jax.nn.softmax(s, axis=-1)

        p = probs(qb1, k1) - lam * probs(qb2, k2)
        return jnp.einsum('bhqk,bkhd->bqhd', p.astype(v.dtype), v)

    out = lax.map(block, jnp.arange(S // Q_BLOCK))
    return jnp.transpose(out, (1, 0, 2, 3, 4)).reshape(B, S, H, dv)


def dsa_attention(q, k, v, iq, ik, iw, bias_table, k_sel):
    B, S, H, D = v.shape
    pos = jnp.arange(S, dtype=jnp.int32)
    scale = D ** -0.5
    idx_scale = (IDX_HEADS ** -0.5) * (IDX_DIM ** -0.5)
    gather = jax.vmap(lambda kk, ss: kk[ss])

    def block(i):
        start = i * SPARSE_Q_BLOCK
        qb = lax.dynamic_slice_in_dim(q, start, SPARSE_Q_BLOCK, axis=1)
        iqb = lax.dynamic_slice_in_dim(iq, start, SPARSE_Q_BLOCK, axis=1)
        iwb = lax.dynamic_slice_in_dim(iw, start, SPARSE_Q_BLOCK, axis=1)
        qpos = start + jnp.arange(SPARSE_Q_BLOCK, dtype=jnp.int32)
        allowed = (pos[None, :] // CHUNK) <= (qpos[:, None] // CHUNK)
        idx_logits = jnp.einsum('bqhd,bkd->bqhk', iqb, ik).astype(jnp.float32)
        score = jnp.einsum('bqh,bqhk->bqk', iwb.astype(jnp.float32) * idx_scale,
                           jax.nn.relu(idx_logits))
        score = jnp.where(allowed[None], score, -jnp.inf)
        _, sel = lax.top_k(score, k_sel)
        valid = (sel // CHUNK) <= (qpos[None, :, None] // CHUNK)
        kg = gather(k, sel)
        vg = gather(v, sel)
        s = jnp.einsum('bqhd,bqkhd->bhqk', qb, kg).astype(jnp.float32) * scale
        rel = sel - qpos[None, :, None]
        bias = jnp.transpose(bias_table[t5_bucket(rel)], (0, 3, 1, 2)).astype(jnp.float32)
        s = jnp.where(valid[:, None], s + bias, -jnp.inf)
        p = jax.nn.softmax(s, axis=-1)
        return jnp.einsum('bhqk,bqkhd->bqhd', p.astype(v.dtype), vg)

    out = lax.map(block, jnp.arange(S // SPARSE_Q_BLOCK))
    return jnp.transpose(out, (1, 0, 2, 3, 4)).reshape(B, S, H, D)


def hybrid_layer(x, norm_w, w_in, w_out, lq1, lk1, lq2, lk2, subln_w, rel_bias, layer_idx):
    B, S, _ = x.shape
    h = rmsnorm(x, norm_w)
    proj = jnp.einsum('bsd,de->bse', h, w_in)
    split_at = np.cumsum(SPLIT_SIZES)[:-1].tolist()
    aq, ak, av, ag, bq, bk, bv, bg, iq, ik, iw = jnp.split(proj, split_at, axis=-1)

    aq = aq.reshape(B, S, A_HEADS, 2, A_QK_DIM)
    ak = ak.reshape(B, S, A_HEADS, 2, A_QK_DIM)
    av = av.reshape(B, S, A_HEADS, A_V_DIM)
    lambda_init = 0.8 - 0.6 * math.exp(-0.3 * layer_idx)
    lam = (jnp.exp(jnp.sum(lq1.astype(jnp.float32) * lk1.astype(jnp.float32)))
           - jnp.exp(jnp.sum(lq2.astype(jnp.float32) * lk2.astype(jnp.float32)))
           + lambda_init)
    ao = diff_attention(aq[..., 0, :], aq[..., 1, :], ak[..., 0, :], ak[..., 1, :], av,
                        lam, rel_bias[:, :A_HEADS])
    ao = rmsnorm(ao, subln_w) * (1.0 - lambda_init)
    ao = ao.reshape(B, S, A_WIDTH) * jax.nn.silu(ag)

    k_sel = min(TOPK_MAX, S // 4)
    bo = dsa_attention(bq.reshape(B, S, B_HEADS, B_HEAD_DIM),
                       bk.reshape(B, S, B_HEADS, B_HEAD_DIM),
                       bv.reshape(B, S, B_HEADS, B_HEAD_DIM),
                       iq.reshape(B, S, IDX_HEADS, IDX_DIM), ik, iw,
                       rel_bias[:, A_HEADS:], k_sel)
    bo = bo.reshape(B, S, B_WIDTH) * jax.nn.silu(bg)

    y = jnp.einsum('bse,ed->bsd', jnp.concatenate([ao, bo], axis=-1), w_out)
    return x + y


def setup_inputs(seed: int = 0) -> dict:
    key = jax.random.key(seed)
    ks = jax.random.split(key, 12)
    f32 = jnp.float32
    x = jax.random.normal(ks[0], (BATCH, SEQ, D_MODEL), f32)
    norm_w = 1.0 + 0.01 * jax.random.normal(ks[1], (DEPTH, D_MODEL), f32)
    w_in = jax.random.normal(ks[2], (DEPTH, D_MODEL, D_IN_PROJ), f32) * D_MODEL ** -0.5
    w_out = jax.random.normal(ks[3], (DEPTH, D_MIX, D_MODEL), f32) * D_MIX ** -0.5
    lambda_q1 = 0.1 * jax.random.normal(ks[4], (DEPTH, A_QK_DIM), f32)
    lambda_k1 = 0.1 * jax.random.normal(ks[5], (DEPTH, A_QK_DIM), f32)
    lambda_q2 = 0.1 * jax.random.normal(ks[6], (DEPTH, A_QK_DIM), f32)
    lambda_k2 = 0.1 * jax.random.normal(ks[7], (DEPTH, A_QK_DIM), f32)
    subln_w = 1.0 + 0.01 * jax.random.normal(ks[8], (DEPTH, A_V_DIM), f32)
    rel_bias = 0.5 * jax.random.normal(ks[9], (N_BUCKETS, N_BIAS_HEADS), f32)
    final_norm_w = 1.0 + 0.01 * jax.random.normal(ks[10], (D_MODEL,), f32)
    return {"x": x, "norm_w": norm_w, "w_in": w_in, "w_out": w_out,
            "lambda_q1": lambda_q1, "lambda_k1": lambda_k1,
            "lambda_q2": lambda_q2, "lambda_k2": lambda_k2,
            "subln_w": subln_w, "rel_bias": rel_bias, "final_norm_w": final_norm_w}


def reference(x, norm_w, w_in, w_out, lambda_q1, lambda_k1, lambda_q2, lambda_k2,
              subln_w, rel_bias, final_norm_w):
    for l in range(DEPTH):
        x = hybrid_layer(x, norm_w[l], w_in[l], w_out[l], lambda_q1[l], lambda_k1[l],
                         lambda_q2[l], lambda_k2[l], subln_w[l], rel_bias, l)
    return rmsnorm(x, final_norm_w)
```

```cpp
#include <hip/hip_runtime.h>
#include <cstdio>
#include <cstdint>
#include <cmath>
#define LAS __attribute__((address_space(3)))
typedef unsigned short bf16_t;
typedef unsigned u32x4_t __attribute__((ext_vector_type(4)));
typedef unsigned u32x2_t __attribute__((ext_vector_type(2)));
typedef float f32x4_t __attribute__((ext_vector_type(4)));

constexpr int DM = 1024, NBATCH = 8, SEQ = 4096, MT = NBATCH * SEQ;
constexpr int D_IN = 4420, NPAD = 4608, NPLANES = 18;
constexpr float EPS = 1e-6f, LOG2E = 1.4426950408889634f;
constexpr float C2 = 0.125f * LOG2E;
constexpr float IDX_SCALE = 0.0625f;
constexpr float LAMBDA_INIT = 0.2f, ONE_M_LAMBDA = 0.8f;
constexpr size_t PLANE = (size_t)MT * 256;
constexpr int PL_AQ = 0, PL_AK = 2, PL_AV = 4, PL_AG = 6, PL_BQ = 8, PL_BK = 10, PL_BV = 12, PL_BG = 14, PL_IQ = 16, PL_IK = 17;

constexpr size_t WS_CTL = 0;
constexpr size_t WS_WINT = 65536;
constexpr size_t WS_WOUTT = WS_WINT + (size_t)NPAD * DM * 2;
constexpr size_t WS_H = WS_WOUTT + (size_t)DM * DM * 2;
constexpr size_t WS_P = WS_H + (size_t)MT * DM * 2;
constexpr size_t WS_IW = WS_P + (size_t)NPLANES * PLANE * 2;
constexpr size_t WS_THR = WS_IW + (size_t)MT * 16;
constexpr size_t WS_KCUT = WS_THR + (size_t)MT * 4;
constexpr size_t WS_SELCNT = WS_KCUT + (size_t)MT * 4;
constexpr size_t WS_AOBO = WS_SELCNT + (size_t)MT * 4;
constexpr size_t WS_SEL = WS_AOBO + (size_t)MT * DM * 2;
constexpr size_t WS_END = WS_SEL + (size_t)MT * 256 * 4;

__device__ __forceinline__ float bf2f(bf16_t v) { return __uint_as_float(((unsigned)v) << 16); }
__device__ __forceinline__ float bflo(unsigned w) { return __uint_as_float(w << 16); }
__device__ __forceinline__ float bfhi(unsigned w) { return __uint_as_float(w & 0xffff0000u); }
__device__ __forceinline__ unsigned pk2(float lo, float hi) {
    typedef float f2 __attribute__((ext_vector_type(2))); typedef __bf16 b2 __attribute__((ext_vector_type(2)));
    f2 v = {lo, hi}; b2 b = __builtin_convertvector(v, b2); return __builtin_bit_cast(unsigned, b); }
__device__ __forceinline__ float wave_sum(float v) {
#pragma unroll
    for (int o = 1; o < 64; o <<= 1) v += __shfl_xor(v, o);
    return v; }
__device__ __forceinline__ int wave_sum_i(int v) {
#pragma unroll
    for (int o = 1; o < 64; o <<= 1) v += __shfl_xor(v, o);
    return v; }
__device__ __forceinline__ float wave_max(float v) {
#pragma unroll
    for (int o = 1; o < 64; o <<= 1) v = fmaxf(v, __shfl_xor(v, o));
    return v; }
__device__ __forceinline__ int t5_bucket(int rel) {
    const int ret = rel > 0 ? 16 : 0; const int n = rel < 0 ? -rel : rel;
    if (n < 8) return ret + n;
    int large = 2 + (31 - __builtin_clz((unsigned)(n * n))); large = large > 15 ? 15 : large;
    return ret + large; }
__device__ __forceinline__ unsigned f2key(float f) { const unsigned u = __float_as_uint(f); return (u & 0x80000000u) ? ~u : (u | 0x80000000u); }
__device__ __forceinline__ float key2f(unsigned k) { return __uint_as_float((k & 0x80000000u) ? (k ^ 0x80000000u) : ~k); }
__device__ __forceinline__ float silu_f(float v) { return v * __builtin_amdgcn_rcpf(1.0f + __builtin_amdgcn_exp2f(-v * LOG2E)); }
namespace pg8 {
#define PG8_LAS __attribute__((address_space(3)))
typedef unsigned short bf16_t;
typedef short bf16x8 __attribute__((ext_vector_type(8)));
typedef float f32x4 __attribute__((ext_vector_type(4)));
typedef unsigned u32x4 __attribute__((ext_vector_type(4)));
constexpr int BM = 256, BK = 64, HALF = 128, HTB = HALF * BK * 2  , STAGE_BYTES = 8 * HTB, NXCD = 8, WGM = 8;

__host__ __device__ __forceinline__ int lds_byte(int r, int c) { const int st = (r >> 4) * 2 + (c >> 5), rr = r & 15, cc = c & 31, ob = rr * 64 + cc * 2; return st * 1024 + (ob ^ (((ob >> 9) & 1) << 5)); }
__host__ __device__ __forceinline__ void stage_rc(int b, int& R, int& C) { const int st = b / 1024, sb = b % 1024, swz = sb ^ (((sb >> 9) & 1) << 5); R = (st >> 1) * 16 + swz / 64; C = (st & 1) * 32 + (swz % 64) / 2; }
__host__ __device__ __forceinline__ int perm32(int rho) { const int n = rho >> 4, i = rho & 15; return 8 * (i >> 2) + 4 * n + (i & 3); }

struct Unit { int pm, pn; };
struct Gemm { const bf16_t* A; const bf16_t* Bt; int M, N, K; };

struct StaticOrder {
    int nM, nN, nwg, G, c;
    __host__ __device__ void init(int M, int N, int G_, int c_) { nM = M / BM; nN = N / BM; nwg = nM * nN; G = G_; c = c_; }
    __host__ __device__ bool next(int i, Unit& u) const {
        const long L = (long)i * G + c; if (L >= nwg) return false;
        int wgid = (int)L; { const int q = nwg / NXCD, r = nwg % NXCD, xcd = wgid % NXCD, off = wgid / NXCD; wgid = (xcd < r ? xcd * (q + 1) : r * (q + 1) + (xcd - r) * q) + off; }
        const int nig = WGM * nN, gid = wgid / nig, fm = gid * WGM, gsz = (nM - fm) < WGM ? (nM - fm) : WGM;
        u.pm = fm + ((wgid % nig) % gsz); u.pn = (wgid % nig) / gsz; return true;
    }
    __device__ __forceinline__ void a_ready(const Unit&) const {}
    __device__ __forceinline__ void done(const Unit&) const {}
};

__device__ __forceinline__ unsigned cvt_pk_bf16(float lo, float hi) { unsigned r; asm volatile("v_cvt_pk_bf16_f32 %0, %1, %2" : "=v"(r) : "v"(lo), "v"(hi)); return r; }
template <class Epi, class Sched, bool ALIGN_EPI = false, bool SP2 = false>
__device__ __forceinline__ void gemm_phase(PG8_LAS unsigned char* lds, const Gemm g, const Sched& S, const Epi& E) {
    const int tid = threadIdx.x, wid = __builtin_amdgcn_readfirstlane(tid >> 6), lane = tid & 63, wr = wid >> 2, wc = wid & 3, fr = lane & 15, fq = lane >> 4;
    const int K = g.K, nt = K / BK;
    unsigned voffA[2], voffB[2];
#pragma unroll
    for (int i = 0; i < 2; ++i) { int R, C; stage_rc(tid * 16 + i * 8192, R, C); const int Rb = Epi::PERM ? ((R & ~31) + perm32(R & 31)) : R;
        voffA[i] = (unsigned)(R * K + C) * 2u; voffB[i] = (unsigned)(Rb * K + C) * 2u; }
    const size_t kstep = (size_t)(BK * 2);
    const size_t hstep = (size_t)HALF * K * 2;
    const size_t tstep = 2 * hstep;
    const unsigned ldsw = (unsigned)wid * 1024u;
    const int aoff = lds_byte(wr * 64 + fr, fq * 8), boff = lds_byte(wc * 32 + fr, fq * 8);
#define PG8_SA(b, h) (((b) * 2 + (h)) * HTB)
#define PG8_SB(b, h) ((4 + (b) * 2 + (h)) * HTB)
#define PG8_STAGE(bufoff, gbase, voff) do { _Pragma("unroll") for (int _i = 0; _i < 2; ++_i) \
        __builtin_amdgcn_global_load_lds((const unsigned*)((const char*)(gbase) + (voff)[_i]), (PG8_LAS unsigned*)(lds + (bufoff) + ldsw + _i * 8192), 16, 0, 0); } while (0)
#define PG8_LDA(dst, b, h) do { _Pragma("unroll") for (int m = 0; m < 4; ++m) _Pragma("unroll") for (int k = 0; k < 2; ++k) dst[m][k] = *(const PG8_LAS bf16x8*)(lds + PG8_SA(b, h) + aoff + m * 2048 + k * 1024); } while (0)
#define PG8_LDB(dst, b, h) do { _Pragma("unroll") for (int n = 0; n < 2; ++n) _Pragma("unroll") for (int k = 0; k < 2; ++k) dst[n][k] = *(const PG8_LAS bf16x8*)(lds + PG8_SB(b, h) + boff + n * 2048 + k * 1024); } while (0)
#define PG8_MMA(ai, bj, At, Bt) do { __builtin_amdgcn_s_setprio(1); _Pragma("unroll") for (int m = 0; m < 4; ++m) _Pragma("unroll") for (int n = 0; n < 2; ++n) _Pragma("unroll") for (int k = 0; k < 2; ++k) \
        acc[ai][bj][m][n] = __builtin_amdgcn_mfma_f32_16x16x32_bf16(Bt[n][k], At[m][k], acc[ai][bj][m][n], 0, 0, 0); __builtin_amdgcn_s_setprio(0); } while (0)
#define PG8_WAIT_V(n) asm volatile("s_waitcnt vmcnt(" #n ")" ::: "memory")
#define PG8_WAIT_L(n) asm volatile("s_waitcnt lgkmcnt(" #n ")" ::: "memory")
#define PG8_BAR __builtin_amdgcn_s_barrier()
#define PG8_SCHED __builtin_amdgcn_sched_barrier(0)
    Unit cur, nxt; int ui = 0;
    if (!S.next(0, cur)) return;
    f32x4 acc[2][2][4][2];
#pragma unroll
    for (int a = 0; a < 2; ++a)
#pragma unroll
        for (int b = 0; b < 2; ++b)
#pragma unroll
            for (int m = 0; m < 4; ++m)
#pragma unroll
                for (int n = 0; n < 2; ++n) acc[a][b][m][n] = (f32x4){0.f, 0.f, 0.f, 0.f};
    bf16x8 At[4][2], B0[2][2], B1[2][2];
    const char* cA = (const char*)g.A + (size_t)cur.pm * tstep; const char* cB = (const char*)g.Bt + (size_t)cur.pn * tstep;
    S.a_ready(cur);
    if constexpr (SP2) {
        PG8_STAGE(PG8_SB(0, 0), cB, voffB); PG8_STAGE(PG8_SB(0, 1), cB + hstep, voffB); PG8_STAGE(PG8_SA(0, 0), cA, voffA); PG8_STAGE(PG8_SA(0, 1), cA + hstep, voffA);
        if (wr == 1) PG8_BAR;
        PG8_WAIT_V(2); PG8_BAR;
        PG8_STAGE(PG8_SB(1, 0), cB + kstep, voffB); PG8_STAGE(PG8_SA(1, 0), cA + kstep, voffA); PG8_STAGE(PG8_SB(1, 1), cB + hstep + kstep, voffB);
        PG8_WAIT_V(6); PG8_BAR;
    } else {
        PG8_STAGE(PG8_SB(0, 0), cB, voffB); PG8_STAGE(PG8_SA(0, 0), cA, voffA); PG8_STAGE(PG8_SB(0, 1), cB + hstep, voffB); PG8_STAGE(PG8_SA(0, 1), cA + hstep, voffA);
        if (wr == 1) PG8_BAR;
        PG8_WAIT_V(4); PG8_BAR;
        PG8_STAGE(PG8_SB(1, 0), cB + kstep, voffB); PG8_STAGE(PG8_SA(1, 0), cA + kstep, voffA); PG8_STAGE(PG8_SB(1, 1), cB + hstep + kstep, voffB);
        PG8_WAIT_V(6); PG8_BAR;
    }
    for (;;) {
        const bool has_next = S.next(ui + 1, nxt);
        const char* nA = has_next ? (const char*)g.A + (size_t)nxt.pm * tstep : cA; const char* nB = has_next ? (const char*)g.Bt + (size_t)nxt.pn * tstep : cB;
        for (int t = 0; t < nt; t += 2) {
            const bool last = (t == nt - 2);
            const char* a1 = cA + (size_t)(t + 1) * kstep;
            const char* a2 = last ? nA : cA + (size_t)(t + 2) * kstep; const char* b2 = last ? nB : cB + (size_t)(t + 2) * kstep;
            const char* a3 = a2 + kstep; const char* b3 = b2 + kstep;
            if (last && has_next) S.a_ready(nxt);
            if constexpr (SP2) {
            PG8_LDB(B0, 0, 0); PG8_LDB(B1, 0, 1); PG8_SCHED; PG8_LDA(At, 0, 0); PG8_STAGE(PG8_SA(1, 1), a1 + hstep, voffA);
            PG8_WAIT_V(8); PG8_WAIT_L(0); PG8_BAR; PG8_MMA(0, 0, At, B0); PG8_MMA(0, 1, At, B1); PG8_BAR; PG8_SCHED;
            PG8_LDA(At, 0, 1); PG8_STAGE(PG8_SB(0, 0), b2, voffB); PG8_STAGE(PG8_SB(0, 1), b2 + hstep, voffB); PG8_STAGE(PG8_SA(0, 0), a2, voffA);
            PG8_WAIT_V(8); PG8_WAIT_L(0); PG8_BAR; PG8_MMA(1, 0, At, B0); PG8_MMA(1, 1, At, B1); PG8_BAR; PG8_SCHED;
            PG8_LDB(B0, 1, 0); PG8_LDB(B1, 1, 1); PG8_SCHED; PG8_LDA(At, 1, 0); PG8_STAGE(PG8_SA(0, 1), a2 + hstep, voffA);
            PG8_WAIT_V(8); PG8_WAIT_L(0); PG8_BAR; PG8_MMA(0, 0, At, B0); PG8_MMA(0, 1, At, B1); PG8_BAR; PG8_SCHED;
            PG8_LDA(At, 1, 1); PG8_STAGE(PG8_SB(1, 0), b3, voffB); PG8_STAGE(PG8_SB(1, 1), b3 + hstep, voffB); PG8_STAGE(PG8_SA(1, 0), a3, voffA);
            PG8_WAIT_V(8); PG8_WAIT_L(0); PG8_BAR; PG8_MMA(1, 0, At, B0); PG8_MMA(1, 1, At, B1); PG8_BAR; PG8_SCHED;
            } else {
            PG8_LDB(B0, 0, 0); PG8_SCHED; PG8_LDA(At, 0, 0); PG8_STAGE(PG8_SA(1, 1), a1 + hstep, voffA);
            PG8_WAIT_L(8); PG8_BAR; PG8_WAIT_L(0); PG8_MMA(0, 0, At, B0); PG8_BAR; PG8_SCHED;
            PG8_LDB(B1, 0, 1); PG8_STAGE(PG8_SB(0, 0), b2, voffB);
            PG8_BAR; PG8_WAIT_L(0); PG8_MMA(0, 1, At, B1); PG8_BAR;
            PG8_LDA(At, 0, 1); PG8_STAGE(PG8_SA(0, 0), a2, voffA);
            PG8_BAR; PG8_WAIT_L(0); PG8_MMA(1, 0, At, B0); PG8_BAR; PG8_SCHED;
            PG8_STAGE(PG8_SB(0, 1), b2 + hstep, voffB);
            PG8_WAIT_V(6); PG8_BAR; PG8_MMA(1, 1, At, B1); PG8_BAR;
            PG8_LDB(B0, 1, 0); PG8_SCHED; PG8_LDA(At, 1, 0); PG8_STAGE(PG8_SA(0, 1), a2 + hstep, voffA);
            PG8_WAIT_L(8); PG8_BAR; PG8_WAIT_L(0); PG8_MMA(0, 0, At, B0); PG8_BAR; PG8_SCHED;
            PG8_LDB(B1, 1, 1); PG8_STAGE(PG8_SB(1, 0), b3, voffB);
            PG8_BAR; PG8_WAIT_L(0); PG8_MMA(0, 1, At, B1); PG8_BAR;
            PG8_LDA(At, 1, 1); PG8_STAGE(PG8_SA(1, 0), a3, voffA);
            PG8_BAR; PG8_WAIT_L(0); PG8_MMA(1, 0, At, B0); PG8_BAR; PG8_SCHED;
            PG8_STAGE(PG8_SB(1, 1), b3 + hstep, voffB);
            PG8_WAIT_V(6); PG8_BAR; PG8_MMA(1, 1, At, B1); PG8_BAR;
            }
        }
        if constexpr (ALIGN_EPI) { if (wr == 0) PG8_BAR; }
        if constexpr (!Epi::AFTER_DRAIN) { E(acc, cur, wr, wc, fr, fq); S.done(cur); }
        if (!has_next) break;
#pragma unroll
        for (int a = 0; a < 2; ++a)
#pragma unroll
            for (int b = 0; b < 2; ++b)
#pragma unroll
                for (int m = 0; m < 4; ++m)
#pragma unroll
                    for (int n = 0; n < 2; ++n) acc[a][b][m][n] = (f32x4){0.f, 0.f, 0.f, 0.f};
        cur = nxt; cA = nA; cB = nB; ++ui;
        if constexpr (ALIGN_EPI) { if (wr == 1) PG8_BAR; }
    }
    PG8_WAIT_V(0);
    if constexpr (!ALIGN_EPI) { if (wr == 0) PG8_BAR; }
    PG8_BAR;
    if constexpr (Epi::AFTER_DRAIN) { E.fused(acc, cur, wr, wc, fr, fq, lds, wid, lane); S.done(cur); }
#undef PG8_SA
#undef PG8_SB
#undef PG8_STAGE
#undef PG8_LDA
#undef PG8_LDB
#undef PG8_MMA
#undef PG8_WAIT_V
#undef PG8_WAIT_L
#undef PG8_BAR
#undef PG8_SCHED
}
}
namespace pg8 {
struct EpiProj {
    static constexpr bool PERM = true, AFTER_DRAIN = false;
    bf16_t* P;
    __device__ __forceinline__ void operator()(const f32x4 (&acc)[2][2][4][2], const Unit& u, int wr, int wc, int fr, int fq) const {
        const int row0 = u.pm * BM + wr * 64 + fr, col0 = wc * 32 + 8 * fq, pl = u.pn;
        bf16_t* base = P + (size_t)pl * ((size_t)MT * 256);
        const int mode = (pl < 2 || pl == 8 || pl == 9) ? 1 : ((pl == 6 || pl == 7 || pl == 14 || pl == 15) ? 2 : 0);
#pragma unroll
        for (int ai = 0; ai < 2; ++ai)
#pragma unroll
            for (int m = 0; m < 4; ++m) { bf16_t* rowp = base + (size_t)(row0 + ai * HALF + m * 16) * 256 + col0;
#pragma unroll
                for (int bj = 0; bj < 2; ++bj) { f32x4 v0 = acc[ai][bj][m][0], v1 = acc[ai][bj][m][1];
                    if (mode == 1) { v0 = v0 * C2; v1 = v1 * C2; }
                    if (mode == 2) {
#pragma unroll
                        for (int j = 0; j < 4; ++j) { v0[j] = silu_f(v0[j]); v1[j] = silu_f(v1[j]); } }
                    u32x4 w; w.x = cvt_pk_bf16(v0[0], v0[1]); w.y = cvt_pk_bf16(v0[2], v0[3]); w.z = cvt_pk_bf16(v1[0], v1[1]); w.w = cvt_pk_bf16(v1[2], v1[3]);
                    *(u32x4*)(rowp + bj * HALF) = w; } }
    }
};
struct EpiOut {
    static constexpr bool PERM = false, AFTER_DRAIN = false;
    const float* X; float* O;
    __device__ __forceinline__ void operator()(const f32x4 (&acc)[2][2][4][2], const Unit& u, int wr, int wc, int fr, int fq) const {
        const int row0 = u.pm * BM + wr * 64 + fr, col0 = u.pn * BM + wc * 32 + 4 * fq;
#pragma unroll
        for (int ai = 0; ai < 2; ++ai)
#pragma unroll
            for (int m = 0; m < 4; ++m) { const size_t off = (size_t)(row0 + ai * HALF + m * 16) * DM + col0;
#pragma unroll
                for (int bj = 0; bj < 2; ++bj)
#pragma unroll
                    for (int n = 0; n < 2; ++n) { const f32x4 xv = *(const f32x4*)(X + off + bj * HALF + n * 16); *(f32x4*)(O + off + bj * HALF + n * 16) = xv + acc[ai][bj][m][n]; } }
    }
};
}
__global__ void __launch_bounds__(512, 2) k_gemm_proj(const bf16_t* A, const bf16_t* Bt, bf16_t* P) {
    extern __shared__ __attribute__((aligned(16))) unsigned char shm[];
    pg8::Gemm g{A, Bt, MT, NPAD, DM}; pg8::StaticOrder S; S.init(MT, NPAD, (int)gridDim.x, (int)blockIdx.x);
    pg8::EpiProj E{P};
    pg8::gemm_phase<pg8::EpiProj, pg8::StaticOrder, true, true>((PG8_LAS unsigned char*)shm, g, S, E);
}
__global__ void __launch_bounds__(512, 2) k_gemm_out(const bf16_t* A, const bf16_t* Bt, const float* X, float* O) {
    extern __shared__ __attribute__((aligned(16))) unsigned char shm[];
    pg8::Gemm g{A, Bt, MT, DM, DM}; pg8::StaticOrder S; S.init(MT, DM, (int)gridDim.x, (int)blockIdx.x);
    pg8::EpiOut E{X, O};
    pg8::gemm_phase<pg8::EpiOut, pg8::StaticOrder, true, true>((PG8_LAS unsigned char*)shm, g, S, E);
}
__device__ __forceinline__ void prologue_body(int gw, int ngw, int lane, const float* __restrict__ x, const float* __restrict__ norm_w, const float* __restrict__ w_in,
                                              const float* __restrict__ w_out, bf16_t* H, float* IW, bf16_t* WinT, bf16_t* WoutT) {
    for (int m = gw; m < MT; m += ngw) {
        const f32x4_t* xr = (const f32x4_t*)(x + (size_t)m * DM) + lane;
        f32x4_t v[4]; float s = 0.f;
#pragma unroll
        for (int j = 0; j < 4; ++j) { v[j] = xr[64 * j]; s += (v[j].x * v[j].x + v[j].y * v[j].y) + (v[j].z * v[j].z + v[j].w * v[j].w); }
        const float rstd = 1.0f / sqrtf(wave_sum(s) * (1.0f / DM) + EPS);
        float a0 = 0.f, a1 = 0.f, a2 = 0.f, a3 = 0.f;
        u32x2_t* o8 = (u32x2_t*)(H + (size_t)m * DM) + lane;
#pragma unroll
        for (int j = 0; j < 4; ++j) {
            const f32x4_t w = ((const f32x4_t*)norm_w)[64 * j + lane];
            f32x4_t hv; hv.x = v[j].x * rstd * w.x; hv.y = v[j].y * rstd * w.y; hv.z = v[j].z * rstd * w.z; hv.w = v[j].w * rstd * w.w;
            const int d = 256 * j + 4 * lane;
            const f32x4_t w0 = *(const f32x4_t*)(w_in + (size_t)(d + 0) * D_IN + 4416), w1 = *(const f32x4_t*)(w_in + (size_t)(d + 1) * D_IN + 4416);
            const f32x4_t w2 = *(const f32x4_t*)(w_in + (size_t)(d + 2) * D_IN + 4416), w3 = *(const f32x4_t*)(w_in + (size_t)(d + 3) * D_IN + 4416);
            a0 += hv.x * w0.x + hv.y * w1.x + hv.z * w2.x + hv.w * w3.x;
            a1 += hv.x * w0.y + hv.y * w1.y + hv.z * w2.y + hv.w * w3.y;
            a2 += hv.x * w0.z + hv.y * w1.z + hv.z * w2.z + hv.w * w3.z;
            a3 += hv.x * w0.w + hv.y * w1.w + hv.z * w2.w + hv.w * w3.w;
            u32x2_t o; o.x = pk2(hv.x, hv.y); o.y = pk2(hv.z, hv.w); o8[64 * j] = o;
        }
        a0 = wave_sum(a0); a1 = wave_sum(a1); a2 = wave_sum(a2); a3 = wave_sum(a3);
        if (lane == 0) { f32x4_t o = {a0, a1, a2, a3}; *(f32x4_t*)(IW + (size_t)m * 4) = o; }
    }
    const long tid = (long)gw * 64 + lane, nth = (long)ngw * 64;
    for (long i = tid; i < (long)NPAD * (DM / 8); i += nth) {
        const int n = (int)(i % NPAD), k8 = (int)(i / NPAD);
        float e[8];
#pragma unroll
        for (int q = 0; q < 8; ++q) e[q] = (n < D_IN) ? w_in[(size_t)(k8 * 8 + q) * D_IN + n] : 0.f;
        u32x4_t o; o.x = pk2(e[0], e[1]); o.y = pk2(e[2], e[3]); o.z = pk2(e[4], e[5]); o.w = pk2(e[6], e[7]);
        *(u32x4_t*)(WinT + (size_t)n * DM + k8 * 8) = o;
    }
    for (long i = tid; i < (long)DM * (DM / 8); i += nth) {
        const int n = (int)(i % DM), k8 = (int)(i / DM);
        float e[8];
#pragma unroll
        for (int q = 0; q < 8; ++q) e[q] = w_out[(size_t)(k8 * 8 + q) * DM + n];
        u32x4_t o; o.x = pk2(e[0], e[1]); o.y = pk2(e[2], e[3]); o.z = pk2(e[4], e[5]); o.w = pk2(e[6], e[7]);
        *(u32x4_t*)(WoutT + (size_t)n * DM + k8 * 8) = o;
    }
}
__global__ void __launch_bounds__(256) k_prologue(const float* x, const float* norm_w, const float* w_in, const float* w_out, unsigned char* ws) {
    const int gw = (blockIdx.x * 256 + threadIdx.x) >> 6, ngw = gridDim.x * 4, lane = threadIdx.x & 63;
    prologue_body(gw, ngw, lane, x, norm_w, w_in, w_out, (bf16_t*)(ws + WS_H), (float*)(ws + WS_IW), (bf16_t*)(ws + WS_WINT), (bf16_t*)(ws + WS_WOUTT));
}
__device__ __forceinline__ void final_norm_body(int gw, int ngw, int lane, float* out, const float* __restrict__ fw) {
    for (int m = gw; m < MT; m += ngw) {
        f32x4_t* xr = (f32x4_t*)(out + (size_t)m * DM) + lane;
        f32x4_t v[4]; float s = 0.f;
#pragma unroll
        for (int j = 0; j < 4; ++j) { v[j] = xr[64 * j]; s += (v[j].x * v[j].x + v[j].y * v[j].y) + (v[j].z * v[j].z + v[j].w * v[j].w); }
        const float rstd = 1.0f / sqrtf(wave_sum(s) * (1.0f / DM) + EPS);
#pragma unroll
        for (int j = 0; j < 4; ++j) { const f32x4_t w = ((const f32x4_t*)fw)[64 * j + lane]; f32x4_t o;
            o.x = v[j].x * rstd * w.x; o.y = v[j].y * rstd * w.y; o.z = v[j].z * rstd * w.z; o.w = v[j].w * rstd * w.w; xr[64 * j] = o; }
    }
}
__global__ void __launch_bounds__(256) k_final(float* out, const float* fw) {
    final_norm_body((blockIdx.x * 256 + threadIdx.x) >> 6, gridDim.x * 4, threadIdx.x & 63, out, fw);
}

__global__ void __launch_bounds__(64) k_sel_naive(unsigned char* ws) {
    __shared__ unsigned skey[1][4096];
    __shared__ float sq[1][256];
    const int w = 0, lane = threadIdx.x & 63;
    const bf16_t* P = (const bf16_t*)(ws + WS_P); const float* IW = (const float*)(ws + WS_IW);
    float* THR = (float*)(ws + WS_THR); int* KCUT = (int*)(ws + WS_KCUT); int* SELCNT = (int*)(ws + WS_SELCNT); int* SEL = (int*)(ws + WS_SEL);
    for (int m = blockIdx.x; m < MT; m += gridDim.x) {
        const int b = m / SEQ, tpos = m % SEQ, N = ((tpos >> 6) + 1) << 6;
        int* sel = SEL + (size_t)m * 256;
        if (N <= 256) {
            for (int j = lane; j < N; j += 64) sel[j] = j;
            if (lane == 0) { THR[m] = -INFINITY; KCUT[m] = 0x7fffffff; SELCNT[m] = N; }
            continue;
        }
        { const u32x2_t q = *(const u32x2_t*)(P + PL_IQ * PLANE + (size_t)m * 256 + lane * 4);
          sq[w][lane * 4 + 0] = bflo(q.x); sq[w][lane * 4 + 1] = bfhi(q.x); sq[w][lane * 4 + 2] = bflo(q.y); sq[w][lane * 4 + 3] = bfhi(q.y); }
        const f32x4_t iw = *(const f32x4_t*)(IW + (size_t)m * 4);
        const float wg0 = iw.x * IDX_SCALE, wg1 = iw.y * IDX_SCALE, wg2 = iw.z * IDX_SCALE, wg3 = iw.w * IDX_SCALE;
        __syncthreads();
        for (int i = 0; i < N / 64; ++i) {
            const int s = i * 64 + lane; const bf16_t* kr = P + PL_IK * PLANE + (size_t)(b * SEQ + s) * 256;
            float l0 = 0.f, l1 = 0.f, l2 = 0.f, l3 = 0.f;
#pragma unroll
            for (int c = 0; c < 8; ++c) { const u32x4_t kv = *(const u32x4_t*)(kr + c * 8);
                const float k[8] = {bflo(kv.x), bfhi(kv.x), bflo(kv.y), bfhi(kv.y), bflo(kv.z), bfhi(kv.z), bflo(kv.w), bfhi(kv.w)};
#pragma unroll
                for (int e = 0; e < 8; ++e) { const int d = c * 8 + e; l0 += sq[w][d] * k[e]; l1 += sq[w][64 + d] * k[e]; l2 += sq[w][128 + d] * k[e]; l3 += sq[w][192 + d] * k[e]; } }
            float sc = wg0 * fmaxf(l0, 0.f) + wg1 * fmaxf(l1, 0.f) + wg2 * fmaxf(l2, 0.f) + wg3 * fmaxf(l3, 0.f);
            sc += 0.0f;
            skey[w][s] = f2key(sc);
        }
        __syncthreads();
        unsigned prefix = 0u;
        for (int bit = 31; bit >= 0; --bit) { const unsigned cand = prefix | (1u << bit); int c = 0;
            for (int i = 0; i < N / 64; ++i) c += (skey[w][i * 64 + lane] >= cand) ? 1 : 0;
            c = wave_sum_i(c); if (c >= 256) prefix = cand; }
        int cgt = 0; for (int i = 0; i < N / 64; ++i) cgt += (skey[w][i * 64 + lane] > prefix) ? 1 : 0;
        cgt = wave_sum_i(cgt);
        const int r = 256 - cgt;
        int run = 0, kcut = 0x7fffffff;
        for (int i = 0; i < N / 64; ++i) { const unsigned long long bm = __ballot(skey[w][i * 64 + lane] == prefix); const int c = __popcll(bm);
            if (run + c >= r) { unsigned long long t = bm; for (int q = 0; q < r - run - 1; ++q) t &= t - 1; kcut = i * 64 + (int)__builtin_ctzll(t); break; }
            run += c; }
        int base = 0;
        for (int i = 0; i < N / 64; ++i) { const unsigned k = skey[w][i * 64 + lane]; const int idx = i * 64 + lane; const bool f = (k > prefix) || (k == prefix && idx <= kcut);
            const unsigned long long bm = __ballot(f); const int pos = base + __popcll(bm & ((1ull << lane) - 1ull)); if (f && pos < 256) sel[pos] = idx; base += __popcll(bm); }
        if (lane == 0) { THR[m] = key2f(prefix); KCUT[m] = kcut; SELCNT[m] = 256; }
        __syncthreads();
    }
}
__global__ void __launch_bounds__(64) k_dsa_naive(unsigned char* ws, const float* __restrict__ rel_bias) {
    __shared__ float sq[1][512];
    __shared__ float sc[1][8][256];
    __shared__ int ssel[1][256];
    const int w = 0, lane = threadIdx.x & 63;
    const bf16_t* P = (const bf16_t*)(ws + WS_P); const int* SELCNT = (const int*)(ws + WS_SELCNT); const int* SEL = (const int*)(ws + WS_SEL);
    bf16_t* AOBO = (bf16_t*)(ws + WS_AOBO);
    for (int m0 = blockIdx.x; m0 < MT; m0 += gridDim.x) {
        const int m = m0 + w; const int b = m / SEQ, tpos = m % SEQ; const int cnt = SELCNT[m];
        { const int hc = lane * 8; const u32x4_t q = *(const u32x4_t*)(P + (PL_BQ + (hc >> 8)) * PLANE + (size_t)m * 256 + (hc & 255));
          sq[w][hc + 0] = bflo(q.x); sq[w][hc + 1] = bfhi(q.x); sq[w][hc + 2] = bflo(q.y); sq[w][hc + 3] = bfhi(q.y); sq[w][hc + 4] = bflo(q.z); sq[w][hc + 5] = bfhi(q.z); sq[w][hc + 6] = bflo(q.w); sq[w][hc + 7] = bfhi(q.w); }
        for (int j = lane; j < 256; j += 64) ssel[w][j] = (j < cnt) ? SEL[(size_t)m * 256 + j] : 0;
        __syncthreads();
        for (int jj = 0; jj < 4; ++jj) { const int j = jj * 64 + lane;
            if (j < cnt) { const int s = ssel[w][j]; const size_t ms = (size_t)(b * SEQ + s); const int bk = t5_bucket(s - tpos);
                for (int h = 0; h < 8; ++h) { const bf16_t* kr = P + (PL_BK + (h >> 2)) * PLANE + ms * 256 + (h & 3) * 64; float a = 0.f;
#pragma unroll
                    for (int c = 0; c < 8; ++c) { const u32x4_t kv = *(const u32x4_t*)(kr + c * 8); const float* q = &sq[w][h * 64 + c * 8];
                        a += q[0] * bflo(kv.x) + q[1] * bfhi(kv.x) + q[2] * bflo(kv.y) + q[3] * bfhi(kv.y) + q[4] * bflo(kv.z) + q[5] * bfhi(kv.z) + q[6] * bflo(kv.w) + q[7] * bfhi(kv.w); }
                    sc[w][h][j] = a + rel_bias[bk * 12 + 4 + h] * LOG2E; }
            } else { for (int h = 0; h < 8; ++h) sc[w][h][j] = -INFINITY; }
        }
        __syncthreads();
        for (int h = 0; h < 8; ++h) { float v0 = sc[w][h][lane], v1 = sc[w][h][64 + lane], v2 = sc[w][h][128 + lane], v3 = sc[w][h][192 + lane];
            const float mx = wave_max(fmaxf(fmaxf(v0, v1), fmaxf(v2, v3)));
            v0 = __builtin_amdgcn_exp2f(v0 - mx); v1 = __builtin_amdgcn_exp2f(v1 - mx); v2 = __builtin_amdgcn_exp2f(v2 - mx); v3 = __builtin_amdgcn_exp2f(v3 - mx);
            const float inv = 1.0f / wave_sum((v0 + v1) + (v2 + v3));
            sc[w][h][lane] = v0 * inv; sc[w][h][64 + lane] = v1 * inv; sc[w][h][128 + lane] = v2 * inv; sc[w][h][192 + lane] = v3 * inv; }
        __syncthreads();
        { const int hc = lane * 8, h = lane >> 3; float acc[8];
#pragma unroll
          for (int e = 0; e < 8; ++e) acc[e] = 0.f;
          for (int j = 0; j < cnt; ++j) { const float p = sc[w][h][j]; const int s = ssel[w][j];
              const u32x4_t vv = *(const u32x4_t*)(P + (PL_BV + (hc >> 8)) * PLANE + (size_t)(b * SEQ + s) * 256 + (hc & 255));
              acc[0] += p * bflo(vv.x); acc[1] += p * bfhi(vv.x); acc[2] += p * bflo(vv.y); acc[3] += p * bfhi(vv.y); acc[4] += p * bflo(vv.z); acc[5] += p * bfhi(vv.z); acc[6] += p * bflo(vv.w); acc[7] += p * bfhi(vv.w); }
          const u32x4_t g = *(const u32x4_t*)(P + (PL_BG + (hc >> 8)) * PLANE + (size_t)m * 256 + (hc & 255));
          u32x4_t o; o.x = pk2(acc[0] * bflo(g.x), acc[1] * bfhi(g.x)); o.y = pk2(acc[2] * bflo(g.y), acc[3] * bfhi(g.y)); o.z = pk2(acc[4] * bflo(g.z), acc[5] * bfhi(g.z)); o.w = pk2(acc[6] * bflo(g.w), acc[7] * bfhi(g.w));
          *(u32x4_t*)(AOBO + (size_t)m * DM + 512 + hc) = o; }
        __syncthreads();
    }
}
__global__ void __launch_bounds__(64) k_diff_naive(unsigned char* ws, const float* __restrict__ rel_bias, const float* lq1, const float* lk1, const float* lq2, const float* lk2, const float* __restrict__ subln_w) {
    __shared__ float s1[4096];
    __shared__ float s2[4096];
    __shared__ float sq[128];
    const int lane = threadIdx.x;
    const bf16_t* P = (const bf16_t*)(ws + WS_P); bf16_t* AOBO = (bf16_t*)(ws + WS_AOBO);
    const float lam = expf(wave_sum(lq1[lane] * lk1[lane])) - expf(wave_sum(lq2[lane] * lk2[lane])) + LAMBDA_INIT;
    for (int it = blockIdx.x; it < MT * 4; it += gridDim.x) {
        const int m = it >> 2, h = it & 3, b = m / SEQ, tpos = m % SEQ, N = ((tpos >> 6) + 1) << 6;
        const int pq = h >> 1, co = (h & 1) * 128;
        { const unsigned q = *(const unsigned*)(P + (PL_AQ + pq) * PLANE + (size_t)m * 256 + co + lane * 2); sq[lane * 2] = bflo(q); sq[lane * 2 + 1] = bfhi(q); }
        __syncthreads();
        float mx1 = -INFINITY, mx2 = -INFINITY;
        for (int i = 0; i < N / 64; ++i) { const int s = i * 64 + lane; const bf16_t* kr = P + (PL_AK + pq) * PLANE + (size_t)(b * SEQ + s) * 256 + co;
            float d1 = 0.f, d2 = 0.f;
#pragma unroll
            for (int c = 0; c < 8; ++c) { const u32x4_t kv = *(const u32x4_t*)(kr + c * 8); const float* q = &sq[c * 8];
                d1 += q[0] * bflo(kv.x) + q[1] * bfhi(kv.x) + q[2] * bflo(kv.y) + q[3] * bfhi(kv.y) + q[4] * bflo(kv.z) + q[5] * bfhi(kv.z) + q[6] * bflo(kv.w) + q[7] * bfhi(kv.w); }
#pragma unroll
            for (int c = 0; c < 8; ++c) { const u32x4_t kv = *(const u32x4_t*)(kr + 64 + c * 8); const float* q = &sq[64 + c * 8];
                d2 += q[0] * bflo(kv.x) + q[1] * bfhi(kv.x) + q[2] * bflo(kv.y) + q[3] * bfhi(kv.y) + q[4] * bflo(kv.z) + q[5] * bfhi(kv.z) + q[6] * bflo(kv.w) + q[7] * bfhi(kv.w); }
            const float bias = rel_bias[t5_bucket(s - tpos) * 12 + h] * LOG2E;
            d1 += bias; d2 += bias; s1[s] = d1; s2[s] = d2; mx1 = fmaxf(mx1, d1); mx2 = fmaxf(mx2, d2); }
        mx1 = wave_max(mx1); mx2 = wave_max(mx2);
        float l1 = 0.f, l2 = 0.f;
        for (int i = 0; i < N / 64; ++i) { const int s = i * 64 + lane; const float p1 = __builtin_amdgcn_exp2f(s1[s] - mx1), p2 = __builtin_amdgcn_exp2f(s2[s] - mx2); s1[s] = p1; s2[s] = p2; l1 += p1; l2 += p2; }
        l1 = wave_sum(l1); l2 = wave_sum(l2);
        const float i1 = 1.0f / l1, i2 = lam / l2;
        for (int i = 0; i < N / 64; ++i) { const int s = i * 64 + lane; s1[s] = s1[s] * i1 - s2[s] * i2; }
        __syncthreads();
        float a0 = 0.f, a1 = 0.f;
        const bf16_t* vb = P + (PL_AV + pq) * PLANE + (size_t)(b * SEQ) * 256 + co + lane * 2;
        for (int s = 0; s < N; ++s) { const float wv = s1[s]; const unsigned vv = *(const unsigned*)(vb + (size_t)s * 256); a0 += wv * bflo(vv); a1 += wv * bfhi(vv); }
        const float rstd = 1.0f / sqrtf(wave_sum(a0 * a0 + a1 * a1) * (1.0f / 128.0f) + EPS);
        const unsigned g = *(const unsigned*)(P + (PL_AG + pq) * PLANE + (size_t)m * 256 + co + lane * 2);
        const float o0 = a0 * rstd * subln_w[lane * 2] * ONE_M_LAMBDA * bflo(g), o1 = a1 * rstd * subln_w[lane * 2 + 1] * ONE_M_LAMBDA * bfhi(g);
        *(unsigned*)(AOBO + (size_t)m * DM + h * 128 + lane * 2) = pk2(o0, o1);
        __syncthreads();
    }
}
extern "C" void kernel_launch(void* const* d_in, const int* in_sizes, int n_in, void* d_out, int out_size, void* d_ws, size_t ws_size, hipStream_t stream) {
    static int ready = 0;
    if (ready == 0) {
        if (n_in != 11 || out_size != MT * DM || ws_size < WS_END) { fprintf(stderr, "kernel_launch: unexpected shapes (n_in %d out %d ws %zu need %zu)\n", n_in, out_size, ws_size, (size_t)WS_END); ready = -1; return; }
        if (hipFuncSetAttribute((const void*)k_gemm_proj, hipFuncAttributeMaxDynamicSharedMemorySize, pg8::STAGE_BYTES) != hipSuccess ||
            hipFuncSetAttribute((const void*)k_gemm_out, hipFuncAttributeMaxDynamicSharedMemorySize, pg8::STAGE_BYTES) != hipSuccess) { fprintf(stderr, "kernel_launch: hipFuncSetAttribute failed\n"); ready = -1; return; }
        ready = 1;
    }
    if (ready < 0) return;
    const float* x = (const float*)d_in[0]; const float* norm_w = (const float*)d_in[1]; const float* w_in = (const float*)d_in[2]; const float* w_out = (const float*)d_in[3];
    const float* lq1 = (const float*)d_in[4]; const float* lk1 = (const float*)d_in[5]; const float* lq2 = (const float*)d_in[6]; const float* lk2 = (const float*)d_in[7];
    const float* subln_w = (const float*)d_in[8]; const float* rel_bias = (const float*)d_in[9]; const float* fnw = (const float*)d_in[10];
    unsigned char* ws = (unsigned char*)d_ws; float* out = (float*)d_out;
    hipLaunchKernelGGL(k_prologue, dim3(2048), dim3(256), 0, stream, x, norm_w, w_in, w_out, ws);
    hipLaunchKernelGGL(k_gemm_proj, dim3(256), dim3(512), pg8::STAGE_BYTES, stream, (const bf16_t*)(ws + WS_H), (const bf16_t*)(ws + WS_WINT), (bf16_t*)(ws + WS_P));
    hipLaunchKernelGGL(k_sel_naive, dim3(4096), dim3(64), 0, stream, ws);
    hipLaunchKernelGGL(k_dsa_naive, dim3(4096), dim3(64), 0, stream, ws, rel_bias);
    hipLaunchKernelGGL(k_diff_naive, dim3(8192), dim3(64), 0, stream, ws, rel_bias, lq1, lk1, lq2, lk2, subln_w);
    hipLaunchKernelGGL(k_gemm_out, dim3(256), dim3(512), pg8::STAGE_BYTES, stream, (const bf16_t*)(ws + WS_AOBO), (const bf16_t*)(ws + WS_WOUTT), x, out);
    hipLaunchKernelGGL(k_final, dim3(2048), dim3(256), 0, stream, out, fnw);
}
```

```cpp
#include <hip/hip_runtime.h>
#include <cstdio>
#include <cstdint>
#include <cstring>
#include <cmath>
#define LAS __attribute__((address_space(3)))
typedef unsigned short bf16_t;
typedef unsigned u32x4_t __attribute__((ext_vector_type(4)));
typedef unsigned u32x2_t __attribute__((ext_vector_type(2)));
typedef float f32x4_t __attribute__((ext_vector_type(4)));

constexpr int DM = 1024, NBATCH = 8, SEQ = 4096, MT = NBATCH * SEQ;
constexpr int D_IN = 4420, NPAD = 4608, NPLANES = 18;
constexpr float EPS = 1e-6f, LOG2E = 1.4426950408889634f;
constexpr float C2 = 0.125f * LOG2E;
constexpr float IDX_SCALE = 0.0625f;
constexpr float LAMBDA_INIT = 0.2f, ONE_M_LAMBDA = 0.8f;
constexpr size_t PLANE = (size_t)MT * 256;
constexpr int PL_AQ = 0, PL_AK = 2, PL_AV = 4, PL_AG = 6, PL_BQ = 8, PL_BK = 10, PL_BV = 12, PL_BG = 14, PL_IQ = 16, PL_IK = 17;

constexpr size_t WS_CTL = 0;
constexpr size_t WS_WINT = 65536;
constexpr size_t WS_WOUTT = WS_WINT + (size_t)NPAD * DM * 2;
constexpr size_t WS_H = WS_WOUTT + (size_t)DM * DM * 2;
constexpr size_t WS_P = WS_H + (size_t)MT * DM * 2;
constexpr size_t WS_IW = WS_P + (size_t)NPLANES * PLANE * 2;
constexpr size_t WS_THR = WS_IW + (size_t)MT * 16;
constexpr size_t WS_KCUT = WS_THR + (size_t)MT * 4;
constexpr size_t WS_SELCNT = WS_KCUT + (size_t)MT * 4;
constexpr size_t WS_AOBO = WS_SELCNT + (size_t)MT * 4;
constexpr size_t WS_SEL = WS_AOBO + (size_t)MT * DM * 2;
constexpr size_t WS_END = WS_SEL + (size_t)MT * 256 * 4;

__device__ __forceinline__ float bf2f(bf16_t v) { return __uint_as_float(((unsigned)v) << 16); }
__device__ __forceinline__ float bflo(unsigned w) { return __uint_as_float(w << 16); }
__device__ __forceinline__ float bfhi(unsigned w) { return __uint_as_float(w & 0xffff0000u); }
__device__ __forceinline__ unsigned pk2(float lo, float hi) {
    typedef float f2 __attribute__((ext_vector_type(2))); typedef __bf16 b2 __attribute__((ext_vector_type(2)));
    f2 v = {lo, hi}; b2 b = __builtin_convertvector(v, b2); return __builtin_bit_cast(unsigned, b); }
__device__ __forceinline__ float wave_sum(float v) {
#pragma unroll
    for (int o = 1; o < 64; o <<= 1) v += __shfl_xor(v, o);
    return v; }
__device__ __forceinline__ int wave_sum_i(int v) {
#pragma unroll
    for (int o = 1; o < 64; o <<= 1) v += __shfl_xor(v, o);
    return v; }
__device__ __forceinline__ float wave_max(float v) {
#pragma unroll
    for (int o = 1; o < 64; o <<= 1) v = fmaxf(v, __shfl_xor(v, o));
    return v; }
__device__ __forceinline__ int t5_bucket(int rel) {
    const int ret = rel > 0 ? 16 : 0; const int n = rel < 0 ? -rel : rel;
    if (n < 8) return ret + n;
    int large = 2 + (31 - __builtin_clz((unsigned)(n * n))); large = large > 15 ? 15 : large;
    return ret + large; }
__device__ __forceinline__ unsigned f2key(float f) { const unsigned u = __float_as_uint(f); return (u & 0x80000000u) ? ~u : (u | 0x80000000u); }
__device__ __forceinline__ float key2f(unsigned k) { return __uint_as_float((k & 0x80000000u) ? (k ^ 0x80000000u) : ~k); }
__device__ __forceinline__ float silu_f(float v) { return v * __builtin_amdgcn_rcpf(1.0f + __builtin_amdgcn_exp2f(-v * LOG2E)); }
namespace pg8 {
#define PG8_LAS __attribute__((address_space(3)))
typedef unsigned short bf16_t;
typedef short bf16x8 __attribute__((ext_vector_type(8)));
typedef float f32x4 __attribute__((ext_vector_type(4)));
typedef unsigned u32x4 __attribute__((ext_vector_type(4)));
constexpr int BM = 256, BK = 64, HALF = 128, HTB = HALF * BK * 2  , STAGE_BYTES = 8 * HTB, NXCD = 8, WGM = 8;

__host__ __device__ __forceinline__ int lds_byte(int r, int c) { const int st = (r >> 4) * 2 + (c >> 5), rr = r & 15, cc = c & 31, ob = rr * 64 + cc * 2; return st * 1024 + (ob ^ (((ob >> 9) & 1) << 5)); }
__host__ __device__ __forceinline__ void stage_rc(int b, int& R, int& C) { const int st = b / 1024, sb = b % 1024, swz = sb ^ (((sb >> 9) & 1) << 5); R = (st >> 1) * 16 + swz / 64; C = (st & 1) * 32 + (swz % 64) / 2; }
__host__ __device__ __forceinline__ int perm32(int rho) { const int n = rho >> 4, i = rho & 15; return 8 * (i >> 2) + 4 * n + (i & 3); }

struct Unit { int pm, pn; };
struct Gemm { const bf16_t* A; const bf16_t* Bt; int M, N, K; };

struct StaticOrder {
    int nM, nN, nwg, G, c;
    __host__ __device__ void init(int M, int N, int G_, int c_) { nM = M / BM; nN = N / BM; nwg = nM * nN; G = G_; c = c_; }
    __host__ __device__ bool next(int i, Unit& u) const {
        const long L = (long)i * G + c; if (L >= nwg) return false;
        int wgid = (int)L; { const int q = nwg / NXCD, r = nwg % NXCD, xcd = wgid % NXCD, off = wgid / NXCD; wgid = (xcd < r ? xcd * (q + 1) : r * (q + 1) + (xcd - r) * q) + off; }
        const int nig = WGM * nN, gid = wgid / nig, fm = gid * WGM, gsz = (nM - fm) < WGM ? (nM - fm) : WGM;
        u.pm = fm + ((wgid % nig) % gsz); u.pn = (wgid % nig) / gsz; return true;
    }
    __device__ __forceinline__ void a_ready(const Unit&) const {}
    __device__ __forceinline__ void done(const Unit&) const {}
};

__device__ __forceinline__ unsigned cvt_pk_bf16(float lo, float hi) { unsigned r; asm volatile("v_cvt_pk_bf16_f32 %0, %1, %2" : "=v"(r) : "v"(lo), "v"(hi)); return r; }
template <class Epi, class Sched, bool ALIGN_EPI = false, bool SP2 = false>
__device__ __forceinline__ void gemm_phase(PG8_LAS unsigned char* lds, const Gemm g, const Sched& S, const Epi& E) {
    const int tid = threadIdx.x, wid = __builtin_amdgcn_readfirstlane(tid >> 6), lane = tid & 63, wr = wid >> 2, wc = wid & 3, fr = lane & 15, fq = lane >> 4;
    const int K = g.K, nt = K / BK;
    unsigned voffA[2], voffB[2];
#pragma unroll
    for (int i = 0; i < 2; ++i) { int R, C; stage_rc(tid * 16 + i * 8192, R, C); const int Rb = Epi::PERM ? ((R & ~31) + perm32(R & 31)) : R;
        voffA[i] = (unsigned)(R * K + C) * 2u; voffB[i] = (unsigned)(Rb * K + C) * 2u; }
    const size_t kstep = (size_t)(BK * 2);
    const size_t hstep = (size_t)HALF * K * 2;
    const size_t tstep = 2 * hstep;
    const unsigned ldsw = (unsigned)wid * 1024u;
    const int aoff = lds_byte(wr * 64 + fr, fq * 8), boff = lds_byte(wc * 32 + fr, fq * 8);
#define PG8_SA(b, h) (((b) * 2 + (h)) * HTB)
#define PG8_SB(b, h) ((4 + (b) * 2 + (h)) * HTB)
#define PG8_STAGE(bufoff, gbase, voff) do { _Pragma("unroll") for (int _i = 0; _i < 2; ++_i) \
        __builtin_amdgcn_global_load_lds((const unsigned*)((const char*)(gbase) + (voff)[_i]), (PG8_LAS unsigned*)(lds + (bufoff) + ldsw + _i * 8192), 16, 0, 0); } while (0)
#define PG8_LDA(dst, b, h) do { _Pragma("unroll") for (int m = 0; m < 4; ++m) _Pragma("unroll") for (int k = 0; k < 2; ++k) dst[m][k] = *(const PG8_LAS bf16x8*)(lds + PG8_SA(b, h) + aoff + m * 2048 + k * 1024); } while (0)
#define PG8_LDB(dst, b, h) do { _Pragma("unroll") for (int n = 0; n < 2; ++n) _Pragma("unroll") for (int k = 0; k < 2; ++k) dst[n][k] = *(const PG8_LAS bf16x8*)(lds + PG8_SB(b, h) + boff + n * 2048 + k * 1024); } while (0)
#define PG8_MMA(ai, bj, At, Bt) do { __builtin_amdgcn_s_setprio(1); _Pragma("unroll") for (int m = 0; m < 4; ++m) _Pragma("unroll") for (int n = 0; n < 2; ++n) _Pragma("unroll") for (int k = 0; k < 2; ++k) \
        acc[ai][bj][m][n] = __builtin_amdgcn_mfma_f32_16x16x32_bf16(Bt[n][k], At[m][k], acc[ai][bj][m][n], 0, 0, 0); __builtin_amdgcn_s_setprio(0); } while (0)
#define PG8_WAIT_V(n) asm volatile("s_waitcnt vmcnt(" #n ")" ::: "memory")
#define PG8_WAIT_L(n) asm volatile("s_waitcnt lgkmcnt(" #n ")" ::: "memory")
#define PG8_BAR __builtin_amdgcn_s_barrier()
#define PG8_SCHED __builtin_amdgcn_sched_barrier(0)
    Unit cur, nxt; int ui = 0;
    if (!S.next(0, cur)) return;
    f32x4 acc[2][2][4][2];
#pragma unroll
    for (int a = 0; a < 2; ++a)
#pragma unroll
        for (int b = 0; b < 2; ++b)
#pragma unroll
            for (int m = 0; m < 4; ++m)
#pragma unroll
                for (int n = 0; n < 2; ++n) acc[a][b][m][n] = (f32x4){0.f, 0.f, 0.f, 0.f};
    bf16x8 At[4][2], B0[2][2], B1[2][2];
    const char* cA = (const char*)g.A + (size_t)cur.pm * tstep; const char* cB = (const char*)g.Bt + (size_t)cur.pn * tstep;
    S.a_ready(cur);
    if constexpr (SP2) {
        PG8_STAGE(PG8_SB(0, 0), cB, voffB); PG8_STAGE(PG8_SB(0, 1), cB + hstep, voffB); PG8_STAGE(PG8_SA(0, 0), cA, voffA); PG8_STAGE(PG8_SA(0, 1), cA + hstep, voffA);
        if (wr == 1) PG8_BAR;
        PG8_WAIT_V(2); PG8_BAR;
        PG8_STAGE(PG8_SB(1, 0), cB + kstep, voffB); PG8_STAGE(PG8_SA(1, 0), cA + kstep, voffA); PG8_STAGE(PG8_SB(1, 1), cB + hstep + kstep, voffB);
        PG8_WAIT_V(6); PG8_BAR;
    } else {
        PG8_STAGE(PG8_SB(0, 0), cB, voffB); PG8_STAGE(PG8_SA(0, 0), cA, voffA); PG8_STAGE(PG8_SB(0, 1), cB + hstep, voffB); PG8_STAGE(PG8_SA(0, 1), cA + hstep, voffA);
        if (wr == 1) PG8_BAR;
        PG8_WAIT_V(4); PG8_BAR;
        PG8_STAGE(PG8_SB(1, 0), cB + kstep, voffB); PG8_STAGE(PG8_SA(1, 0), cA + kstep, voffA); PG8_STAGE(PG8_SB(1, 1), cB + hstep + kstep, voffB);
        PG8_WAIT_V(6); PG8_BAR;
    }
    for (;;) {
        const bool has_next = S.next(ui + 1, nxt);
        const char* nA = has_next ? (const char*)g.A + (size_t)nxt.pm * tstep : cA; const char* nB = has_next ? (const char*)g.Bt + (size_t)nxt.pn * tstep : cB;
        for (int t = 0; t < nt; t += 2) {
            const bool last = (t == nt - 2);
            const char* a1 = cA + (size_t)(t + 1) * kstep;
            const char* a2 = last ? nA : cA + (size_t)(t + 2) * kstep; const char* b2 = last ? nB : cB + (size_t)(t + 2) * kstep;
            const char* a3 = a2 + kstep; const char* b3 = b2 + kstep;
            if (last && has_next) S.a_ready(nxt);
            if constexpr (SP2) {
            PG8_LDB(B0, 0, 0); PG8_LDB(B1, 0, 1); PG8_SCHED; PG8_LDA(At, 0, 0); PG8_STAGE(PG8_SA(1, 1), a1 + hstep, voffA);
            PG8_WAIT_V(8); PG8_WAIT_L(0); PG8_BAR; PG8_MMA(0, 0, At, B0); PG8_MMA(0, 1, At, B1); PG8_BAR; PG8_SCHED;
            PG8_LDA(At, 0, 1); PG8_STAGE(PG8_SB(0, 0), b2, voffB); PG8_STAGE(PG8_SB(0, 1), b2 + hstep, voffB); PG8_STAGE(PG8_SA(0, 0), a2, voffA);
            PG8_WAIT_V(8); PG8_WAIT_L(0); PG8_BAR; PG8_MMA(1, 0, At, B0); PG8_MMA(1, 1, At, B1); PG8_BAR; PG8_SCHED;
            PG8_LDB(B0, 1, 0); PG8_LDB(B1, 1, 1); PG8_SCHED; PG8_LDA(At, 1, 0); PG8_STAGE(PG8_SA(0, 1), a2 + hstep, voffA);
            PG8_WAIT_V(8); PG8_WAIT_L(0); PG8_BAR; PG8_MMA(0, 0, At, B0); PG8_MMA(0, 1, At, B1); PG8_BAR; PG8_SCHED;
            PG8_LDA(At, 1, 1); PG8_STAGE(PG8_SB(1, 0), b3, voffB); PG8_STAGE(PG8_SB(1, 1), b3 + hstep, voffB); PG8_STAGE(PG8_SA(1, 0), a3, voffA);
            PG8_WAIT_V(8); PG8_WAIT_L(0); PG8_BAR; PG8_MMA(1, 0, At, B0); PG8_MMA(1, 1, At, B1); PG8_BAR; PG8_SCHED;
            } else {
            PG8_LDB(B0, 0, 0); PG8_SCHED; PG8_LDA(At, 0, 0); PG8_STAGE(PG8_SA(1, 1), a1 + hstep, voffA);
            PG8_WAIT_L(8); PG8_BAR; PG8_WAIT_L(0); PG8_MMA(0, 0, At, B0); PG8_BAR; PG8_SCHED;
            PG8_LDB(B1, 0, 1); PG8_STAGE(PG8_SB(0, 0), b2, voffB);
            PG8_BAR; PG8_WAIT_L(0); PG8_MMA(0, 1, At, B1); PG8_BAR;
            PG8_LDA(At, 0, 1); PG8_STAGE(PG8_SA(0, 0), a2, voffA);
            PG8_BAR; PG8_WAIT_L(0); PG8_MMA(1, 0, At, B0); PG8_BAR; PG8_SCHED;
            PG8_STAGE(PG8_SB(0, 1), b2 + hstep, voffB);
            PG8_WAIT_V(6); PG8_BAR; PG8_MMA(1, 1, At, B1); PG8_BAR;
            PG8_LDB(B0, 1, 0); PG8_SCHED; PG8_LDA(At, 1, 0); PG8_STAGE(PG8_SA(0, 1), a2 + hstep, voffA);
            PG8_WAIT_L(8); PG8_BAR; PG8_WAIT_L(0); PG8_MMA(0, 0, At, B0); PG8_BAR; PG8_SCHED;
            PG8_LDB(B1, 1, 1); PG8_STAGE(PG8_SB(1, 0), b3, voffB);
            PG8_BAR; PG8_WAIT_L(0); PG8_MMA(0, 1, At, B1); PG8_BAR;
            PG8_LDA(At, 1, 1); PG8_STAGE(PG8_SA(1, 0), a3, voffA);
            PG8_BAR; PG8_WAIT_L(0); PG8_MMA(1, 0, At, B0); PG8_BAR; PG8_SCHED;
            PG8_STAGE(PG8_SB(1, 1), b3 + hstep, voffB);
            PG8_WAIT_V(6); PG8_BAR; PG8_MMA(1, 1, At, B1); PG8_BAR;
            }
        }
        if constexpr (ALIGN_EPI) { if (wr == 0) PG8_BAR; }
        if constexpr (!Epi::AFTER_DRAIN) { E(acc, cur, wr, wc, fr, fq); S.done(cur); }
        if (!has_next) break;
#pragma unroll
        for (int a = 0; a < 2; ++a)
#pragma unroll
            for (int b = 0; b < 2; ++b)
#pragma unroll
                for (int m = 0; m < 4; ++m)
#pragma unroll
                    for (int n = 0; n < 2; ++n) acc[a][b][m][n] = (f32x4){0.f, 0.f, 0.f, 0.f};
        cur = nxt; cA = nA; cB = nB; ++ui;
        if constexpr (ALIGN_EPI) { if (wr == 1) PG8_BAR; }
    }
    PG8_WAIT_V(0);
    if constexpr (!ALIGN_EPI) { if (wr == 0) PG8_BAR; }
    PG8_BAR;
    if constexpr (Epi::AFTER_DRAIN) { E.fused(acc, cur, wr, wc, fr, fq, lds, wid, lane); S.done(cur); }
#undef PG8_SA
#undef PG8_SB
#undef PG8_STAGE
#undef PG8_LDA
#undef PG8_LDB
#undef PG8_MMA
#undef PG8_WAIT_V
#undef PG8_WAIT_L
#undef PG8_BAR
#undef PG8_SCHED
}
}
namespace pg8 {
struct EpiProj {
    static constexpr bool PERM = true, AFTER_DRAIN = false;
    bf16_t* P;
    __device__ __forceinline__ void operator()(const f32x4 (&acc)[2][2][4][2], const Unit& u, int wr, int wc, int fr, int fq) const {
        const int row0 = u.pm * BM + wr * 64 + fr, col0 = wc * 32 + 8 * fq, pl = u.pn;
        bf16_t* base = P + (size_t)pl * ((size_t)MT * 256);
        const int mode = (pl < 2 || pl == 8 || pl == 9) ? 1 : ((pl == 6 || pl == 7 || pl == 14 || pl == 15) ? 2 : 0);
#pragma unroll
        for (int ai = 0; ai < 2; ++ai)
#pragma unroll
            for (int m = 0; m < 4; ++m) { bf16_t* rowp = base + (size_t)(row0 + ai * HALF + m * 16) * 256 + col0;
#pragma unroll
                for (int bj = 0; bj < 2; ++bj) { f32x4 v0 = acc[ai][bj][m][0], v1 = acc[ai][bj][m][1];
                    if (mode == 1) { v0 = v0 * C2; v1 = v1 * C2; }
                    if (mode == 2) {
#pragma unroll
                        for (int j = 0; j < 4; ++j) { v0[j] = silu_f(v0[j]); v1[j] = silu_f(v1[j]); } }
                    u32x4 w; w.x = cvt_pk_bf16(v0[0], v0[1]); w.y = cvt_pk_bf16(v0[2], v0[3]); w.z = cvt_pk_bf16(v1[0], v1[1]); w.w = cvt_pk_bf16(v1[2], v1[3]);
                    *(u32x4*)(rowp + bj * HALF) = w; } }
    }
};
struct EpiOut {
    static constexpr bool PERM = false, AFTER_DRAIN = false;
    const float* X; float* O;
    __device__ __forceinline__ void operator()(const f32x4 (&acc)[2][2][4][2], const Unit& u, int wr, int wc, int fr, int fq) const {
        const int row0 = u.pm * BM + wr * 64 + fr, col0 = u.pn * BM + wc * 32 + 4 * fq;
#pragma unroll
        for (int ai = 0; ai < 2; ++ai)
#pragma unroll
            for (int m = 0; m < 4; ++m) { const size_t off = (size_t)(row0 + ai * HALF + m * 16) * DM + col0;
#pragma unroll
                for (int bj = 0; bj < 2; ++bj)
#pragma unroll
                    for (int n = 0; n < 2; ++n) { const f32x4 xv = *(const f32x4*)(X + off + bj * HALF + n * 16); *(f32x4*)(O + off + bj * HALF + n * 16) = xv + acc[ai][bj][m][n]; } }
    }
};
}
#include <cstdlib>
#include <vector>

#define XB_TMO      128
#define XB_XCNT(j)  (256  + 64 * (j))
#define XB_XSUB(j)  (1280 + 64 * (j))
#define XB_XGEN(j)  (2304 + 64 * (j))
#define XB_TOP      3328
#define XB_TOPGEN   3392
#define XCD_BAR_WORDS 3456
#define XB_SPIN_CAP (1u << 18)
#define LAS __attribute__((address_space(3)))

__device__ __forceinline__ unsigned xb_ld(unsigned* p)              { return __hip_atomic_load(p, __ATOMIC_RELAXED, __HIP_MEMORY_SCOPE_AGENT); }
__device__ __forceinline__ unsigned xb_add(unsigned* p, unsigned v) { return __hip_atomic_fetch_add(p, v, __ATOMIC_RELAXED, __HIP_MEMORY_SCOPE_AGENT); }
__device__ __forceinline__ unsigned xb_xcc_id() { return (unsigned)__builtin_amdgcn_s_getreg((3 << 11) | 20) & 0xFu; }
#define XB_SPIN(cond, bar) do { unsigned _sp = 0; while (cond) { __builtin_amdgcn_s_sleep(1); \
    if ((++_sp & 255u) == 0u) { if (xb_ld(&(bar)[XB_TMO])) break; if (_sp > XB_SPIN_CAP) { atomicAdd(&(bar)[XB_TMO], 1u); break; } } } } while (0)

struct XcdBarrier {
    unsigned* bar; unsigned x;
    volatile LAS unsigned* st;
};

__device__ __forceinline__ XcdBarrier xcd_barrier_post(unsigned* bar, volatile LAS unsigned* st) {
    XcdBarrier b; b.bar = bar; b.x = xb_xcc_id(); b.st = st;
    if (threadIdx.x == 0) (void)xb_add(&bar[XB_XCNT(b.x)], 1u);
    return b;
}
__device__ __forceinline__ void xcd_barrier_complete(unsigned* bar, unsigned x, unsigned& nloc, unsigned& nx) {
    const unsigned G = gridDim.x * gridDim.y * gridDim.z;
    unsigned sum, cnt, mine, sp = 0u;
    for (;;) {
        sum = 0u; cnt = 0u; mine = 0u;
#pragma unroll
        for (unsigned j = 0; j < 16; ++j) { const unsigned c = xb_ld(&bar[XB_XCNT(j)]); sum += c; cnt += (c > 0u) ? 1u : 0u; mine = (j == x) ? c : mine; }
        if (sum == G) break;
        __builtin_amdgcn_s_sleep(1);
        if ((++sp & 255u) == 0u) { if (xb_ld(&bar[XB_TMO])) break; if (sp > XB_SPIN_CAP) { atomicAdd(&bar[XB_TMO], 1u); break; } }
    }
    nloc = mine > 0u ? mine : 1u; nx = cnt > 0u ? cnt : 1u;
}

__device__ __forceinline__ void xcd_barrier(const XcdBarrier& b) {
    asm volatile("s_waitcnt vmcnt(0)" ::: "memory");
    __syncthreads();
    if (threadIdx.x == 0) {
        unsigned* bar = b.bar;
        __builtin_amdgcn_s_waitcnt(0);
        unsigned nloc = b.st[0], nx = b.st[1];
        if (nloc == 0u) { xcd_barrier_complete(bar, b.x, nloc, nx); b.st[0] = nloc; b.st[1] = nx; }
        const unsigned old = xb_add(&bar[XB_XSUB(b.x)], 1u);
        const unsigned gen = old / nloc;
        if (old + 1u == (gen + 1u) * nloc) {
            __builtin_amdgcn_fence(__ATOMIC_RELEASE, "agent");
            asm volatile("s_waitcnt vmcnt(0)" ::: "memory");
            const unsigned og = xb_add(&bar[XB_TOP], 1u);
            const unsigned tg = og / nx;
            if (og + 1u == (tg + 1u) * nx) xb_add(&bar[XB_TOPGEN], 1u);
            else XB_SPIN(xb_ld(&bar[XB_TOPGEN]) == tg, bar);
            __builtin_amdgcn_fence(__ATOMIC_ACQUIRE, "agent");
            xb_add(&bar[XB_XGEN(b.x)], 1u);
            asm volatile("s_waitcnt vmcnt(0)" ::: "memory");
        } else {
            XB_SPIN(xb_ld(&bar[XB_XGEN(b.x)]) == gen, bar);
            __builtin_amdgcn_fence(__ATOMIC_ACQUIRE, "agent");
            asm volatile("s_waitcnt vmcnt(0)" ::: "memory");
        }
    }
    __syncthreads();
}
__device__ __forceinline__ void prologue_body(int gw, int ngw, int lane, const float* __restrict__ x, const float* __restrict__ norm_w, const float* __restrict__ w_in,
                                              const float* __restrict__ w_out, bf16_t* H, float* IW, bf16_t* WinT, bf16_t* WoutT) {
    for (int m = gw; m < MT; m += ngw) {
        const f32x4_t* xr = (const f32x4_t*)(x + (size_t)m * DM) + lane;
        f32x4_t v[4]; float s = 0.f;
#pragma unroll
        for (int j = 0; j < 4; ++j) { v[j] = xr[64 * j]; s += (v[j].x * v[j].x + v[j].y * v[j].y) + (v[j].z * v[j].z + v[j].w * v[j].w); }
        const float rstd = 1.0f / sqrtf(wave_sum(s) * (1.0f / DM) + EPS);
        float a0 = 0.f, a1 = 0.f, a2 = 0.f, a3 = 0.f;
        u32x2_t* o8 = (u32x2_t*)(H + (size_t)m * DM) + lane;
#pragma unroll
        for (int j = 0; j < 4; ++j) {
            const f32x4_t w = ((const f32x4_t*)norm_w)[64 * j + lane];
            f32x4_t hv; hv.x = v[j].x * rstd * w.x; hv.y = v[j].y * rstd * w.y; hv.z = v[j].z * rstd * w.z; hv.w = v[j].w * rstd * w.w;
            const int d = 256 * j + 4 * lane;
            const f32x4_t w0 = *(const f32x4_t*)(w_in + (size_t)(d + 0) * D_IN + 4416), w1 = *(const f32x4_t*)(w_in + (size_t)(d + 1) * D_IN + 4416);
            const f32x4_t w2 = *(const f32x4_t*)(w_in + (size_t)(d + 2) * D_IN + 4416), w3 = *(const f32x4_t*)(w_in + (size_t)(d + 3) * D_IN + 4416);
            a0 += hv.x * w0.x + hv.y * w1.x + hv.z * w2.x + hv.w * w3.x;
            a1 += hv.x * w0.y + hv.y * w1.y + hv.z * w2.y + hv.w * w3.y;
            a2 += hv.x * w0.z + hv.y * w1.z + hv.z * w2.z + hv.w * w3.z;
            a3 += hv.x * w0.w + hv.y * w1.w + hv.z * w2.w + hv.w * w3.w;
            u32x2_t o; o.x = pk2(hv.x, hv.y); o.y = pk2(hv.z, hv.w); o8[64 * j] = o;
        }
        a0 = wave_sum(a0); a1 = wave_sum(a1); a2 = wave_sum(a2); a3 = wave_sum(a3);
        if (lane == 0) { f32x4_t o = {a0, a1, a2, a3}; *(f32x4_t*)(IW + (size_t)m * 4) = o; }
    }
    const long tid = (long)gw * 64 + lane, nth = (long)ngw * 64;
    for (long i = tid; i < (long)NPAD * (DM / 8); i += nth) {
        const int n = (int)(i % NPAD), k8 = (int)(i / NPAD);
        float e[8];
#pragma unroll
        for (int q = 0; q < 8; ++q) e[q] = (n < D_IN) ? w_in[(size_t)(k8 * 8 + q) * D_IN + n] : 0.f;
        u32x4_t o; o.x = pk2(e[0], e[1]); o.y = pk2(e[2], e[3]); o.z = pk2(e[4], e[5]); o.w = pk2(e[6], e[7]);
        *(u32x4_t*)(WinT + (size_t)n * DM + k8 * 8) = o;
    }
    for (long i = tid; i < (long)DM * (DM / 8); i += nth) {
        const int n = (int)(i % DM), k8 = (int)(i / DM);
        float e[8];
#pragma unroll
        for (int q = 0; q < 8; ++q) e[q] = w_out[(size_t)(k8 * 8 + q) * DM + n];
        u32x4_t o; o.x = pk2(e[0], e[1]); o.y = pk2(e[2], e[3]); o.z = pk2(e[4], e[5]); o.w = pk2(e[6], e[7]);
        *(u32x4_t*)(WoutT + (size_t)n * DM + k8 * 8) = o;
    }
}
__device__ __forceinline__ void final_norm_body(int gw, int ngw, int lane, float* out, const float* __restrict__ fw) {
    for (int m = gw; m < MT; m += ngw) {
        f32x4_t* xr = (f32x4_t*)(out + (size_t)m * DM) + lane;
        f32x4_t v[4]; float s = 0.f;
#pragma unroll
        for (int j = 0; j < 4; ++j) { v[j] = xr[64 * j]; s += (v[j].x * v[j].x + v[j].y * v[j].y) + (v[j].z * v[j].z + v[j].w * v[j].w); }
        const float rstd = 1.0f / sqrtf(wave_sum(s) * (1.0f / DM) + EPS);
#pragma unroll
        for (int j = 0; j < 4; ++j) { const f32x4_t w = ((const f32x4_t*)fw)[64 * j + lane]; f32x4_t o;
            o.x = v[j].x * rstd * w.x; o.y = v[j].y * rstd * w.y; o.z = v[j].z * rstd * w.z; o.w = v[j].w * rstd * w.w; xr[64 * j] = o; }
    }
}

#define WAVE_SYNC() asm volatile("s_waitcnt vmcnt(0) lgkmcnt(0)" ::: "memory")
__device__ __forceinline__ void sel_naive_one(int m, int lane, unsigned* skey, float* sq, unsigned char* ws) {
    const bf16_t* P = (const bf16_t*)(ws + WS_P); const float* IW = (const float*)(ws + WS_IW);
    float* THR = (float*)(ws + WS_THR); int* KCUT = (int*)(ws + WS_KCUT); int* SELCNT = (int*)(ws + WS_SELCNT); int* SEL = (int*)(ws + WS_SEL);
    const int b = m / SEQ, tpos = m % SEQ, N = ((tpos >> 6) + 1) << 6;
    int* sel = SEL + (size_t)m * 256;
    if (N <= 256) {
        for (int j = lane; j < N; j += 64) sel[j] = j;
        if (lane == 0) { THR[m] = -INFINITY; KCUT[m] = 0x7fffffff; SELCNT[m] = N; }
        return;
    }
    { const u32x2_t q = *(const u32x2_t*)(P + PL_IQ * PLANE + (size_t)m * 256 + lane * 4);
      sq[lane * 4 + 0] = bflo(q.x); sq[lane * 4 + 1] = bfhi(q.x); sq[lane * 4 + 2] = bflo(q.y); sq[lane * 4 + 3] = bfhi(q.y); }
    const f32x4_t iw = *(const f32x4_t*)(IW + (size_t)m * 4);
    const float wg0 = iw.x * IDX_SCALE, wg1 = iw.y * IDX_SCALE, wg2 = iw.z * IDX_SCALE, wg3 = iw.w * IDX_SCALE;
    WAVE_SYNC();
    for (int i = 0; i < N / 64; ++i) {
        asm volatile("" ::: "memory");
        const int s = i * 64 + lane; const bf16_t* kr = P + PL_IK * PLANE + (size_t)(b * SEQ + s) * 256;
        float l0 = 0.f, l1 = 0.f, l2 = 0.f, l3 = 0.f;
#pragma unroll
        for (int c = 0; c < 8; ++c) { const u32x4_t kv = *(const u32x4_t*)(kr + c * 8);
            const float k[8] = {bflo(kv.x), bfhi(kv.x), bflo(kv.y), bfhi(kv.y), bflo(kv.z), bfhi(kv.z), bflo(kv.w), bfhi(kv.w)};
#pragma unroll
            for (int e = 0; e < 8; ++e) { const int d = c * 8 + e; l0 += sq[d] * k[e]; l1 += sq[64 + d] * k[e]; l2 += sq[128 + d] * k[e]; l3 += sq[192 + d] * k[e]; } }
        float sc = wg0 * fmaxf(l0, 0.f) + wg1 * fmaxf(l1, 0.f) + wg2 * fmaxf(l2, 0.f) + wg3 * fmaxf(l3, 0.f);
        sc += 0.0f;
        skey[s] = f2key(sc);
    }
    WAVE_SYNC();
    unsigned prefix = 0u;
    for (int bit = 31; bit >= 0; --bit) { const unsigned cand = prefix | (1u << bit); int c = 0;
        for (int i = 0; i < N / 64; ++i) c += (skey[i * 64 + lane] >= cand) ? 1 : 0;
        c = wave_sum_i(c); if (c >= 256) prefix = cand; }
    int cgt = 0; for (int i = 0; i < N / 64; ++i) cgt += (skey[i * 64 + lane] > prefix) ? 1 : 0;
    cgt = wave_sum_i(cgt);
    const int r = 256 - cgt;
    int run = 0, kcut = 0x7fffffff;
    for (int i = 0; i < N / 64; ++i) { const unsigned long long bm = __ballot(skey[i * 64 + lane] == prefix); const int c = __popcll(bm);
        if (run + c >= r) { unsigned long long t = bm; for (int q = 0; q < r - run - 1; ++q) t &= t - 1; kcut = i * 64 + (int)__builtin_ctzll(t); break; }
        run += c; }
    int base = 0;
    for (int i = 0; i < N / 64; ++i) { const unsigned k = skey[i * 64 + lane]; const int idx = i * 64 + lane; const bool f = (k > prefix) || (k == prefix && idx <= kcut);
        const unsigned long long bm = __ballot(f); const int pos = base + __popcll(bm & ((1ull << lane) - 1ull)); if (f && pos < 256) sel[pos] = idx; base += __popcll(bm); }
    if (lane == 0) { THR[m] = key2f(prefix); KCUT[m] = kcut; SELCNT[m] = 256; }
    WAVE_SYNC();
}
__device__ __forceinline__ void dsa_naive_one(int m, int lane, float* sq, float* sc, int* ssel, unsigned char* ws, const float* __restrict__ rel_bias) {
    const bf16_t* P = (const bf16_t*)(ws + WS_P); const int* SELCNT = (const int*)(ws + WS_SELCNT); const int* SEL = (const int*)(ws + WS_SEL);
    bf16_t* AOBO = (bf16_t*)(ws + WS_AOBO);
    const int b = m / SEQ, tpos = m % SEQ; const int cnt = SELCNT[m];
    { const int hc = lane * 8; const u32x4_t q = *(const u32x4_t*)(P + (PL_BQ + (hc >> 8)) * PLANE + (size_t)m * 256 + (hc & 255));
      sq[hc + 0] = bflo(q.x); sq[hc + 1] = bfhi(q.x); sq[hc + 2] = bflo(q.y); sq[hc + 3] = bfhi(q.y); sq[hc + 4] = bflo(q.z); sq[hc + 5] = bfhi(q.z); sq[hc + 6] = bflo(q.w); sq[hc + 7] = bfhi(q.w); }
    for (int j = lane; j < 256; j += 64) ssel[j] = (j < cnt) ? SEL[(size_t)m * 256 + j] : 0;
    WAVE_SYNC();
    for (int jj = 0; jj < 4; ++jj) { const int j = jj * 64 + lane;
        if (j < cnt) { const int s = ssel[j]; const size_t ms = (size_t)(b * SEQ + s); const int bk = t5_bucket(s - tpos);
            for (int h = 0; h < 8; ++h) { const bf16_t* kr = P + (PL_BK + (h >> 2)) * PLANE + ms * 256 + (h & 3) * 64; float a = 0.f;
#pragma unroll
                for (int c = 0; c < 8; ++c) { const u32x4_t kv = *(const u32x4_t*)(kr + c * 8); const float* q = &sq[h * 64 + c * 8];
                    a += q[0] * bflo(kv.x) + q[1] * bfhi(kv.x) + q[2] * bflo(kv.y) + q[3] * bfhi(kv.y) + q[4] * bflo(kv.z) + q[5] * bfhi(kv.z) + q[6] * bflo(kv.w) + q[7] * bfhi(kv.w); }
                sc[h * 256 + j] = a + rel_bias[bk * 12 + 4 + h] * LOG2E; }
        } else { for (int h = 0; h < 8; ++h) sc[h * 256 + j] = -INFINITY; }
    }
    WAVE_SYNC();
    for (int h = 0; h < 8; ++h) { float v0 = sc[h * 256 + lane], v1 = sc[h * 256 + 64 + lane], v2 = sc[h * 256 + 128 + lane], v3 = sc[h * 256 + 192 + lane];
        const float mx = wave_max(fmaxf(fmaxf(v0, v1), fmaxf(v2, v3)));
        v0 = __builtin_amdgcn_exp2f(v0 - mx); v1 = __builtin_amdgcn_exp2f(v1 - mx); v2 = __builtin_amdgcn_exp2f(v2 - mx); v3 = __builtin_amdgcn_exp2f(v3 - mx);
        const float inv = 1.0f / wave_sum((v0 + v1) + (v2 + v3));
        sc[h * 256 + lane] = v0 * inv; sc[h * 256 + 64 + lane] = v1 * inv; sc[h * 256 + 128 + lane] = v2 * inv; sc[h * 256 + 192 + lane] = v3 * inv; }
    WAVE_SYNC();
    { const int hc = lane * 8, h = lane >> 3; float acc[8];
#pragma unroll
      for (int e = 0; e < 8; ++e) acc[e] = 0.f;
      for (int j = 0; j < cnt; ++j) { const float p = sc[h * 256 + j]; const int s = ssel[j];
          const u32x4_t vv = *(const u32x4_t*)(P + (PL_BV + (hc >> 8)) * PLANE + (size_t)(b * SEQ + s) * 256 + (hc & 255));
          acc[0] += p * bflo(vv.x); acc[1] += p * bfhi(vv.x); acc[2] += p * bflo(vv.y); acc[3] += p * bfhi(vv.y); acc[4] += p * bflo(vv.z); acc[5] += p * bfhi(vv.z); acc[6] += p * bflo(vv.w); acc[7] += p * bfhi(vv.w); }
      const u32x4_t g = *(const u32x4_t*)(P + (PL_BG + (hc >> 8)) * PLANE + (size_t)m * 256 + (hc & 255));
      u32x4_t o; o.x = pk2(acc[0] * bflo(g.x), acc[1] * bfhi(g.x)); o.y = pk2(acc[2] * bflo(g.y), acc[3] * bfhi(g.y)); o.z = pk2(acc[4] * bflo(g.z), acc[5] * bfhi(g.z)); o.w = pk2(acc[6] * bflo(g.w), acc[7] * bfhi(g.w));
      *(u32x4_t*)(AOBO + (size_t)m * DM + 512 + hc) = o; }
    WAVE_SYNC();
}
__device__ __forceinline__ float diff_lambda(int lane, const float* lq1, const float* lk1, const float* lq2, const float* lk2) {
    return expf(wave_sum(lq1[lane] * lk1[lane])) - expf(wave_sum(lq2[lane] * lk2[lane])) + LAMBDA_INIT; }
__device__ __forceinline__ void diff_naive_one(int m, int h, int lane, float* s1, float* s2, float* sq, float lam, unsigned char* ws, const float* __restrict__ rel_bias, const float* __restrict__ subln_w) {
    const bf16_t* P = (const bf16_t*)(ws + WS_P); bf16_t* AOBO = (bf16_t*)(ws + WS_AOBO);
    const int b = m / SEQ, tpos = m % SEQ, N = ((tpos >> 6) + 1) << 6;
    const int pq = h >> 1, co = (h & 1) * 128;
    { const unsigned q = *(const unsigned*)(P + (PL_AQ + pq) * PLANE + (size_t)m * 256 + co + lane * 2); sq[lane * 2] = bflo(q); sq[lane * 2 + 1] = bfhi(q); }
    WAVE_SYNC();
    float mx1 = -INFINITY, mx2 = -INFINITY;
    for (int i = 0; i < N / 64; ++i) { asm volatile("" ::: "memory"); const int s = i * 64 + lane; const bf16_t* kr = P + (PL_AK + pq) * PLANE + (size_t)(b * SEQ + s) * 256 + co;
        float d1 = 0.f, d2 = 0.f;
#pragma unroll
        for (int c = 0; c < 8; ++c) { const u32x4_t kv = *(const u32x4_t*)(kr + c * 8); const float* q = &sq[c * 8];
            d1 += q[0] * bflo(kv.x) + q[1] * bfhi(kv.x) + q[2] * bflo(kv.y) + q[3] * bfhi(kv.y) + q[4] * bflo(kv.z) + q[5] * bfhi(kv.z) + q[6] * bflo(kv.w) + q[7] * bfhi(kv.w); }
#pragma unroll
        for (int c = 0; c < 8; ++c) { const u32x4_t kv = *(const u32x4_t*)(kr + 64 + c * 8); const float* q = &sq[64 + c * 8];
            d2 += q[0] * bflo(kv.x) + q[1] * bfhi(kv.x) + q[2] * bflo(kv.y) + q[3] * bfhi(kv.y) + q[4] * bflo(kv.z) + q[5] * bfhi(kv.z) + q[6] * bflo(kv.w) + q[7] * bfhi(kv.w); }
        const float bias = rel_bias[t5_bucket(s - tpos) * 12 + h] * LOG2E;
        d1 += bias; d2 += bias; s1[s] = d1; s2[s] = d2; mx1 = fmaxf(mx1, d1); mx2 = fmaxf(mx2, d2); }
    mx1 = wave_max(mx1); mx2 = wave_max(mx2);
    float l1 = 0.f, l2 = 0.f;
    for (int i = 0; i < N / 64; ++i) { const int s = i * 64 + lane; const float p1 = __builtin_amdgcn_exp2f(s1[s] - mx1), p2 = __builtin_amdgcn_exp2f(s2[s] - mx2); s1[s] = p1; s2[s] = p2; l1 += p1; l2 += p2; }
    l1 = wave_sum(l1); l2 = wave_sum(l2);
    const float i1 = 1.0f / l1, i2 = lam / l2;
    for (int i = 0; i < N / 64; ++i) { const int s = i * 64 + lane; s1[s] = s1[s] * i1 - s2[s] * i2; }
    WAVE_SYNC();
    float a0 = 0.f, a1 = 0.f;
    const bf16_t* vb = P + (PL_AV + pq) * PLANE + (size_t)(b * SEQ) * 256 + co + lane * 2;
    for (int s = 0; s < N; ++s) { const float wv = s1[s]; const unsigned vv = *(const unsigned*)(vb + (size_t)s * 256); a0 += wv * bflo(vv); a1 += wv * bfhi(vv); }
    const float rstd = 1.0f / sqrtf(wave_sum(a0 * a0 + a1 * a1) * (1.0f / 128.0f) + EPS);
    const unsigned g = *(const unsigned*)(P + (PL_AG + pq) * PLANE + (size_t)m * 256 + co + lane * 2);
    const float o0 = a0 * rstd * subln_w[lane * 2] * ONE_M_LAMBDA * bflo(g), o1 = a1 * rstd * subln_w[lane * 2 + 1] * ONE_M_LAMBDA * bfhi(g);
    *(unsigned*)(AOBO + (size_t)m * DM + h * 128 + lane * 2) = pk2(o0, o1);
    WAVE_SYNC();
}
constexpr int LDS_MAIN = 139264;
constexpr int MISC_OFF = LDS_MAIN, LDS_BYTES = LDS_MAIN + 64;
constexpr size_t BAR_BYTES = (size_t)XCD_BAR_WORDS * 4;
struct Args { const float* in[11]; float* out; unsigned char* ws; };

__global__ void __launch_bounds__(512, 2) fwd(Args a) {
    extern __shared__ __attribute__((aligned(16))) unsigned char lds[];
    const int tid = threadIdx.x, lane = tid & 63, wave = __builtin_amdgcn_readfirstlane(tid >> 6);
    volatile LAS unsigned* misc = (volatile LAS unsigned*)((LAS unsigned char*)lds + MISC_OFF);
    if (tid < 16) misc[tid] = 0u;
    __syncthreads();
    XcdBarrier bar = xcd_barrier_post((unsigned*)a.ws, misc);
    const int G = gridDim.x, gw = blockIdx.x * 8 + wave, ngw = G * 8;
    unsigned char* ws = a.ws;
    const float* x = a.in[0]; const float* rel_bias = a.in[9];
    prologue_body(gw, ngw, lane, x, a.in[1], a.in[2], a.in[3], (bf16_t*)(ws + WS_H), (float*)(ws + WS_IW), (bf16_t*)(ws + WS_WINT), (bf16_t*)(ws + WS_WOUTT));
    xcd_barrier(bar);
    { pg8::Gemm g{(const bf16_t*)(ws + WS_H), (const bf16_t*)(ws + WS_WINT), MT, NPAD, DM}; pg8::StaticOrder S; S.init(MT, NPAD, G, (int)blockIdx.x);
      pg8::EpiProj E{(bf16_t*)(ws + WS_P)};
      pg8::gemm_phase<pg8::EpiProj, pg8::StaticOrder, true, true>((PG8_LAS unsigned char*)lds, g, S, E); }
    xcd_barrier(bar);
    { unsigned* skey = (unsigned*)(lds + wave * 17408); float* sq = (float*)(lds + wave * 17408 + 16384);
      for (int m = gw; m < MT; m += ngw) sel_naive_one(m, lane, skey, sq, ws); }
    xcd_barrier(bar);
    { float* sq = (float*)(lds + wave * 11264); float* sc = sq + 512; int* ssel = (int*)(sc + 2048);
      for (int m = gw; m < MT; m += ngw) dsa_naive_one(m, lane, sq, sc, ssel, ws, rel_bias); }
    __syncthreads();
    if (wave < 4) { float* s1 = (float*)(lds + wave * 33280); float* s2 = s1 + 4096; float* sq = s2 + 4096;
      const float lam = diff_lambda(lane, a.in[4], a.in[5], a.in[6], a.in[7]);
      for (int it = blockIdx.x * 4 + wave; it < MT * 4; it += G * 4) diff_naive_one(it >> 2, it & 3, lane, s1, s2, sq, lam, ws, rel_bias, a.in[8]); }
    xcd_barrier(bar);
    { pg8::Gemm g{(const bf16_t*)(ws + WS_AOBO), (const bf16_t*)(ws + WS_WOUTT), MT, DM, DM}; pg8::StaticOrder S; S.init(MT, DM, G, (int)blockIdx.x);
      pg8::EpiOut E{x, a.out};
      pg8::gemm_phase<pg8::EpiOut, pg8::StaticOrder, true, true>((PG8_LAS unsigned char*)lds, g, S, E); }
    xcd_barrier(bar);
    final_norm_body(gw, ngw, lane, a.out, a.in[10]);
}

extern "C" void kernel_launch(void* const* d_in, const int* in_sizes, int n_in, void* d_out, int out_size, void* d_ws, size_t ws_size, hipStream_t stream) {
    static int grid = 0;
    if (grid == 0) {
        if (n_in != 11 || out_size != MT * DM || ws_size < WS_END) { fprintf(stderr, "kernel_launch: unexpected shapes (n_in %d out %d ws %zu need %zu)\n", n_in, out_size, ws_size, (size_t)WS_END); grid = -1; return; }
        int dev = 0, cus = 0, per_cu = 0;
        if (hipGetDevice(&dev) != hipSuccess || hipDeviceGetAttribute(&cus, hipDeviceAttributeMultiprocessorCount, dev) != hipSuccess) { grid = -1; return; }
        if (hipFuncSetAttribute((const void*)fwd, hipFuncAttributeMaxDynamicSharedMemorySize, LDS_BYTES) != hipSuccess) { fprintf(stderr, "kernel_launch: hipFuncSetAttribute failed\n"); grid = -1; return; }
        if (hipOccupancyMaxActiveBlocksPerMultiprocessor(&per_cu, (const void*)fwd, 512, LDS_BYTES) != hipSuccess || per_cu < 1) { fprintf(stderr, "kernel_launch: occupancy query says %d blocks per CU\n", per_cu); (void)hipGetLastError(); }
        grid = cus;
    }
    if (grid < 0) return;
    if (hipMemsetAsync(d_ws, 0, BAR_BYTES, stream) != hipSuccess) { fprintf(stderr, "kernel_launch: memset failed\n"); return; }
    Args a; memset(&a, 0, sizeof(a));
    for (int i = 0; i < 11; ++i) a.in[i] = (const float*)d_in[i];
    a.out = (float*)d_out; a.ws = (unsigned char*)d_ws;
    hipLaunchKernelGGL(fwd, dim3(grid), dim3(512), LDS_BYTES, stream, a);
}
```

```cpp
#include <hip/hip_runtime.h>
#include <cstdio>
#include <cstdint>
#include <cstring>
#include <cmath>
#define LAS __attribute__((address_space(3)))
typedef unsigned short bf16_t;
typedef unsigned u32x4_t __attribute__((ext_vector_type(4)));
typedef unsigned u32x2_t __attribute__((ext_vector_type(2)));
typedef float f32x4_t __attribute__((ext_vector_type(4)));

constexpr int DM = 1024, NBATCH = 8, SEQ = 4096, MT = NBATCH * SEQ;
constexpr int D_IN = 4420, NPAD = 4608, NPLANES = 18;
constexpr float EPS = 1e-6f, LOG2E = 1.4426950408889634f;
constexpr float C2 = 0.125f * LOG2E;
constexpr float IDX_SCALE = 0.0625f;
constexpr float LAMBDA_INIT = 0.2f, ONE_M_LAMBDA = 0.8f;
constexpr size_t PLANE = (size_t)MT * 256;
constexpr int PL_AQ = 0, PL_AK = 2, PL_AV = 4, PL_AG = 6, PL_BQ = 8, PL_BK = 10, PL_BV = 12, PL_BG = 14, PL_IQ = 16, PL_IK = 17;

constexpr size_t WS_CTL = 0;
constexpr size_t WS_WINT = 65536;
constexpr size_t WS_WOUTT = WS_WINT + (size_t)NPAD * DM * 2;
constexpr size_t WS_H = WS_WOUTT + (size_t)DM * DM * 2;
constexpr size_t WS_P = WS_H + (size_t)MT * DM * 2;
constexpr size_t WS_IW = WS_P + (size_t)NPLANES * PLANE * 2;
constexpr size_t WS_THR = WS_IW + (size_t)MT * 16;
constexpr size_t WS_KCUT = WS_THR + (size_t)MT * 4;
constexpr size_t WS_SELCNT = WS_KCUT + (size_t)MT * 4;
constexpr size_t WS_AOBO = WS_SELCNT + (size_t)MT * 4;
constexpr size_t WS_SEL = WS_AOBO + (size_t)MT * DM * 2;
constexpr size_t WS_END = WS_SEL + (size_t)MT * 256 * 4;

__device__ __forceinline__ float bf2f(bf16_t v) { return __uint_as_float(((unsigned)v) << 16); }
__device__ __forceinline__ float bflo(unsigned w) { return __uint_as_float(w << 16); }
__device__ __forceinline__ float bfhi(unsigned w) { return __uint_as_float(w & 0xffff0000u); }
__device__ __forceinline__ unsigned pk2(float lo, float hi) {
    typedef float f2 __attribute__((ext_vector_type(2))); typedef __bf16 b2 __attribute__((ext_vector_type(2)));
    f2 v = {lo, hi}; b2 b = __builtin_convertvector(v, b2); return __builtin_bit_cast(unsigned, b); }
__device__ __forceinline__ float wave_sum(float v) {
#pragma unroll
    for (int o = 1; o < 64; o <<= 1) v += __shfl_xor(v, o);
    return v; }
__device__ __forceinline__ int wave_sum_i(int v) {
#pragma unroll
    for (int o = 1; o < 64; o <<= 1) v += __shfl_xor(v, o);
    return v; }
__device__ __forceinline__ float wave_max(float v) {
#pragma unroll
    for (int o = 1; o < 64; o <<= 1) v = fmaxf(v, __shfl_xor(v, o));
    return v; }
__device__ __forceinline__ int t5_bucket(int rel) {
    const int ret = rel > 0 ? 16 : 0; const int n = rel < 0 ? -rel : rel;
    if (n < 8) return ret + n;
    int large = 2 + (31 - __builtin_clz((unsigned)(n * n))); large = large > 15 ? 15 : large;
    return ret + large; }
__device__ __forceinline__ unsigned f2key(float f) { const unsigned u = __float_as_uint(f); return (u & 0x80000000u) ? ~u : (u | 0x80000000u); }
__device__ __forceinline__ float key2f(unsigned k) { return __uint_as_float((k & 0x80000000u) ? (k ^ 0x80000000u) : ~k); }
__device__ __forceinline__ float silu_f(float v) { return v * __builtin_amdgcn_rcpf(1.0f + __builtin_amdgcn_exp2f(-v * LOG2E)); }
namespace pg8 {
#define PG8_LAS __attribute__((address_space(3)))
typedef unsigned short bf16_t;
typedef short bf16x8 __attribute__((ext_vector_type(8)));
typedef float f32x4 __attribute__((ext_vector_type(4)));
typedef unsigned u32x4 __attribute__((ext_vector_type(4)));
constexpr int BM = 256, BK = 64, HALF = 128, HTB = HALF * BK * 2  , STAGE_BYTES = 8 * HTB, NXCD = 8, WGM = 8;

__host__ __device__ __forceinline__ int lds_byte(int r, int c) { const int st = (r >> 4) * 2 + (c >> 5), rr = r & 15, cc = c & 31, ob = rr * 64 + cc * 2; return st * 1024 + (ob ^ (((ob >> 9) & 1) << 5)); }
__host__ __device__ __forceinline__ void stage_rc(int b, int& R, int& C) { const int st = b / 1024, sb = b % 1024, swz = sb ^ (((sb >> 9) & 1) << 5); R = (st >> 1) * 16 + swz / 64; C = (st & 1) * 32 + (swz % 64) / 2; }
__host__ __device__ __forceinline__ int perm32(int rho) { const int n = rho >> 4, i = rho & 15; return 8 * (i >> 2) + 4 * n + (i & 3); }

struct Unit { int pm, pn; };
struct Gemm { const bf16_t* A; const bf16_t* Bt; int M, N, K; };

struct StaticOrder {
    int nM, nN, nwg, G, c;
    __host__ __device__ void init(int M, int N, int G_, int c_) { nM = M / BM; nN = N / BM; nwg = nM * nN; G = G_; c = c_; }
    __host__ __device__ bool next(int i, Unit& u) const {
        const long L = (long)i * G + c; if (L >= nwg) return false;
        int wgid = (int)L; { const int q = nwg / NXCD, r = nwg % NXCD, xcd = wgid % NXCD, off = wgid / NXCD; wgid = (xcd < r ? xcd * (q + 1) : r * (q + 1) + (xcd - r) * q) + off; }
        const int nig = WGM * nN, gid = wgid / nig, fm = gid * WGM, gsz = (nM - fm) < WGM ? (nM - fm) : WGM;
        u.pm = fm + ((wgid % nig) % gsz); u.pn = (wgid % nig) / gsz; return true;
    }
    __device__ __forceinline__ void a_ready(const Unit&) const {}
    __device__ __forceinline__ void done(const Unit&) const {}
};

__device__ __forceinline__ unsigned cvt_pk_bf16(float lo, float hi) { unsigned r; asm volatile("v_cvt_pk_bf16_f32 %0, %1, %2" : "=v"(r) : "v"(lo), "v"(hi)); return r; }
template <class Epi, class Sched, bool ALIGN_EPI = false, bool SP2 = false>
__device__ __forceinline__ void gemm_phase(PG8_LAS unsigned char* lds, const Gemm g, const Sched& S, const Epi& E) {
    const int tid = threadIdx.x, wid = __builtin_amdgcn_readfirstlane(tid >> 6), lane = tid & 63, wr = wid >> 2, wc = wid & 3, fr = lane & 15, fq = lane >> 4;
    const int K = g.K, nt = K / BK;
    unsigned voffA[2], voffB[2];
#pragma unroll
    for (int i = 0; i < 2; ++i) { int R, C; stage_rc(tid * 16 + i * 8192, R, C); const int Rb = Epi::PERM ? ((R & ~31) + perm32(R & 31)) : R;
        voffA[i] = (unsigned)(R * K + C) * 2u; voffB[i] = (unsigned)(Rb * K + C) * 2u; }
    const size_t kstep = (size_t)(BK * 2);
    const size_t hstep = (size_t)HALF * K * 2;
    const size_t tstep = 2 * hstep;
    const unsigned ldsw = (unsigned)wid * 1024u;
    const int aoff = lds_byte(wr * 64 + fr, fq * 8), boff = lds_byte(wc * 32 + fr, fq * 8);
#define PG8_SA(b, h) (((b) * 2 + (h)) * HTB)
#define PG8_SB(b, h) ((4 + (b) * 2 + (h)) * HTB)
#define PG8_STAGE(bufoff, gbase, voff) do { _Pragma("unroll") for (int _i = 0; _i < 2; ++_i) \
        __builtin_amdgcn_global_load_lds((const unsigned*)((const char*)(gbase) + (voff)[_i]), (PG8_LAS unsigned*)(lds + (bufoff) + ldsw + _i * 8192), 16, 0, 0); } while (0)
#define PG8_LDA(dst, b, h) do { _Pragma("unroll") for (int m = 0; m < 4; ++m) _Pragma("unroll") for (int k = 0; k < 2; ++k) dst[m][k] = *(const PG8_LAS bf16x8*)(lds + PG8_SA(b, h) + aoff + m * 2048 + k * 1024); } while (0)
#define PG8_LDB(dst, b, h) do { _Pragma("unroll") for (int n = 0; n < 2; ++n) _Pragma("unroll") for (int k = 0; k < 2; ++k) dst[n][k] = *(const PG8_LAS bf16x8*)(lds + PG8_SB(b, h) + boff + n * 2048 + k * 1024); } while (0)
#define PG8_MMA(ai, bj, At, Bt) do { __builtin_amdgcn_s_setprio(1); _Pragma("unroll") for (int m = 0; m < 4; ++m) _Pragma("unroll") for (int n = 0; n < 2; ++n) _Pragma("unroll") for (int k = 0; k < 2; ++k) \
        acc[ai][bj][m][n] = __builtin_amdgcn_mfma_f32_16x16x32_bf16(Bt[n][k], At[m][k], acc[ai][bj][m][n], 0, 0, 0); __builtin_amdgcn_s_setprio(0); } while (0)
#define PG8_WAIT_V(n) asm volatile("s_waitcnt vmcnt(" #n ")" ::: "memory")
#define PG8_WAIT_L(n) asm volatile("s_waitcnt lgkmcnt(" #n ")" ::: "memory")
#define PG8_BAR __builtin_amdgcn_s_barrier()
#define PG8_SCHED __builtin_amdgcn_sched_barrier(0)
    Unit cur, nxt; int ui = 0;
    if (!S.next(0, cur)) return;
    f32x4 acc[2][2][4][2];
#pragma unroll
    for (int a = 0; a < 2; ++a)
#pragma unroll
        for (int b = 0; b < 2; ++b)
#pragma unroll
            for (int m = 0; m < 4; ++m)
#pragma unroll
                for (int n = 0; n < 2; ++n) acc[a][b][m][n] = (f32x4){0.f, 0.f, 0.f, 0.f};
    bf16x8 At[4][2], B0[2][2], B1[2][2];
    const char* cA = (const char*)g.A + (size_t)cur.pm * tstep; const char* cB = (const char*)g.Bt + (size_t)cur.pn * tstep;
    S.a_ready(cur);
    if constexpr (SP2) {
        PG8_STAGE(PG8_SB(0, 0), cB, voffB); PG8_STAGE(PG8_SB(0, 1), cB + hstep, voffB); PG8_STAGE(PG8_SA(0, 0), cA, voffA); PG8_STAGE(PG8_SA(0, 1), cA + hstep, voffA);
        if (wr == 1) PG8_BAR;
        PG8_WAIT_V(2); PG8_BAR;
        PG8_STAGE(PG8_SB(1, 0), cB + kstep, voffB); PG8_STAGE(PG8_SA(1, 0), cA + kstep, voffA); PG8_STAGE(PG8_SB(1, 1), cB + hstep + kstep, voffB);
        PG8_WAIT_V(6); PG8_BAR;
    } else {
        PG8_STAGE(PG8_SB(0, 0), cB, voffB); PG8_STAGE(PG8_SA(0, 0), cA, voffA); PG8_STAGE(PG8_SB(0, 1), cB + hstep, voffB); PG8_STAGE(PG8_SA(0, 1), cA + hstep, voffA);
        if (wr == 1) PG8_BAR;
        PG8_WAIT_V(4); PG8_BAR;
        PG8_STAGE(PG8_SB(1, 0), cB + kstep, voffB); PG8_STAGE(PG8_SA(1, 0), cA + kstep, voffA); PG8_STAGE(PG8_SB(1, 1), cB + hstep + kstep, voffB);
        PG8_WAIT_V(6); PG8_BAR;
    }
    for (;;) {
        const bool has_next = S.next(ui + 1, nxt);
        const char* nA = has_next ? (const char*)g.A + (size_t)nxt.pm * tstep : cA; const char* nB = has_next ? (const char*)g.Bt + (size_t)nxt.pn * tstep : cB;
        for (int t = 0; t < nt; t += 2) {
            const bool last = (t == nt - 2);
            const char* a1 = cA + (size_t)(t + 1) * kstep;
            const char* a2 = last ? nA : cA + (size_t)(t + 2) * kstep; const char* b2 = last ? nB : cB + (size_t)(t + 2) * kstep;
            const char* a3 = a2 + kstep; const char* b3 = b2 + kstep;
            if (last && has_next) S.a_ready(nxt);
            if constexpr (SP2) {
            PG8_LDB(B0, 0, 0); PG8_LDB(B1, 0, 1); PG8_SCHED; PG8_LDA(At, 0, 0); PG8_STAGE(PG8_SA(1, 1), a1 + hstep, voffA);
            PG8_WAIT_V(8); PG8_WAIT_L(0); PG8_BAR; PG8_MMA(0, 0, At, B0); PG8_MMA(0, 1, At, B1); PG8_BAR; PG8_SCHED;
            PG8_LDA(At, 0, 1); PG8_STAGE(PG8_SB(0, 0), b2, voffB); PG8_STAGE(PG8_SB(0, 1), b2 + hstep, voffB); PG8_STAGE(PG8_SA(0, 0), a2, voffA);
            PG8_WAIT_V(8); PG8_WAIT_L(0); PG8_BAR; PG8_MMA(1, 0, At, B0); PG8_MMA(1, 1, At, B1); PG8_BAR; PG8_SCHED;
            PG8_LDB(B0, 1, 0); PG8_LDB(B1, 1, 1); PG8_SCHED; PG8_LDA(At, 1, 0); PG8_STAGE(PG8_SA(0, 1), a2 + hstep, voffA);
            PG8_WAIT_V(8); PG8_WAIT_L(0); PG8_BAR; PG8_MMA(0, 0, At, B0); PG8_MMA(0, 1, At, B1); PG8_BAR; PG8_SCHED;
            PG8_LDA(At, 1, 1); PG8_STAGE(PG8_SB(1, 0), b3, voffB); PG8_STAGE(PG8_SB(1, 1), b3 + hstep, voffB); PG8_STAGE(PG8_SA(1, 0), a3, voffA);
            PG8_WAIT_V(8); PG8_WAIT_L(0); PG8_BAR; PG8_MMA(1, 0, At, B0); PG8_MMA(1, 1, At, B1); PG8_BAR; PG8_SCHED;
            } else {
            PG8_LDB(B0, 0, 0); PG8_SCHED; PG8_LDA(At, 0, 0); PG8_STAGE(PG8_SA(1, 1), a1 + hstep, voffA);
            PG8_WAIT_L(8); PG8_BAR; PG8_WAIT_L(0); PG8_MMA(0, 0, At, B0); PG8_BAR; PG8_SCHED;
            PG8_LDB(B1, 0, 1); PG8_STAGE(PG8_SB(0, 0), b2, voffB);
            PG8_BAR; PG8_WAIT_L(0); PG8_MMA(0, 1, At, B1); PG8_BAR;
            PG8_LDA(At, 0, 1); PG8_STAGE(PG8_SA(0, 0), a2, voffA);
            PG8_BAR; PG8_WAIT_L(0); PG8_MMA(1, 0, At, B0); PG8_BAR; PG8_SCHED;
            PG8_STAGE(PG8_SB(0, 1), b2 + hstep, voffB);
            PG8_WAIT_V(6); PG8_BAR; PG8_MMA(1, 1, At, B1); PG8_BAR;
            PG8_LDB(B0, 1, 0); PG8_SCHED; PG8_LDA(At, 1, 0); PG8_STAGE(PG8_SA(0, 1), a2 + hstep, voffA);
            PG8_WAIT_L(8); PG8_BAR; PG8_WAIT_L(0); PG8_MMA(0, 0, At, B0); PG8_BAR; PG8_SCHED;
            PG8_LDB(B1, 1, 1); PG8_STAGE(PG8_SB(1, 0), b3, voffB);
            PG8_BAR; PG8_WAIT_L(0); PG8_MMA(0, 1, At, B1); PG8_BAR;
            PG8_LDA(At, 1, 1); PG8_STAGE(PG8_SA(1, 0), a3, voffA);
            PG8_BAR; PG8_WAIT_L(0); PG8_MMA(1, 0, At, B0); PG8_BAR; PG8_SCHED;
            PG8_STAGE(PG8_SB(1, 1), b3 + hstep, voffB);
            PG8_WAIT_V(6); PG8_BAR; PG8_MMA(1, 1, At, B1); PG8_BAR;
            }
        }
        if constexpr (ALIGN_EPI) { if (wr == 0) PG8_BAR; }
        if constexpr (!Epi::AFTER_DRAIN) { E(acc, cur, wr, wc, fr, fq); S.done(cur); }
        if (!has_next) break;
#pragma unroll
        for (int a = 0; a < 2; ++a)
#pragma unroll
            for (int b = 0; b < 2; ++b)
#pragma unroll
                for (int m = 0; m < 4; ++m)
#pragma unroll
                    for (int n = 0; n < 2; ++n) acc[a][b][m][n] = (f32x4){0.f, 0.f, 0.f, 0.f};
        cur = nxt; cA = nA; cB = nB; ++ui;
        if constexpr (ALIGN_EPI) { if (wr == 1) PG8_BAR; }
    }
    PG8_WAIT_V(0);
    if constexpr (!ALIGN_EPI) { if (wr == 0) PG8_BAR; }
    PG8_BAR;
    if constexpr (Epi::AFTER_DRAIN) { E.fused(acc, cur, wr, wc, fr, fq, lds, wid, lane); S.done(cur); }
#undef PG8_SA
#undef PG8_SB
#undef PG8_STAGE
#undef PG8_LDA
#undef PG8_LDB
#undef PG8_MMA
#undef PG8_WAIT_V
#undef PG8_WAIT_L
#undef PG8_BAR
#undef PG8_SCHED
}
}
namespace pg8 {
struct EpiProj {
    static constexpr bool PERM = true, AFTER_DRAIN = false;
    bf16_t* P;
    __device__ __forceinline__ void operator()(const f32x4 (&acc)[2][2][4][2], const Unit& u, int wr, int wc, int fr, int fq) const {
        const int row0 = u.pm * BM + wr * 64 + fr, col0 = wc * 32 + 8 * fq, pl = u.pn;
        bf16_t* base = P + (size_t)pl * ((size_t)MT * 256);
        const int mode = (pl < 2 || pl == 8 || pl == 9) ? 1 : ((pl == 6 || pl == 7 || pl == 14 || pl == 15) ? 2 : 0);
#pragma unroll
        for (int ai = 0; ai < 2; ++ai)
#pragma unroll
            for (int m = 0; m < 4; ++m) { bf16_t* rowp = base + (size_t)(row0 + ai * HALF + m * 16) * 256 + col0;
#pragma unroll
                for (int bj = 0; bj < 2; ++bj) { f32x4 v0 = acc[ai][bj][m][0], v1 = acc[ai][bj][m][1];
                    if (mode == 1) { v0 = v0 * C2; v1 = v1 * C2; }
                    if (mode == 2) {
#pragma unroll
                        for (int j = 0; j < 4; ++j) { v0[j] = silu_f(v0[j]); v1[j] = silu_f(v1[j]); } }
                    u32x4 w; w.x = cvt_pk_bf16(v0[0], v0[1]); w.y = cvt_pk_bf16(v0[2], v0[3]); w.z = cvt_pk_bf16(v1[0], v1[1]); w.w = cvt_pk_bf16(v1[2], v1[3]);
                    *(u32x4*)(rowp + bj * HALF) = w; } }
    }
};
struct EpiOut {
    static constexpr bool PERM = false, AFTER_DRAIN = false;
    const float* X; float* O;
    __device__ __forceinline__ void operator()(const f32x4 (&acc)[2][2][4][2], const Unit& u, int wr, int wc, int fr, int fq) const {
        const int row0 = u.pm * BM + wr * 64 + fr, col0 = u.pn * BM + wc * 32 + 4 * fq;
#pragma unroll
        for (int ai = 0; ai < 2; ++ai)
#pragma unroll
            for (int m = 0; m < 4; ++m) { const size_t off = (size_t)(row0 + ai * HALF + m * 16) * DM + col0;
#pragma unroll
                for (int bj = 0; bj < 2; ++bj)
#pragma unroll
                    for (int n = 0; n < 2; ++n) { const f32x4 xv = *(const f32x4*)(X + off + bj * HALF + n * 16); *(f32x4*)(O + off + bj * HALF + n * 16) = xv + acc[ai][bj][m][n]; } }
    }
};
}
#include <cstdlib>
#include <vector>

#define XB_TMO      128
#define XB_XCNT(j)  (256  + 64 * (j))
#define XB_XSUB(j)  (1280 + 64 * (j))
#define XB_XGEN(j)  (2304 + 64 * (j))
#define XB_TOP      3328
#define XB_TOPGEN   3392
#define XCD_BAR_WORDS 3456
#define XB_SPIN_CAP (1u << 18)
#define LAS __attribute__((address_space(3)))

__device__ __forceinline__ unsigned xb_ld(unsigned* p)              { return __hip_atomic_load(p, __ATOMIC_RELAXED, __HIP_MEMORY_SCOPE_AGENT); }
__device__ __forceinline__ unsigned xb_add(unsigned* p, unsigned v) { return __hip_atomic_fetch_add(p, v, __ATOMIC_RELAXED, __HIP_MEMORY_SCOPE_AGENT); }
__device__ __forceinline__ unsigned xb_xcc_id() { return (unsigned)__builtin_amdgcn_s_getreg((3 << 11) | 20) & 0xFu; }
#define XB_SPIN(cond, bar) do { unsigned _sp = 0; while (cond) { __builtin_amdgcn_s_sleep(1); \
    if ((++_sp & 255u) == 0u) { if (xb_ld(&(bar)[XB_TMO])) break; if (_sp > XB_SPIN_CAP) { atomicAdd(&(bar)[XB_TMO], 1u); break; } } } } while (0)

struct XcdBarrier {
    unsigned* bar; unsigned x;
    volatile LAS unsigned* st;
};

__device__ __forceinline__ XcdBarrier xcd_barrier_post(unsigned* bar, volatile LAS unsigned* st) {
    XcdBarrier b; b.bar = bar; b.x = xb_xcc_id(); b.st = st;
    if (threadIdx.x == 0) (void)xb_add(&bar[XB_XCNT(b.x)], 1u);
    return b;
}
__device__ __forceinline__ void xcd_barrier_complete(unsigned* bar, unsigned x, unsigned& nloc, unsigned& nx) {
    const unsigned G = gridDim.x * gridDim.y * gridDim.z;
    unsigned sum, cnt, mine, sp = 0u;
    for (;;) {
        sum = 0u; cnt = 0u; mine = 0u;
#pragma unroll
        for (unsigned j = 0; j < 16; ++j) { const unsigned c = xb_ld(&bar[XB_XCNT(j)]); sum += c; cnt += (c > 0u) ? 1u : 0u; mine = (j == x) ? c : mine; }
        if (sum == G) break;
        __builtin_amdgcn_s_sleep(1);
        if ((++sp & 255u) == 0u) { if (xb_ld(&bar[XB_TMO])) break; if (sp > XB_SPIN_CAP) { atomicAdd(&bar[XB_TMO], 1u); break; } }
    }
    nloc = mine > 0u ? mine : 1u; nx = cnt > 0u ? cnt : 1u;
}

__device__ __forceinline__ void xcd_barrier(const XcdBarrier& b) {
    asm volatile("s_waitcnt vmcnt(0)" ::: "memory");
    __syncthreads();
    if (threadIdx.x == 0) {
        unsigned* bar = b.bar;
        __builtin_amdgcn_s_waitcnt(0);
        unsigned nloc = b.st[0], nx = b.st[1];
        if (nloc == 0u) { xcd_barrier_complete(bar, b.x, nloc, nx); b.st[0] = nloc; b.st[1] = nx; }
        const unsigned old = xb_add(&bar[XB_XSUB(b.x)], 1u);
        const unsigned gen = old / nloc;
        if (old + 1u == (gen + 1u) * nloc) {
            __builtin_amdgcn_fence(__ATOMIC_RELEASE, "agent");
            asm volatile("s_waitcnt vmcnt(0)" ::: "memory");
            const unsigned og = xb_add(&bar[XB_TOP], 1u);
            const unsigned tg = og / nx;
            if (og + 1u == (tg + 1u) * nx) xb_add(&bar[XB_TOPGEN], 1u);
            else XB_SPIN(xb_ld(&bar[XB_TOPGEN]) == tg, bar);
            __builtin_amdgcn_fence(__ATOMIC_ACQUIRE, "agent");
            xb_add(&bar[XB_XGEN(b.x)], 1u);
            asm volatile("s_waitcnt vmcnt(0)" ::: "memory");
        } else {
            XB_SPIN(xb_ld(&bar[XB_XGEN(b.x)]) == gen, bar);
            __builtin_amdgcn_fence(__ATOMIC_ACQUIRE, "agent");
            asm volatile("s_waitcnt vmcnt(0)" ::: "memory");
        }
    }
    __syncthreads();
}
__device__ __forceinline__ void prologue_body(int gw, int ngw, int lane, const float* __restrict__ x, const float* __restrict__ norm_w, const float* __restrict__ w_in,
                                              const float* __restrict__ w_out, bf16_t* H, float* IW, bf16_t* WinT, bf16_t* WoutT) {
    for (int m = gw; m < MT; m += ngw) {
        const f32x4_t* xr = (const f32x4_t*)(x + (size_t)m * DM) + lane;
        f32x4_t v[4]; float s = 0.f;
#pragma unroll
        for (int j = 0; j < 4; ++j) { v[j] = xr[64 * j]; s += (v[j].x * v[j].x + v[j].y * v[j].y) + (v[j].z * v[j].z + v[j].w * v[j].w); }
        const float rstd = 1.0f / sqrtf(wave_sum(s) * (1.0f / DM) + EPS);
        float a0 = 0.f, a1 = 0.f, a2 = 0.f, a3 = 0.f;
        u32x2_t* o8 = (u32x2_t*)(H + (size_t)m * DM) + lane;
#pragma unroll
        for (int j = 0; j < 4; ++j) {
            const f32x4_t w = ((const f32x4_t*)norm_w)[64 * j + lane];
            f32x4_t hv; hv.x = v[j].x * rstd * w.x; hv.y = v[j].y * rstd * w.y; hv.z = v[j].z * rstd * w.z; hv.w = v[j].w * rstd * w.w;
            const int d = 256 * j + 4 * lane;
            const f32x4_t w0 = *(const f32x4_t*)(w_in + (size_t)(d + 0) * D_IN + 4416), w1 = *(const f32x4_t*)(w_in + (size_t)(d + 1) * D_IN + 4416);
            const f32x4_t w2 = *(const f32x4_t*)(w_in + (size_t)(d + 2) * D_IN + 4416), w3 = *(const f32x4_t*)(w_in + (size_t)(d + 3) * D_IN + 4416);
            a0 += hv.x * w0.x + hv.y * w1.x + hv.z * w2.x + hv.w * w3.x;
            a1 += hv.x * w0.y + hv.y * w1.y + hv.z * w2.y + hv.w * w3.y;
            a2 += hv.x * w0.z + hv.y * w1.z + hv.z * w2.z + hv.w * w3.z;
            a3 += hv.x * w0.w + hv.y * w1.w + hv.z * w2.w + hv.w * w3.w;
            u32x2_t o; o.x = pk2(hv.x, hv.y); o.y = pk2(hv.z, hv.w); o8[64 * j] = o;
        }
        a0 = wave_sum(a0); a1 = wave_sum(a1); a2 = wave_sum(a2); a3 = wave_sum(a3);
        if (lane == 0) { f32x4_t o = {a0, a1, a2, a3}; *(f32x4_t*)(IW + (size_t)m * 4) = o; }
    }
    const long tid = (long)gw * 64 + lane, nth = (long)ngw * 64;
    for (long i = tid; i < (long)NPAD * (DM / 8); i += nth) {
        const int n = (int)(i % NPAD), k8 = (int)(i / NPAD);
        float e[8];
#pragma unroll
        for (int q = 0; q < 8; ++q) e[q] = (n < D_IN) ? w_in[(size_t)(k8 * 8 + q) * D_IN + n] : 0.f;
        u32x4_t o; o.x = pk2(e[0], e[1]); o.y = pk2(e[2], e[3]); o.z = pk2(e[4], e[5]); o.w = pk2(e[6], e[7]);
        *(u32x4_t*)(WinT + (size_t)n * DM + k8 * 8) = o;
    }
    for (long i = tid; i < (long)DM * (DM / 8); i += nth) {
        const int n = (int)(i % DM), k8 = (int)(i / DM);
        float e[8];
#pragma unroll
        for (int q = 0; q < 8; ++q) e[q] = w_out[(size_t)(k8 * 8 + q) * DM + n];
        u32x4_t o; o.x = pk2(e[0], e[1]); o.y = pk2(e[2], e[3]); o.z = pk2(e[4], e[5]); o.w = pk2(e[6], e[7]);
        *(u32x4_t*)(WoutT + (size_t)n * DM + k8 * 8) = o;
    }
}
__device__ __forceinline__ void final_norm_body(int gw, int ngw, int lane, float* out, const float* __restrict__ fw) {
    for (int m = gw; m < MT; m += ngw) {
        f32x4_t* xr = (f32x4_t*)(out + (size_t)m * DM) + lane;
        f32x4_t v[4]; float s = 0.f;
#pragma unroll
        for (int j = 0; j < 4; ++j) { v[j] = xr[64 * j]; s += (v[j].x * v[j].x + v[j].y * v[j].y) + (v[j].z * v[j].z + v[j].w * v[j].w); }
        const float rstd = 1.0f / sqrtf(wave_sum(s) * (1.0f / DM) + EPS);
#pragma unroll
        for (int j = 0; j < 4; ++j) { const f32x4_t w = ((const f32x4_t*)fw)[64 * j + lane]; f32x4_t o;
            o.x = v[j].x * rstd * w.x; o.y = v[j].y * rstd * w.y; o.z = v[j].z * rstd * w.z; o.w = v[j].w * rstd * w.w; xr[64 * j] = o; }
    }
}

#define WAVE_SYNC() asm volatile("s_waitcnt vmcnt(0) lgkmcnt(0)" ::: "memory")
__device__ __forceinline__ void sel_naive_one(int m, int lane, unsigned* skey, float* sq, unsigned char* ws) {
    const bf16_t* P = (const bf16_t*)(ws + WS_P); const float* IW = (const float*)(ws + WS_IW);
    float* THR = (float*)(ws + WS_THR); int* KCUT = (int*)(ws + WS_KCUT); int* SELCNT = (int*)(ws + WS_SELCNT); int* SEL = (int*)(ws + WS_SEL);
    const int b = m / SEQ, tpos = m % SEQ, N = ((tpos >> 6) + 1) << 6;
    int* sel = SEL + (size_t)m * 256;
    if (N <= 256) {
        for (int j = lane; j < N; j += 64) sel[j] = j;
        if (lane == 0) { THR[m] = -INFINITY; KCUT[m] = 0x7fffffff; SELCNT[m] = N; }
        return;
    }
    { const u32x2_t q = *(const u32x2_t*)(P + PL_IQ * PLANE + (size_t)m * 256 + lane * 4);
      sq[lane * 4 + 0] = bflo(q.x); sq[lane * 4 + 1] = bfhi(q.x); sq[lane * 4 + 2] = bflo(q.y); sq[lane * 4 + 3] = bfhi(q.y); }
    const f32x4_t iw = *(const f32x4_t*)(IW + (size_t)m * 4);
    const float wg0 = iw.x * IDX_SCALE, wg1 = iw.y * IDX_SCALE, wg2 = iw.z * IDX_SCALE, wg3 = iw.w * IDX_SCALE;
    WAVE_SYNC();
    for (int i = 0; i < N / 64; ++i) {
        asm volatile("" ::: "memory");
        const int s = i * 64 + lane; const bf16_t* kr = P + PL_IK * PLANE + (size_t)(b * SEQ + s) * 256;
        float l0 = 0.f, l1 = 0.f, l2 = 0.f, l3 = 0.f;
#pragma unroll
        for (int c = 0; c < 8; ++c) { const u32x4_t kv = *(const u32x4_t*)(kr + c * 8);
            const float k[8] = {bflo(kv.x), bfhi(kv.x), bflo(kv.y), bfhi(kv.y), bflo(kv.z), bfhi(kv.z), bflo(kv.w), bfhi(kv.w)};
#pragma unroll
            for (int e = 0; e < 8; ++e) { const int d = c * 8 + e; l0 += sq[d] * k[e]; l1 += sq[64 + d] * k[e]; l2 += sq[128 + d] * k[e]; l3 += sq[192 + d] * k[e]; } }
        float sc = wg0 * fmaxf(l0, 0.f) + wg1 * fmaxf(l1, 0.f) + wg2 * fmaxf(l2, 0.f) + wg3 * fmaxf(l3, 0.f);
        sc += 0.0f;
        skey[s] = f2key(sc);
    }
    WAVE_SYNC();
    unsigned prefix = 0u;
    for (int bit = 31; bit >= 0; --bit) { const unsigned cand = prefix | (1u << bit); int c = 0;
        for (int i = 0; i < N / 64; ++i) c += (skey[i * 64 + lane] >= cand) ? 1 : 0;
        c = wave_sum_i(c); if (c >= 256) prefix = cand; }
    int cgt = 0; for (int i = 0; i < N / 64; ++i) cgt += (skey[i * 64 + lane] > prefix) ? 1 : 0;
    cgt = wave_sum_i(cgt);
    const int r = 256 - cgt;
    int run = 0, kcut = 0x7fffffff;
    for (int i = 0; i < N / 64; ++i) { const unsigned long long bm = __ballot(skey[i * 64 + lane] == prefix); const int c = __popcll(bm);
        if (run + c >= r) { unsigned long long t = bm; for (int q = 0; q < r - run - 1; ++q) t &= t - 1; kcut = i * 64 + (int)__builtin_ctzll(t); break; }
        run += c; }
    int base = 0;
    for (int i = 0; i < N / 64; ++i) { const unsigned k = skey[i * 64 + lane]; const int idx = i * 64 + lane; const bool f = (k > prefix) || (k == prefix && idx <= kcut);
        const unsigned long long bm = __ballot(f); const int pos = base + __popcll(bm & ((1ull << lane) - 1ull)); if (f && pos < 256) sel[pos] = idx; base += __popcll(bm); }
    if (lane == 0) { THR[m] = key2f(prefix); KCUT[m] = kcut; SELCNT[m] = 256; }
    WAVE_SYNC();
}
__device__ __forceinline__ void dsa_naive_one(int m, int lane, float* sq, float* sc, int* ssel, unsigned char* ws, const float* __restrict__ rel_bias) {
    const bf16_t* P = (const bf16_t*)(ws + WS_P); const int* SELCNT = (const int*)(ws + WS_SELCNT); const int* SEL = (const int*)(ws + WS_SEL);
    bf16_t* AOBO = (bf16_t*)(ws + WS_AOBO);
    const int b = m / SEQ, tpos = m % SEQ; const int cnt = SELCNT[m];
    { const int hc = lane * 8; const u32x4_t q = *(const u32x4_t*)(P + (PL_BQ + (hc >> 8)) * PLANE + (size_t)m * 256 + (hc & 255));
      sq[hc + 0] = bflo(q.x); sq[hc + 1] = bfhi(q.x); sq[hc + 2] = bflo(q.y); sq[hc + 3] = bfhi(q.y); sq[hc + 4] = bflo(q.z); sq[hc + 5] = bfhi(q.z); sq[hc + 6] = bflo(q.w); sq[hc + 7] = bfhi(q.w); }
    for (int j = lane; j < 256; j += 64) ssel[j] = (j < cnt) ? SEL[(size_t)m * 256 + j] : 0;
    WAVE_SYNC();
    for (int jj = 0; jj < 4; ++jj) { const int j = jj * 64 + lane;
        if (j < cnt) { const int s = ssel[j]; const size_t ms = (size_t)(b * SEQ + s); const int bk = t5_bucket(s - tpos);
            for (int h = 0; h < 8; ++h) { const bf16_t* kr = P + (PL_BK + (h >> 2)) * PLANE + ms * 256 + (h & 3) * 64; float a = 0.f;
#pragma unroll
                for (int c = 0; c < 8; ++c) { const u32x4_t kv = *(const u32x4_t*)(kr + c * 8); const float* q = &sq[h * 64 + c * 8];
                    a += q[0] * bflo(kv.x) + q[1] * bfhi(kv.x) + q[2] * bflo(kv.y) + q[3] * bfhi(kv.y) + q[4] * bflo(kv.z) + q[5] * bfhi(kv.z) + q[6] * bflo(kv.w) + q[7] * bfhi(kv.w); }
                sc[h * 256 + j] = a + rel_bias[bk * 12 + 4 + h] * LOG2E; }
        } else { for (int h = 0; h < 8; ++h) sc[h * 256 + j] = -INFINITY; }
    }
    WAVE_SYNC();
    for (int h = 0; h < 8; ++h) { float v0 = sc[h * 256 + lane], v1 = sc[h * 256 + 64 + lane], v2 = sc[h * 256 + 128 + lane], v3 = sc[h * 256 + 192 + lane];
        const float mx = wave_max(fmaxf(fmaxf(v0, v1), fmaxf(v2, v3)));
        v0 = __builtin_amdgcn_exp2f(v0 - mx); v1 = __builtin_amdgcn_exp2f(v1 - mx); v2 = __builtin_amdgcn_exp2f(v2 - mx); v3 = __builtin_amdgcn_exp2f(v3 - mx);
        const float inv = 1.0f / wave_sum((v0 + v1) + (v2 + v3));
        sc[h * 256 + lane] = v0 * inv; sc[h * 256 + 64 + lane] = v1 * inv; sc[h * 256 + 128 + lane] = v2 * inv; sc[h * 256 + 192 + lane] = v3 * inv; }
    WAVE_SYNC();
    { const int hc = lane * 8, h = lane >> 3; float acc[8];
#pragma unroll
      for (int e = 0; e < 8; ++e) acc[e] = 0.f;
      for (int j = 0; j < cnt; ++j) { const float p = sc[h * 256 + j]; const int s = ssel[j];
          const u32x4_t vv = *(const u32x4_t*)(P + (PL_BV + (hc >> 8)) * PLANE + (size_t)(b * SEQ + s) * 256 + (hc & 255));
          acc[0] += p * bflo(vv.x); acc[1] += p * bfhi(vv.x); acc[2] += p * bflo(vv.y); acc[3] += p * bfhi(vv.y); acc[4] += p * bflo(vv.z); acc[5] += p * bfhi(vv.z); acc[6] += p * bflo(vv.w); acc[7] += p * bfhi(vv.w); }
      const u32x4_t g = *(const u32x4_t*)(P + (PL_BG + (hc >> 8)) * PLANE + (size_t)m * 256 + (hc & 255));
      u32x4_t o; o.x = pk2(acc[0] * bflo(g.x), acc[1] * bfhi(g.x)); o.y = pk2(acc[2] * bflo(g.y), acc[3] * bfhi(g.y)); o.z = pk2(acc[4] * bflo(g.z), acc[5] * bfhi(g.z)); o.w = pk2(acc[6] * bflo(g.w), acc[7] * bfhi(g.w));
      *(u32x4_t*)(AOBO + (size_t)m * DM + 512 + hc) = o; }
    WAVE_SYNC();
}
__device__ __forceinline__ float diff_lambda(int lane, const float* lq1, const float* lk1, const float* lq2, const float* lk2) {
    return expf(wave_sum(lq1[lane] * lk1[lane])) - expf(wave_sum(lq2[lane] * lk2[lane])) + LAMBDA_INIT; }
__device__ __forceinline__ void diff_naive_one(int m, int h, int lane, float* s1, float* s2, float* sq, float lam, unsigned char* ws, const float* __restrict__ rel_bias, const float* __restrict__ subln_w) {
    const bf16_t* P = (const bf16_t*)(ws + WS_P); bf16_t* AOBO = (bf16_t*)(ws + WS_AOBO);
    const int b = m / SEQ, tpos = m % SEQ, N = ((tpos >> 6) + 1) << 6;
    const int pq = h >> 1, co = (h & 1) * 128;
    { const unsigned q = *(const unsigned*)(P + (PL_AQ + pq) * PLANE + (size_t)m * 256 + co + lane * 2); sq[lane * 2] = bflo(q); sq[lane * 2 + 1] = bfhi(q); }
    WAVE_SYNC();
    float mx1 = -INFINITY, mx2 = -INFINITY;
    for (int i = 0; i < N / 64; ++i) { asm volatile("" ::: "memory"); const int s = i * 64 + lane; const bf16_t* kr = P + (PL_AK + pq) * PLANE + (size_t)(b * SEQ + s) * 256 + co;
        float d1 = 0.f, d2 = 0.f;
#pragma unroll
        for (int c = 0; c < 8; ++c) { const u32x4_t kv = *(const u32x4_t*)(kr + c * 8); const float* q = &sq[c * 8];
            d1 += q[0] * bflo(kv.x) + q[1] * bfhi(kv.x) + q[2] * bflo(kv.y) + q[3] * bfhi(kv.y) + q[4] * bflo(kv.z) + q[5] * bfhi(kv.z) + q[6] * bflo(kv.w) + q[7] * bfhi(kv.w); }
#pragma unroll
        for (int c = 0; c < 8; ++c) { const u32x4_t kv = *(const u32x4_t*)(kr + 64 + c * 8); const float* q = &sq[64 + c * 8];
            d2 += q[0] * bflo(kv.x) + q[1] * bfhi(kv.x) + q[2] * bflo(kv.y) + q[3] * bfhi(kv.y) + q[4] * bflo(kv.z) + q[5] * bfhi(kv.z) + q[6] * bflo(kv.w) + q[7] * bfhi(kv.w); }
        const float bias = rel_bias[t5_bucket(s - tpos) * 12 + h] * LOG2E;
        d1 += bias; d2 += bias; s1[s] = d1; s2[s] = d2; mx1 = fmaxf(mx1, d1); mx2 = fmaxf(mx2, d2); }
    mx1 = wave_max(mx1); mx2 = wave_max(mx2);
    float l1 = 0.f, l2 = 0.f;
    for (int i = 0; i < N / 64; ++i) { const int s = i * 64 + lane; const float p1 = __builtin_amdgcn_exp2f(s1[s] - mx1), p2 = __builtin_amdgcn_exp2f(s2[s] - mx2); s1[s] = p1; s2[s] = p2; l1 += p1; l2 += p2; }
    l1 = wave_sum(l1); l2 = wave_sum(l2);
    const float i1 = 1.0f / l1, i2 = lam / l2;
    for (int i = 0; i < N / 64; ++i) { const int s = i * 64 + lane; s1[s] = s1[s] * i1 - s2[s] * i2; }
    WAVE_SYNC();
    float a0 = 0.f, a1 = 0.f;
    const bf16_t* vb = P + (PL_AV + pq) * PLANE + (size_t)(b * SEQ) * 256 + co + lane * 2;
    for (int s = 0; s < N; ++s) { const float wv = s1[s]; const unsigned vv = *(const unsigned*)(vb + (size_t)s * 256); a0 += wv * bflo(vv); a1 += wv * bfhi(vv); }
    const float rstd = 1.0f / sqrtf(wave_sum(a0 * a0 + a1 * a1) * (1.0f / 128.0f) + EPS);
    const unsigned g = *(const unsigned*)(P + (PL_AG + pq) * PLANE + (size_t)m * 256 + co + lane * 2);
    const float o0 = a0 * rstd * subln_w[lane * 2] * ONE_M_LAMBDA * bflo(g), o1 = a1 * rstd * subln_w[lane * 2 + 1] * ONE_M_LAMBDA * bfhi(g);
    *(unsigned*)(AOBO + (size_t)m * DM + h * 128 + lane * 2) = pk2(o0, o1);
    WAVE_SYNC();
}
namespace dfa {
typedef short bf16x8 __attribute__((ext_vector_type(8)));
typedef short s16x4 __attribute__((ext_vector_type(4)));
typedef float f32x16 __attribute__((ext_vector_type(16)));
typedef LAS const char* lds_cptr;
constexpr int KBUF = 16384, VBUF = 16384;
constexpr int OFF_K = 0, OFF_V = 2 * KBUF, OFF_LUT = OFF_V + 2 * VBUF, OFF_X = OFF_LUT + 1024, LDS_NEED = OFF_X + 65536;
constexpr float THR = 8.0f;
__device__ __forceinline__ int crow(int r, int hi) { return (r & 3) + 8 * (r >> 2) + 4 * hi; }
__device__ __forceinline__ s16x4 vtr(lds_cptr p) { return __builtin_bit_cast(s16x4, __builtin_amdgcn_ds_read_tr16_b64_v4i16((LAS s16x4*)p)); }
__device__ __forceinline__ float swap_other_half(float v) { auto rr = __builtin_amdgcn_permlane32_swap(__float_as_uint(v), __float_as_uint(v), false, false); return __uint_as_float((threadIdx.x & 32) ? rr[0] : rr[1]); }

__device__ __forceinline__ void unit(unsigned char* lds, int b, int h, int cc, const bf16_t* P, bf16_t* AOBO, const float* __restrict__ rel_bias, const float* __restrict__ subln_w, float lam) {
    const int tid = threadIdx.x, lane = tid & 63, r32 = lane & 31, hi = lane >> 5;
    const int w = __builtin_amdgcn_readfirstlane(tid >> 6), j = w & 1, qs = w >> 1;
    const int cw = 2 * cc + (qs >> 1);
    const int NT = 2 * cc + 2, NTw = cw + 1;
    const size_t rowb = (size_t)b * SEQ;
    const bf16_t* Kg = P + (size_t)(PL_AK + (h >> 1)) * PLANE + rowb * 256 + (h & 1) * 128;
    const bf16_t* Vg = P + (size_t)(PL_AV + (h >> 1)) * PLANE + rowb * 256 + (h & 1) * 128;
    const bf16_t* Qg = P + (size_t)(PL_AQ + (h >> 1)) * PLANE + rowb * 256 + (h & 1) * 128;
    const bf16_t* Gg = P + (size_t)(PL_AG + (h >> 1)) * PLANE + rowb * 256 + (h & 1) * 128;
    LAS unsigned char* L = (LAS unsigned char*)lds;
    LAS float* lut = (LAS float*)(L + OFF_LUT);
    if (tid < 256) { const int rel = tid - 192; const float far = rel_bias[15 * 12 + h]; lut[tid] = (rel_bias[t5_bucket(rel) * 12 + h] - far) * LOG2E; }
#define DFA_DMA(t, buf) do { \
        _Pragma("unroll") for (int i_ = 0; i_ < 2; ++i_) { const int ch_ = 2 * w + i_; \
            __builtin_amdgcn_global_load_lds((const unsigned*)(Kg + (size_t)((t) * 64 + lane) * 256 + ch_ * 8), (LAS unsigned*)(L + OFF_K + (buf) * KBUF + ch_ * 1024), 16, 0, 0); } \
        _Pragma("unroll") for (int i_ = 0; i_ < 2; ++i_) { const int ii_ = 2 * w + i_, dq_ = ii_ >> 2, g_ = ii_ & 3; \
            __builtin_amdgcn_global_load_lds((const unsigned*)(Vg + (size_t)((t) * 64 + 16 * g_ + (lane >> 2)) * 256 + dq_ * 32 + (lane & 3) * 8), (LAS unsigned*)(L + OFF_V + (buf) * VBUF + dq_ * 4096 + g_ * 1024), 16, 0, 0); } \
    } while (0)
    DFA_DMA(0, 0);
    bf16x8 qf[4];
    { const bf16_t* qp = Qg + (size_t)(128 * cc + 32 * qs + r32) * 256 + 64 * j + 8 * hi;
#pragma unroll
      for (int d0 = 0; d0 < 4; ++d0) qf[d0] = *(const bf16x8*)(qp + 16 * d0); }
    f32x16 o[4];
#pragma unroll
    for (int dq = 0; dq < 4; ++dq)
#pragma unroll
        for (int r = 0; r < 16; ++r) o[dq][r] = 0.f;
    f32x16 negm;
#pragma unroll
    for (int r = 0; r < 16; ++r) negm[r] = 0.f;
    float mrun = 0.f, lsum = 0.f;
    const int koff = (8 * j + hi) * 1024 + r32 * 16;
    const int voff = ((lane >> 4) & 1) * 32 + (lane & 3) * 8 + (4 * hi + ((lane & 15) >> 2)) * 64;
    asm volatile("s_waitcnt vmcnt(0)" ::: "memory");
    __syncthreads();
    for (int t = 0; t < NT; ++t) {
        const int buf = t & 1;
        if (t + 1 < NT) DFA_DMA(t + 1, buf ^ 1);
        if (t < NTw) {
            const lds_cptr kb = (lds_cptr)(L + OFF_K + buf * KBUF + koff);
            f32x16 s0 = negm, s1 = negm;
#pragma unroll
            for (int d0 = 0; d0 < 4; ++d0) {
                const bf16x8 a0 = *(const LAS bf16x8*)(kb + d0 * 2048), a1 = *(const LAS bf16x8*)(kb + d0 * 2048 + 512);
                s0 = __builtin_amdgcn_mfma_f32_32x32x16_bf16(a0, qf[d0], s0, 0, 0, 0);
                s1 = __builtin_amdgcn_mfma_f32_32x32x16_bf16(a1, qf[d0], s1, 0, 0, 0);
            }
            if (t >= cw - 2) {
                const int base = 192 + 64 * (t - cw) - 32 * (qs & 1) - r32 + 4 * hi;
#pragma unroll
                for (int r = 0; r < 16; ++r) { const int kk = (r & 3) + 8 * (r >> 2); s0[r] += lut[base + kk]; s1[r] += lut[base + 32 + kk]; }
            }
            float tm = fmaxf(s0[0], s1[0]);
#pragma unroll
            for (int r = 1; r < 16; ++r) tm = fmaxf(tm, fmaxf(s0[r], s1[r]));
            tm = fmaxf(tm, swap_other_half(tm));
            const bool first = (t == 0);
            if (first || __any(tm > THR)) {
                const float dl = first ? tm : fmaxf(tm, 0.f);
                mrun += dl;
#pragma unroll
                for (int r = 0; r < 16; ++r) { s0[r] -= dl; s1[r] -= dl; negm[r] = -mrun; }
                const float al = __builtin_amdgcn_exp2f(-dl);
                lsum *= al;
                if (!first) {
#pragma unroll
                    for (int dq = 0; dq < 4; ++dq)
#pragma unroll
                        for (int r = 0; r < 16; ++r) o[dq][r] *= al;
                }
            }
            float ps = 0.f;
#pragma unroll
            for (int r = 0; r < 16; ++r) { s0[r] = __builtin_amdgcn_exp2f(s0[r]); s1[r] = __builtin_amdgcn_exp2f(s1[r]); ps += s0[r] + s1[r]; }
            lsum += ps;
            bf16x8 pf[4];
#pragma unroll
            for (int ks = 0; ks < 2; ++ks) {
                u32x4_t a, c;
                a.x = pk2(s0[8 * ks + 0], s0[8 * ks + 1]); a.y = pk2(s0[8 * ks + 2], s0[8 * ks + 3]); a.z = pk2(s0[8 * ks + 4], s0[8 * ks + 5]); a.w = pk2(s0[8 * ks + 6], s0[8 * ks + 7]);
                c.x = pk2(s1[8 * ks + 0], s1[8 * ks + 1]); c.y = pk2(s1[8 * ks + 2], s1[8 * ks + 3]); c.z = pk2(s1[8 * ks + 4], s1[8 * ks + 5]); c.w = pk2(s1[8 * ks + 6], s1[8 * ks + 7]);
                pf[ks] = __builtin_bit_cast(bf16x8, a); pf[2 + ks] = __builtin_bit_cast(bf16x8, c);
            }
            const lds_cptr vp = (lds_cptr)(L + OFF_V + buf * VBUF + voff);
#pragma unroll
            for (int dq = 0; dq < 4; ++dq)
#pragma unroll
                for (int ks = 0; ks < 4; ++ks) {
                    const s16x4 lo = vtr(vp + dq * 4096 + ks * 1024), hh = vtr(vp + dq * 4096 + ks * 1024 + 512);
                    const bf16x8 vf = {lo[0], lo[1], lo[2], lo[3], hh[0], hh[1], hh[2], hh[3]};
                    o[dq] = __builtin_amdgcn_mfma_f32_32x32x16_bf16(vf, pf[ks], o[dq], 0, 0, 0);
                }
        }
        asm volatile("s_waitcnt vmcnt(0)" ::: "memory");
        __syncthreads();
    }
#undef DFA_DMA
    const float ltot = lsum + swap_other_half(lsum);
    LAS float* X = (LAS float*)(L + OFF_X) + qs * 4096;
    if (j == 1) {
        const float sc = lam / ltot;
#pragma unroll
        for (int dq = 0; dq < 4; ++dq)
#pragma unroll
            for (int r = 0; r < 16; ++r) X[(dq * 16 + r) * 64 + lane] = o[dq][r] * sc;
    }
    __syncthreads();
    if (j == 0) {
        const float inv = 1.0f / ltot; float ss = 0.f;
#pragma unroll
        for (int dq = 0; dq < 4; ++dq)
#pragma unroll
            for (int r = 0; r < 16; ++r) { const float v = o[dq][r] * inv - X[(dq * 16 + r) * 64 + lane]; o[dq][r] = v; ss += v * v; }
        ss += swap_other_half(ss);
        const float rstd = ONE_M_LAMBDA / sqrtf(ss * (1.0f / 128.0f) + EPS);
        const size_t m = rowb + (size_t)(128 * cc + 32 * qs + r32);
        const bf16_t* gp = Gg + (m - rowb) * 256;
        bf16_t* op = AOBO + m * DM + h * 128;
#pragma unroll
        for (int dq = 0; dq < 4; ++dq)
#pragma unroll
            for (int g = 0; g < 4; ++g) { const int dv = 32 * dq + 8 * g + 4 * hi;
                const u32x2_t gv = *(const u32x2_t*)(gp + dv); const f32x4_t sw = *(const f32x4_t*)(subln_w + dv);
                u32x2_t ov; ov.x = pk2(o[dq][4 * g + 0] * rstd * sw.x * bflo(gv.x), o[dq][4 * g + 1] * rstd * sw.y * bfhi(gv.x));
                ov.y = pk2(o[dq][4 * g + 2] * rstd * sw.z * bflo(gv.y), o[dq][4 * g + 3] * rstd * sw.w * bfhi(gv.y));
                *(u32x2_t*)(op + dv) = ov; }
    }
    __syncthreads();
}
__device__ __forceinline__ void phase(unsigned char* lds, int blk, int G, const bf16_t* P, bf16_t* AOBO, const float* rel_bias, const float* subln_w, float lam) {
    if (G == 256) {
        const int x = blk & 7, i = blk >> 3;
        for (int k = 0; k < 4; ++k) { const int id = 4 * x + k; unit(lds, id >> 2, id & 3, (k & 1) ? 31 - i : i, P, AOBO, rel_bias, subln_w, lam); }
    } else {
        for (int u = blk; u < 32 * 32; u += G) unit(lds, (u >> 5) >> 2, (u >> 5) & 3, u & 31, P, AOBO, rel_bias, subln_w, lam);
    }
}
}
constexpr int LDS_MAIN = 139264;
constexpr int MISC_OFF = LDS_MAIN, LDS_BYTES = LDS_MAIN + 64;
constexpr size_t BAR_BYTES = (size_t)XCD_BAR_WORDS * 4;
struct Args { const float* in[11]; float* out; unsigned char* ws; };

__global__ void __launch_bounds__(512, 2) fwd(Args a) {
    extern __shared__ __attribute__((aligned(16))) unsigned char lds[];
    const int tid = threadIdx.x, lane = tid & 63, wave = __builtin_amdgcn_readfirstlane(tid >> 6);
    volatile LAS unsigned* misc = (volatile LAS unsigned*)((LAS unsigned char*)lds + MISC_OFF);
    if (tid < 16) misc[tid] = 0u;
    __syncthreads();
    XcdBarrier bar = xcd_barrier_post((unsigned*)a.ws, misc);
    const int G = gridDim.x, gw = blockIdx.x * 8 + wave, ngw = G * 8;
    unsigned char* ws = a.ws;
    const float* x = a.in[0]; const float* rel_bias = a.in[9];
    prologue_body(gw, ngw, lane, x, a.in[1], a.in[2], a.in[3], (bf16_t*)(ws + WS_H), (float*)(ws + WS_IW), (bf16_t*)(ws + WS_WINT), (bf16_t*)(ws + WS_WOUTT));
    xcd_barrier(bar);
    { pg8::Gemm g{(const bf16_t*)(ws + WS_H), (const bf16_t*)(ws + WS_WINT), MT, NPAD, DM}; pg8::StaticOrder S; S.init(MT, NPAD, G, (int)blockIdx.x);
      pg8::EpiProj E{(bf16_t*)(ws + WS_P)};
      pg8::gemm_phase<pg8::EpiProj, pg8::StaticOrder, true, true>((PG8_LAS unsigned char*)lds, g, S, E); }
    xcd_barrier(bar);
    { unsigned* skey = (unsigned*)(lds + wave * 17408); float* sq = (float*)(lds + wave * 17408 + 16384);
      for (int m = gw; m < MT; m += ngw) sel_naive_one(m, lane, skey, sq, ws); }
    xcd_barrier(bar);
    { float* sq = (float*)(lds + wave * 11264); float* sc = sq + 512; int* ssel = (int*)(sc + 2048);
      for (int m = gw; m < MT; m += ngw) dsa_naive_one(m, lane, sq, sc, ssel, ws, rel_bias); }
    __syncthreads();
    { const float lam = diff_lambda(lane, a.in[4], a.in[5], a.in[6], a.in[7]);
      dfa::phase(lds, (int)blockIdx.x, G, (const bf16_t*)(ws + WS_P), (bf16_t*)(ws + WS_AOBO), rel_bias, a.in[8], lam); }
    xcd_barrier(bar);
    { pg8::Gemm g{(const bf16_t*)(ws + WS_AOBO), (const bf16_t*)(ws + WS_WOUTT), MT, DM, DM}; pg8::StaticOrder S; S.init(MT, DM, G, (int)blockIdx.x);
      pg8::EpiOut E{x, a.out};
      pg8::gemm_phase<pg8::EpiOut, pg8::StaticOrder, true, true>((PG8_LAS unsigned char*)lds, g, S, E); }
    xcd_barrier(bar);
    final_norm_body(gw, ngw, lane, a.out, a.in[10]);
}

extern "C" void kernel_launch(void* const* d_in, const int* in_sizes, int n_in, void* d_out, int out_size, void* d_ws, size_t ws_size, hipStream_t stream) {
    static int grid = 0;
    if (grid == 0) {
        if (n_in != 11 || out_size != MT * DM || ws_size < WS_END) { fprintf(stderr, "kernel_launch: unexpected shapes (n_in %d out %d ws %zu need %zu)\n", n_in, out_size, ws_size, (size_t)WS_END); grid = -1; return; }
        int dev = 0, cus = 0, per_cu = 0;
        if (hipGetDevice(&dev) != hipSuccess || hipDeviceGetAttribute(&cus, hipDeviceAttributeMultiprocessorCount, dev) != hipSuccess) { grid = -1; return; }
        if (hipFuncSetAttribute((const void*)fwd, hipFuncAttributeMaxDynamicSharedMemorySize, LDS_BYTES) != hipSuccess) { fprintf(stderr, "kernel_launch: hipFuncSetAttribute failed\n"); grid = -1; return; }
        if (hipOccupancyMaxActiveBlocksPerMultiprocessor(&per_cu, (const void*)fwd, 512, LDS_BYTES) != hipSuccess || per_cu < 1) { fprintf(stderr, "kernel_launch: occupancy query says %d blocks per CU\n", per_cu); (void)hipGetLastError(); }
        grid = cus;
    }
    if (grid < 0) return;
    if (hipMemsetAsync(d_ws, 0, BAR_BYTES, stream) != hipSuccess) { fprintf(stderr, "kernel_launch: memset failed\n"); return; }
    Args a; memset(&a, 0, sizeof(a));
    for (int i = 0; i < 11; ++i) a.in[i] = (const float*)d_in[i];
    a.out = (float*)d_out; a.ws = (unsigned char*)d_ws;
    hipLaunchKernelGGL(fwd, dim3(grid), dim3(512), LDS_BYTES, stream, a);
}
```

```cpp
#include <hip/hip_runtime.h>
#include <cstdio>
#include <cstdint>
#include <cstring>
#include <cmath>
#define LAS __attribute__((address_space(3)))
typedef unsigned short bf16_t;
typedef unsigned u32x4_t __attribute__((ext_vector_type(4)));
typedef unsigned u32x2_t __attribute__((ext_vector_type(2)));
typedef float f32x4_t __attribute__((ext_vector_type(4)));

constexpr int DM = 1024, NBATCH = 8, SEQ = 4096, MT = NBATCH * SEQ;
constexpr int D_IN = 4420, NPAD = 4608, NPLANES = 18;
constexpr float EPS = 1e-6f, LOG2E = 1.4426950408889634f;
constexpr float C2 = 0.125f * LOG2E;
constexpr float IDX_SCALE = 0.0625f;
constexpr float LAMBDA_INIT = 0.2f, ONE_M_LAMBDA = 0.8f;
constexpr size_t PLANE = (size_t)MT * 256;
constexpr int PL_AQ = 0, PL_AK = 2, PL_AV = 4, PL_AG = 6, PL_BQ = 8, PL_BK = 10, PL_BV = 12, PL_BG = 14, PL_IQ = 16, PL_IK = 17;

constexpr size_t WS_CTL = 0;
constexpr size_t WS_WINT = 65536;
constexpr size_t WS_WOUTT = WS_WINT + (size_t)NPAD * DM * 2;
constexpr size_t WS_H = WS_WOUTT + (size_t)DM * DM * 2;
constexpr size_t WS_P = WS_H + (size_t)MT * DM * 2;
constexpr size_t WS_IW = WS_P + (size_t)NPLANES * PLANE * 2;
constexpr size_t WS_THR = WS_IW + (size_t)MT * 16;
constexpr size_t WS_KCUT = WS_THR + (size_t)MT * 4;
constexpr size_t WS_SELCNT = WS_KCUT + (size_t)MT * 4;
constexpr size_t WS_AOBO = WS_SELCNT + (size_t)MT * 4;
constexpr size_t WS_SEL = WS_AOBO + (size_t)MT * DM * 2;
constexpr size_t WS_MASK = WS_SEL + (size_t)MT * 256 * 4;
constexpr size_t WS_END = WS_MASK + (size_t)NBATCH * 64 * 32 * 64 * 16;

__device__ __forceinline__ float bf2f(bf16_t v) { return __uint_as_float(((unsigned)v) << 16); }
__device__ __forceinline__ float bflo(unsigned w) { return __uint_as_float(w << 16); }
__device__ __forceinline__ float bfhi(unsigned w) { return __uint_as_float(w & 0xffff0000u); }
__device__ __forceinline__ unsigned pk2(float lo, float hi) {
    typedef float f2 __attribute__((ext_vector_type(2))); typedef __bf16 b2 __attribute__((ext_vector_type(2)));
    f2 v = {lo, hi}; b2 b = __builtin_convertvector(v, b2); return __builtin_bit_cast(unsigned, b); }
__device__ __forceinline__ float wave_sum(float v) {
#pragma unroll
    for (int o = 1; o < 64; o <<= 1) v += __shfl_xor(v, o);
    return v; }
__device__ __forceinline__ int wave_sum_i(int v) {
#pragma unroll
    for (int o = 1; o < 64; o <<= 1) v += __shfl_xor(v, o);
    return v; }
__device__ __forceinline__ float wave_max(float v) {
#pragma unroll
    for (int o = 1; o < 64; o <<= 1) v = fmaxf(v, __shfl_xor(v, o));
    return v; }
__device__ __forceinline__ int t5_bucket(int rel) {
    const int ret = rel > 0 ? 16 : 0; const int n = rel < 0 ? -rel : rel;
    if (n < 8) return ret + n;
    int large = 2 + (31 - __builtin_clz((unsigned)(n * n))); large = large > 15 ? 15 : large;
    return ret + large; }
__device__ __forceinline__ unsigned f2key(float f) { const unsigned u = __float_as_uint(f); return (u & 0x80000000u) ? ~u : (u | 0x80000000u); }
__device__ __forceinline__ float key2f(unsigned k) { return __uint_as_float((k & 0x80000000u) ? (k ^ 0x80000000u) : ~k); }
__device__ __forceinline__ float silu_f(float v) { return v * __builtin_amdgcn_rcpf(1.0f + __builtin_amdgcn_exp2f(-v * LOG2E)); }
namespace pg8 {
#define PG8_LAS __attribute__((address_space(3)))
typedef unsigned short bf16_t;
typedef short bf16x8 __attribute__((ext_vector_type(8)));
typedef float f32x4 __attribute__((ext_vector_type(4)));
typedef unsigned u32x4 __attribute__((ext_vector_type(4)));
constexpr int BM = 256, BK = 64, HALF = 128, HTB = HALF * BK * 2  , STAGE_BYTES = 8 * HTB, NXCD = 8, WGM = 8;

__host__ __device__ __forceinline__ int lds_byte(int r, int c) { const int st = (r >> 4) * 2 + (c >> 5), rr = r & 15, cc = c & 31, ob = rr * 64 + cc * 2; return st * 1024 + (ob ^ (((ob >> 9) & 1) << 5)); }
__host__ __device__ __forceinline__ void stage_rc(int b, int& R, int& C) { const int st = b / 1024, sb = b % 1024, swz = sb ^ (((sb >> 9) & 1) << 5); R = (st >> 1) * 16 + swz / 64; C = (st & 1) * 32 + (swz % 64) / 2; }
__host__ __device__ __forceinline__ int perm32(int rho) { const int n = rho >> 4, i = rho & 15; return 8 * (i >> 2) + 4 * n + (i & 3); }

struct Unit { int pm, pn; };
struct Gemm { const bf16_t* A; const bf16_t* Bt; int M, N, K; };

struct StaticOrder {
    int nM, nN, nwg, G, c;
    __host__ __device__ void init(int M, int N, int G_, int c_) { nM = M / BM; nN = N / BM; nwg = nM * nN; G = G_; c = c_; }
    __host__ __device__ bool next(int i, Unit& u) const {
        const long L = (long)i * G + c; if (L >= nwg) return false;
        int wgid = (int)L; { const int q = nwg / NXCD, r = nwg % NXCD, xcd = wgid % NXCD, off = wgid / NXCD; wgid = (xcd < r ? xcd * (q + 1) : r * (q + 1) + (xcd - r) * q) + off; }
        const int nig = WGM * nN, gid = wgid / nig, fm = gid * WGM, gsz = (nM - fm) < WGM ? (nM - fm) : WGM;
        u.pm = fm + ((wgid % nig) % gsz); u.pn = (wgid % nig) / gsz; return true;
    }
    __device__ __forceinline__ void a_ready(const Unit&) const {}
    __device__ __forceinline__ void done(const Unit&) const {}
};

__device__ __forceinline__ unsigned cvt_pk_bf16(float lo, float hi) { unsigned r; asm volatile("v_cvt_pk_bf16_f32 %0, %1, %2" : "=v"(r) : "v"(lo), "v"(hi)); return r; }
template <class Epi, class Sched, bool ALIGN_EPI = false, bool SP2 = false>
__device__ __forceinline__ void gemm_phase(PG8_LAS unsigned char* lds, const Gemm g, const Sched& S, const Epi& E) {
    const int tid = threadIdx.x, wid = __builtin_amdgcn_readfirstlane(tid >> 6), lane = tid & 63, wr = wid >> 2, wc = wid & 3, fr = lane & 15, fq = lane >> 4;
    const int K = g.K, nt = K / BK;
    unsigned voffA[2], voffB[2];
#pragma unroll
    for (int i = 0; i < 2; ++i) { int R, C; stage_rc(tid * 16 + i * 8192, R, C); const int Rb = Epi::PERM ? ((R & ~31) + perm32(R & 31)) : R;
        voffA[i] = (unsigned)(R * K + C) * 2u; voffB[i] = (unsigned)(Rb * K + C) * 2u; }
    const size_t kstep = (size_t)(BK * 2);
    const size_t hstep = (size_t)HALF * K * 2;
    const size_t tstep = 2 * hstep;
    const unsigned ldsw = (unsigned)wid * 1024u;
    const int aoff = lds_byte(wr * 64 + fr, fq * 8), boff = lds_byte(wc * 32 + fr, fq * 8);
#define PG8_SA(b, h) (((b) * 2 + (h)) * HTB)
#define PG8_SB(b, h) ((4 + (b) * 2 + (h)) * HTB)
#define PG8_STAGE(bufoff, gbase, voff) do { _Pragma("unroll") for (int _i = 0; _i < 2; ++_i) \
        __builtin_amdgcn_global_load_lds((const unsigned*)((const char*)(gbase) + (voff)[_i]), (PG8_LAS unsigned*)(lds + (bufoff) + ldsw + _i * 8192), 16, 0, 0); } while (0)
#define PG8_LDA(dst, b, h) do { _Pragma("unroll") for (int m = 0; m < 4; ++m) _Pragma("unroll") for (int k = 0; k < 2; ++k) dst[m][k] = *(const PG8_LAS bf16x8*)(lds + PG8_SA(b, h) + aoff + m * 2048 + k * 1024); } while (0)
#define PG8_LDB(dst, b, h) do { _Pragma("unroll") for (int n = 0; n < 2; ++n) _Pragma("unroll") for (int k = 0; k < 2; ++k) dst[n][k] = *(const PG8_LAS bf16x8*)(lds + PG8_SB(b, h) + boff + n * 2048 + k * 1024); } while (0)
#define PG8_MMA(ai, bj, At, Bt) do { __builtin_amdgcn_s_setprio(1); _Pragma("unroll") for (int m = 0; m < 4; ++m) _Pragma("unroll") for (int n = 0; n < 2; ++n) _Pragma("unroll") for (int k = 0; k < 2; ++k) \
        acc[ai][bj][m][n] = __builtin_amdgcn_mfma_f32_16x16x32_bf16(Bt[n][k], At[m][k], acc[ai][bj][m][n], 0, 0, 0); __builtin_amdgcn_s_setprio(0); } while (0)
#define PG8_WAIT_V(n) asm volatile("s_waitcnt vmcnt(" #n ")" ::: "memory")
#define PG8_WAIT_L(n) asm volatile("s_waitcnt lgkmcnt(" #n ")" ::: "memory")
#define PG8_BAR __builtin_amdgcn_s_barrier()
#define PG8_SCHED __builtin_amdgcn_sched_barrier(0)
    Unit cur, nxt; int ui = 0;
    if (!S.next(0, cur)) return;
    f32x4 acc[2][2][4][2];
#pragma unroll
    for (int a = 0; a < 2; ++a)
#pragma unroll
        for (int b = 0; b < 2; ++b)
#pragma unroll
            for (int m = 0; m < 4; ++m)
#pragma unroll
                for (int n = 0; n < 2; ++n) acc[a][b][m][n] = (f32x4){0.f, 0.f, 0.f, 0.f};
    bf16x8 At[4][2], B0[2][2], B1[2][2];
    const char* cA = (const char*)g.A + (size_t)cur.pm * tstep; const char* cB = (const char*)g.Bt + (size_t)cur.pn * tstep;
    S.a_ready(cur);
    if constexpr (SP2) {
        PG8_STAGE(PG8_SB(0, 0), cB, voffB); PG8_STAGE(PG8_SB(0, 1), cB + hstep, voffB); PG8_STAGE(PG8_SA(0, 0), cA, voffA); PG8_STAGE(PG8_SA(0, 1), cA + hstep, voffA);
        if (wr == 1) PG8_BAR;
        PG8_WAIT_V(2); PG8_BAR;
        PG8_STAGE(PG8_SB(1, 0), cB + kstep, voffB); PG8_STAGE(PG8_SA(1, 0), cA + kstep, voffA); PG8_STAGE(PG8_SB(1, 1), cB + hstep + kstep, voffB);
        PG8_WAIT_V(6); PG8_BAR;
    } else {
        PG8_STAGE(PG8_SB(0, 0), cB, voffB); PG8_STAGE(PG8_SA(0, 0), cA, voffA); PG8_STAGE(PG8_SB(0, 1), cB + hstep, voffB); PG8_STAGE(PG8_SA(0, 1), cA + hstep, voffA);
        if (wr == 1) PG8_BAR;
        PG8_WAIT_V(4); PG8_BAR;
        PG8_STAGE(PG8_SB(1, 0), cB + kstep, voffB); PG8_STAGE(PG8_SA(1, 0), cA + kstep, voffA); PG8_STAGE(PG8_SB(1, 1), cB + hstep + kstep, voffB);
        PG8_WAIT_V(6); PG8_BAR;
    }
    for (;;) {
        const bool has_next = S.next(ui + 1, nxt);
        const char* nA = has_next ? (const char*)g.A + (size_t)nxt.pm * tstep : cA; const char* nB = has_next ? (const char*)g.Bt + (size_t)nxt.pn * tstep : cB;
        for (int t = 0; t < nt; t += 2) {
            const bool last = (t == nt - 2);
            const char* a1 = cA + (size_t)(t + 1) * kstep;
            const char* a2 = last ? nA : cA + (size_t)(t + 2) * kstep; const char* b2 = last ? nB : cB + (size_t)(t + 2) * kstep;
            const char* a3 = a2 + kstep; const char* b3 = b2 + kstep;
            if (last && has_next) S.a_ready(nxt);
            if constexpr (SP2) {
            PG8_LDB(B0, 0, 0); PG8_LDB(B1, 0, 1); PG8_SCHED; PG8_LDA(At, 0, 0); PG8_STAGE(PG8_SA(1, 1), a1 + hstep, voffA);
            PG8_WAIT_V(8); PG8_WAIT_L(0); PG8_BAR; PG8_MMA(0, 0, At, B0); PG8_MMA(0, 1, At, B1); PG8_BAR; PG8_SCHED;
            PG8_LDA(At, 0, 1); PG8_STAGE(PG8_SB(0, 0), b2, voffB); PG8_STAGE(PG8_SB(0, 1), b2 + hstep, voffB); PG8_STAGE(PG8_SA(0, 0), a2, voffA);
            PG8_WAIT_V(8); PG8_WAIT_L(0); PG8_BAR; PG8_MMA(1, 0, At, B0); PG8_MMA(1, 1, At, B1); PG8_BAR; PG8_SCHED;
            PG8_LDB(B0, 1, 0); PG8_LDB(B1, 1, 1); PG8_SCHED; PG8_LDA(At, 1, 0); PG8_STAGE(PG8_SA(0, 1), a2 + hstep, voffA);
            PG8_WAIT_V(8); PG8_WAIT_L(0); PG8_BAR; PG8_MMA(0, 0, At, B0); PG8_MMA(0, 1, At, B1); PG8_BAR; PG8_SCHED;
            PG8_LDA(At, 1, 1); PG8_STAGE(PG8_SB(1, 0), b3, voffB); PG8_STAGE(PG8_SB(1, 1), b3 + hstep, voffB); PG8_STAGE(PG8_SA(1, 0), a3, voffA);
            PG8_WAIT_V(8); PG8_WAIT_L(0); PG8_BAR; PG8_MMA(1, 0, At, B0); PG8_MMA(1, 1, At, B1); PG8_BAR; PG8_SCHED;
            } else {
            PG8_LDB(B0, 0, 0); PG8_SCHED; PG8_LDA(At, 0, 0); PG8_STAGE(PG8_SA(1, 1), a1 + hstep, voffA);
            PG8_WAIT_L(8); PG8_BAR; PG8_WAIT_L(0); PG8_MMA(0, 0, At, B0); PG8_BAR; PG8_SCHED;
            PG8_LDB(B1, 0, 1); PG8_STAGE(PG8_SB(0, 0), b2, voffB);
            PG8_BAR; PG8_WAIT_L(0); PG8_MMA(0, 1, At, B1); PG8_BAR;
            PG8_LDA(At, 0, 1); PG8_STAGE(PG8_SA(0, 0), a2, voffA);
            PG8_BAR; PG8_WAIT_L(0); PG8_MMA(1, 0, At, B0); PG8_BAR; PG8_SCHED;
            PG8_STAGE(PG8_SB(0, 1), b2 + hstep, voffB);
            PG8_WAIT_V(6); PG8_BAR; PG8_MMA(1, 1, At, B1); PG8_BAR;
            PG8_LDB(B0, 1, 0); PG8_SCHED; PG8_LDA(At, 1, 0); PG8_STAGE(PG8_SA(0, 1), a2 + hstep, voffA);
            PG8_WAIT_L(8); PG8_BAR; PG8_WAIT_L(0); PG8_MMA(0, 0, At, B0); PG8_BAR; PG8_SCHED;
            PG8_LDB(B1, 1, 1); PG8_STAGE(PG8_SB(1, 0), b3, voffB);
            PG8_BAR; PG8_WAIT_L(0); PG8_MMA(0, 1, At, B1); PG8_BAR;
            PG8_LDA(At, 1, 1); PG8_STAGE(PG8_SA(1, 0), a3, voffA);
            PG8_BAR; PG8_WAIT_L(0); PG8_MMA(1, 0, At, B0); PG8_BAR; PG8_SCHED;
            PG8_STAGE(PG8_SB(1, 1), b3 + hstep, voffB);
            PG8_WAIT_V(6); PG8_BAR; PG8_MMA(1, 1, At, B1); PG8_BAR;
            }
        }
        if constexpr (ALIGN_EPI) { if (wr == 0) PG8_BAR; }
        if constexpr (!Epi::AFTER_DRAIN) { E(acc, cur, wr, wc, fr, fq); S.done(cur); }
        if (!has_next) break;
#pragma unroll
        for (int a = 0; a < 2; ++a)
#pragma unroll
            for (int b = 0; b < 2; ++b)
#pragma unroll
                for (int m = 0; m < 4; ++m)
#pragma unroll
                    for (int n = 0; n < 2; ++n) acc[a][b][m][n] = (f32x4){0.f, 0.f, 0.f, 0.f};
        cur = nxt; cA = nA; cB = nB; ++ui;
        if constexpr (ALIGN_EPI) { if (wr == 1) PG8_BAR; }
    }
    PG8_WAIT_V(0);
    if constexpr (!ALIGN_EPI) { if (wr == 0) PG8_BAR; }
    PG8_BAR;
    if constexpr (Epi::AFTER_DRAIN) { E.fused(acc, cur, wr, wc, fr, fq, lds, wid, lane); S.done(cur); }
#undef PG8_SA
#undef PG8_SB
#undef PG8_STAGE
#undef PG8_LDA
#undef PG8_LDB
#undef PG8_MMA
#undef PG8_WAIT_V
#undef PG8_WAIT_L
#undef PG8_BAR
#undef PG8_SCHED
}
}
namespace pg8 {
struct EpiProj {
    static constexpr bool PERM = true, AFTER_DRAIN = false;
    bf16_t* P;
    __device__ __forceinline__ void operator()(const f32x4 (&acc)[2][2][4][2], const Unit& u, int wr, int wc, int fr, int fq) const {
        const int row0 = u.pm * BM + wr * 64 + fr, col0 = wc * 32 + 8 * fq, pl = u.pn;
        bf16_t* base = P + (size_t)pl * ((size_t)MT * 256);
        const int mode = (pl < 2 || pl == 8 || pl == 9) ? 1 : ((pl == 6 || pl == 7 || pl == 14 || pl == 15) ? 2 : 0);
#pragma unroll
        for (int ai = 0; ai < 2; ++ai)
#pragma unroll
            for (int m = 0; m < 4; ++m) { bf16_t* rowp = base + (size_t)(row0 + ai * HALF + m * 16) * 256 + col0;
#pragma unroll
                for (int bj = 0; bj < 2; ++bj) { f32x4 v0 = acc[ai][bj][m][0], v1 = acc[ai][bj][m][1];
                    if (mode == 1) { v0 = v0 * C2; v1 = v1 * C2; }
                    if (mode == 2) {
#pragma unroll
                        for (int j = 0; j < 4; ++j) { v0[j] = silu_f(v0[j]); v1[j] = silu_f(v1[j]); } }
                    u32x4 w; w.x = cvt_pk_bf16(v0[0], v0[1]); w.y = cvt_pk_bf16(v0[2], v0[3]); w.z = cvt_pk_bf16(v1[0], v1[1]); w.w = cvt_pk_bf16(v1[2], v1[3]);
                    *(u32x4*)(rowp + bj * HALF) = w; } }
    }
};
struct EpiOut {
    static constexpr bool PERM = false, AFTER_DRAIN = false;
    const float* X; float* O;
    __device__ __forceinline__ void operator()(const f32x4 (&acc)[2][2][4][2], const Unit& u, int wr, int wc, int fr, int fq) const {
        const int row0 = u.pm * BM + wr * 64 + fr, col0 = u.pn * BM + wc * 32 + 4 * fq;
#pragma unroll
        for (int ai = 0; ai < 2; ++ai)
#pragma unroll
            for (int m = 0; m < 4; ++m) { const size_t off = (size_t)(row0 + ai * HALF + m * 16) * DM + col0;
#pragma unroll
                for (int bj = 0; bj < 2; ++bj)
#pragma unroll
                    for (int n = 0; n < 2; ++n) { const f32x4 xv = *(const f32x4*)(X + off + bj * HALF + n * 16); *(f32x4*)(O + off + bj * HALF + n * 16) = xv + acc[ai][bj][m][n]; } }
    }
};
}
#include <cstdlib>
#include <vector>

#define XB_TMO      128
#define XB_XCNT(j)  (256  + 64 * (j))
#define XB_XSUB(j)  (1280 + 64 * (j))
#define XB_XGEN(j)  (2304 + 64 * (j))
#define XB_TOP      3328
#define XB_TOPGEN   3392
#define XCD_BAR_WORDS 3456
#define XB_SPIN_CAP (1u << 18)
#define LAS __attribute__((address_space(3)))

__device__ __forceinline__ unsigned xb_ld(unsigned* p)              { return __hip_atomic_load(p, __ATOMIC_RELAXED, __HIP_MEMORY_SCOPE_AGENT); }
__device__ __forceinline__ unsigned xb_add(unsigned* p, unsigned v) { return __hip_atomic_fetch_add(p, v, __ATOMIC_RELAXED, __HIP_MEMORY_SCOPE_AGENT); }
__device__ __forceinline__ unsigned xb_xcc_id() { return (unsigned)__builtin_amdgcn_s_getreg((3 << 11) | 20) & 0xFu; }
#define XB_SPIN(cond, bar) do { unsigned _sp = 0; while (cond) { __builtin_amdgcn_s_sleep(1); \
    if ((++_sp & 255u) == 0u) { if (xb_ld(&(bar)[XB_TMO])) break; if (_sp > XB_SPIN_CAP) { atomicAdd(&(bar)[XB_TMO], 1u); break; } } } } while (0)

struct XcdBarrier {
    unsigned* bar; unsigned x;
    volatile LAS unsigned* st;
};

__device__ __forceinline__ XcdBarrier xcd_barrier_post(unsigned* bar, volatile LAS unsigned* st) {
    XcdBarrier b; b.bar = bar; b.x = xb_xcc_id(); b.st = st;
    if (threadIdx.x == 0) (void)xb_add(&bar[XB_XCNT(b.x)], 1u);
    return b;
}
__device__ __forceinline__ void xcd_barrier_complete(unsigned* bar, unsigned x, unsigned& nloc, unsigned& nx) {
    const unsigned G = gridDim.x * gridDim.y * gridDim.z;
    unsigned sum, cnt, mine, sp = 0u;
    for (;;) {
        sum = 0u; cnt = 0u; mine = 0u;
#pragma unroll
        for (unsigned j = 0; j < 16; ++j) { const unsigned c = xb_ld(&bar[XB_XCNT(j)]); sum += c; cnt += (c > 0u) ? 1u : 0u; mine = (j == x) ? c : mine; }
        if (sum == G) break;
        __builtin_amdgcn_s_sleep(1);
        if ((++sp & 255u) == 0u) { if (xb_ld(&bar[XB_TMO])) break; if (sp > XB_SPIN_CAP) { atomicAdd(&bar[XB_TMO], 1u); break; } }
    }
    nloc = mine > 0u ? mine : 1u; nx = cnt > 0u ? cnt : 1u;
}

__device__ __forceinline__ void xcd_barrier(const XcdBarrier& b) {
    asm volatile("s_waitcnt vmcnt(0)" ::: "memory");
    __syncthreads();
    if (threadIdx.x == 0) {
        unsigned* bar = b.bar;
        __builtin_amdgcn_s_waitcnt(0);
        unsigned nloc = b.st[0], nx = b.st[1];
        if (nloc == 0u) { xcd_barrier_complete(bar, b.x, nloc, nx); b.st[0] = nloc; b.st[1] = nx; }
        const unsigned old = xb_add(&bar[XB_XSUB(b.x)], 1u);
        const unsigned gen = old / nloc;
        if (old + 1u == (gen + 1u) * nloc) {
            __builtin_amdgcn_fence(__ATOMIC_RELEASE, "agent");
            asm volatile("s_waitcnt vmcnt(0)" ::: "memory");
            const unsigned og = xb_add(&bar[XB_TOP], 1u);
            const unsigned tg = og / nx;
            if (og + 1u == (tg + 1u) * nx) xb_add(&bar[XB_TOPGEN], 1u);
            else XB_SPIN(xb_ld(&bar[XB_TOPGEN]) == tg, bar);
            __builtin_amdgcn_fence(__ATOMIC_ACQUIRE, "agent");
            xb_add(&bar[XB_XGEN(b.x)], 1u);
            asm volatile("s_waitcnt vmcnt(0)" ::: "memory");
        } else {
            XB_SPIN(xb_ld(&bar[XB_XGEN(b.x)]) == gen, bar);
            __builtin_amdgcn_fence(__ATOMIC_ACQUIRE, "agent");
            asm volatile("s_waitcnt vmcnt(0)" ::: "memory");
        }
    }
    __syncthreads();
}
__device__ __forceinline__ void prologue_body(int gw, int ngw, int lane, const float* __restrict__ x, const float* __restrict__ norm_w, const float* __restrict__ w_in,
                                              const float* __restrict__ w_out, bf16_t* H, float* IW, bf16_t* WinT, bf16_t* WoutT) {
    for (int m = gw; m < MT; m += ngw) {
        const f32x4_t* xr = (const f32x4_t*)(x + (size_t)m * DM) + lane;
        f32x4_t v[4]; float s = 0.f;
#pragma unroll
        for (int j = 0; j < 4; ++j) { v[j] = xr[64 * j]; s += (v[j].x * v[j].x + v[j].y * v[j].y) + (v[j].z * v[j].z + v[j].w * v[j].w); }
        const float rstd = 1.0f / sqrtf(wave_sum(s) * (1.0f / DM) + EPS);
        float a0 = 0.f, a1 = 0.f, a2 = 0.f, a3 = 0.f;
        u32x2_t* o8 = (u32x2_t*)(H + (size_t)m * DM) + lane;
#pragma unroll
        for (int j = 0; j < 4; ++j) {
            const f32x4_t w = ((const f32x4_t*)norm_w)[64 * j + lane];
            f32x4_t hv; hv.x = v[j].x * rstd * w.x; hv.y = v[j].y * rstd * w.y; hv.z = v[j].z * rstd * w.z; hv.w = v[j].w * rstd * w.w;
            const int d = 256 * j + 4 * lane;
            const f32x4_t w0 = *(const f32x4_t*)(w_in + (size_t)(d + 0) * D_IN + 4416), w1 = *(const f32x4_t*)(w_in + (size_t)(d + 1) * D_IN + 4416);
            const f32x4_t w2 = *(const f32x4_t*)(w_in + (size_t)(d + 2) * D_IN + 4416), w3 = *(const f32x4_t*)(w_in + (size_t)(d + 3) * D_IN + 4416);
            a0 += hv.x * w0.x + hv.y * w1.x + hv.z * w2.x + hv.w * w3.x;
            a1 += hv.x * w0.y + hv.y * w1.y + hv.z * w2.y + hv.w * w3.y;
            a2 += hv.x * w0.z + hv.y * w1.z + hv.z * w2.z + hv.w * w3.z;
            a3 += hv.x * w0.w + hv.y * w1.w + hv.z * w2.w + hv.w * w3.w;
            u32x2_t o; o.x = pk2(hv.x, hv.y); o.y = pk2(hv.z, hv.w); o8[64 * j] = o;
        }
        a0 = wave_sum(a0); a1 = wave_sum(a1); a2 = wave_sum(a2); a3 = wave_sum(a3);
        if (lane == 0) { f32x4_t o = {a0, a1, a2, a3}; *(f32x4_t*)(IW + (size_t)m * 4) = o; }
    }
    const long tid = (long)gw * 64 + lane, nth = (long)ngw * 64;
    for (long i = tid; i < (long)NPAD * (DM / 8); i += nth) {
        const int n = (int)(i % NPAD), k8 = (int)(i / NPAD);
        float e[8];
#pragma unroll
        for (int q = 0; q < 8; ++q) e[q] = (n < D_IN) ? w_in[(size_t)(k8 * 8 + q) * D_IN + n] : 0.f;
        u32x4_t o; o.x = pk2(e[0], e[1]); o.y = pk2(e[2], e[3]); o.z = pk2(e[4], e[5]); o.w = pk2(e[6], e[7]);
        *(u32x4_t*)(WinT + (size_t)n * DM + k8 * 8) = o;
    }
    for (long i = tid; i < (long)DM * (DM / 8); i += nth) {
        const int n = (int)(i % DM), k8 = (int)(i / DM);
        float e[8];
#pragma unroll
        for (int q = 0; q < 8; ++q) e[q] = w_out[(size_t)(k8 * 8 + q) * DM + n];
        u32x4_t o; o.x = pk2(e[0], e[1]); o.y = pk2(e[2], e[3]); o.z = pk2(e[4], e[5]); o.w = pk2(e[6], e[7]);
        *(u32x4_t*)(WoutT + (size_t)n * DM + k8 * 8) = o;
    }
}
__device__ __forceinline__ void final_norm_body(int gw, int ngw, int lane, float* out, const float* __restrict__ fw) {
    for (int m = gw; m < MT; m += ngw) {
        f32x4_t* xr = (f32x4_t*)(out + (size_t)m * DM) + lane;
        f32x4_t v[4]; float s = 0.f;
#pragma unroll
        for (int j = 0; j < 4; ++j) { v[j] = xr[64 * j]; s += (v[j].x * v[j].x + v[j].y * v[j].y) + (v[j].z * v[j].z + v[j].w * v[j].w); }
        const float rstd = 1.0f / sqrtf(wave_sum(s) * (1.0f / DM) + EPS);
#pragma unroll
        for (int j = 0; j < 4; ++j) { const f32x4_t w = ((const f32x4_t*)fw)[64 * j + lane]; f32x4_t o;
            o.x = v[j].x * rstd * w.x; o.y = v[j].y * rstd * w.y; o.z = v[j].z * rstd * w.z; o.w = v[j].w * rstd * w.w; xr[64 * j] = o; }
    }
}

#define WAVE_SYNC() asm volatile("s_waitcnt vmcnt(0) lgkmcnt(0)" ::: "memory")
__device__ __forceinline__ void sel_naive_one(int m, int lane, unsigned* skey, float* sq, unsigned char* ws) {
    const bf16_t* P = (const bf16_t*)(ws + WS_P); const float* IW = (const float*)(ws + WS_IW);
    float* THR = (float*)(ws + WS_THR); int* KCUT = (int*)(ws + WS_KCUT); int* SELCNT = (int*)(ws + WS_SELCNT); int* SEL = (int*)(ws + WS_SEL);
    const int b = m / SEQ, tpos = m % SEQ, N = ((tpos >> 6) + 1) << 6;
    int* sel = SEL + (size_t)m * 256;
    unsigned* MASKW = (unsigned*)(ws + WS_MASK) + ((size_t)(b * 64 + (tpos >> 6)) * 32 * 64 + (tpos & 63)) * 4;
    if (N <= 256) {
        for (int j = lane; j < N; j += 64) sel[j] = j;
        if (lane < N / 64) { u32x2_t o = {0xffffffffu, 0xffffffffu}; *(u32x2_t*)(MASKW + (size_t)(lane >> 1) * 256 + (lane & 1) * 2) = o; }
        if (lane == 0) { THR[m] = -INFINITY; KCUT[m] = 0x7fffffff; SELCNT[m] = N; }
        return;
    }
    { const u32x2_t q = *(const u32x2_t*)(P + PL_IQ * PLANE + (size_t)m * 256 + lane * 4);
      sq[lane * 4 + 0] = bflo(q.x); sq[lane * 4 + 1] = bfhi(q.x); sq[lane * 4 + 2] = bflo(q.y); sq[lane * 4 + 3] = bfhi(q.y); }
    const f32x4_t iw = *(const f32x4_t*)(IW + (size_t)m * 4);
    const float wg0 = iw.x * IDX_SCALE, wg1 = iw.y * IDX_SCALE, wg2 = iw.z * IDX_SCALE, wg3 = iw.w * IDX_SCALE;
    WAVE_SYNC();
    for (int i = 0; i < N / 64; ++i) {
        asm volatile("" ::: "memory");
        const int s = i * 64 + lane; const bf16_t* kr = P + PL_IK * PLANE + (size_t)(b * SEQ + s) * 256;
        float l0 = 0.f, l1 = 0.f, l2 = 0.f, l3 = 0.f;
#pragma unroll
        for (int c = 0; c < 8; ++c) { const u32x4_t kv = *(const u32x4_t*)(kr + c * 8);
            const float k[8] = {bflo(kv.x), bfhi(kv.x), bflo(kv.y), bfhi(kv.y), bflo(kv.z), bfhi(kv.z), bflo(kv.w), bfhi(kv.w)};
#pragma unroll
            for (int e = 0; e < 8; ++e) { const int d = c * 8 + e; l0 += sq[d] * k[e]; l1 += sq[64 + d] * k[e]; l2 += sq[128 + d] * k[e]; l3 += sq[192 + d] * k[e]; } }
        float sc = wg0 * fmaxf(l0, 0.f) + wg1 * fmaxf(l1, 0.f) + wg2 * fmaxf(l2, 0.f) + wg3 * fmaxf(l3, 0.f);
        sc += 0.0f;
        skey[s] = f2key(sc);
    }
    WAVE_SYNC();
    unsigned prefix = 0u;
    for (int bit = 31; bit >= 0; --bit) { const unsigned cand = prefix | (1u << bit); int c = 0;
        for (int i = 0; i < N / 64; ++i) c += (skey[i * 64 + lane] >= cand) ? 1 : 0;
        c = wave_sum_i(c); if (c >= 256) prefix = cand; }
    int cgt = 0; for (int i = 0; i < N / 64; ++i) cgt += (skey[i * 64 + lane] > prefix) ? 1 : 0;
    cgt = wave_sum_i(cgt);
    const int r = 256 - cgt;
    int run = 0, kcut = 0x7fffffff;
    for (int i = 0; i < N / 64; ++i) { const unsigned long long bm = __ballot(skey[i * 64 + lane] == prefix); const int c = __popcll(bm);
        if (run + c >= r) { unsigned long long t = bm; for (int q = 0; q < r - run - 1; ++q) t &= t - 1; kcut = i * 64 + (int)__builtin_ctzll(t); break; }
        run += c; }
    int base = 0;
    for (int i = 0; i < N / 64; ++i) { const unsigned k = skey[i * 64 + lane]; const int idx = i * 64 + lane; const bool f = (k > prefix) || (k == prefix && idx <= kcut);
        const unsigned long long bm = __ballot(f); const int pos = base + __popcll(bm & ((1ull << lane) - 1ull)); if (f && pos < 256) sel[pos] = idx; base += __popcll(bm);
        if (lane == 0) { u32x2_t o = {(unsigned)bm, (unsigned)(bm >> 32)}; *(u32x2_t*)(MASKW + (size_t)(i >> 1) * 256 + (i & 1) * 2) = o; } }
    if (lane == 0) { THR[m] = key2f(prefix); KCUT[m] = kcut; SELCNT[m] = 256; }
    WAVE_SYNC();
}
__device__ __forceinline__ void dsa_naive_one(int m, int lane, float* sq, float* sc, int* ssel, unsigned char* ws, const float* __restrict__ rel_bias) {
    const bf16_t* P = (const bf16_t*)(ws + WS_P); const int* SELCNT = (const int*)(ws + WS_SELCNT); const int* SEL = (const int*)(ws + WS_SEL);
    bf16_t* AOBO = (bf16_t*)(ws + WS_AOBO);
    const int b = m / SEQ, tpos = m % SEQ; const int cnt = SELCNT[m];
    { const int hc = lane * 8; const u32x4_t q = *(const u32x4_t*)(P + (PL_BQ + (hc >> 8)) * PLANE + (size_t)m * 256 + (hc & 255));
      sq[hc + 0] = bflo(q.x); sq[hc + 1] = bfhi(q.x); sq[hc + 2] = bflo(q.y); sq[hc + 3] = bfhi(q.y); sq[hc + 4] = bflo(q.z); sq[hc + 5] = bfhi(q.z); sq[hc + 6] = bflo(q.w); sq[hc + 7] = bfhi(q.w); }
    for (int j = lane; j < 256; j += 64) ssel[j] = (j < cnt) ? SEL[(size_t)m * 256 + j] : 0;
    WAVE_SYNC();
    for (int jj = 0; jj < 4; ++jj) { const int j = jj * 64 + lane;
        if (j < cnt) { const int s = ssel[j]; const size_t ms = (size_t)(b * SEQ + s); const int bk = t5_bucket(s - tpos);
            for (int h = 0; h < 8; ++h) { const bf16_t* kr = P + (PL_BK + (h >> 2)) * PLANE + ms * 256 + (h & 3) * 64; float a = 0.f;
#pragma unroll
                for (int c = 0; c < 8; ++c) { const u32x4_t kv = *(const u32x4_t*)(kr + c * 8); const float* q = &sq[h * 64 + c * 8];
                    a += q[0] * bflo(kv.x) + q[1] * bfhi(kv.x) + q[2] * bflo(kv.y) + q[3] * bfhi(kv.y) + q[4] * bflo(kv.z) + q[5] * bfhi(kv.z) + q[6] * bflo(kv.w) + q[7] * bfhi(kv.w); }
                sc[h * 256 + j] = a + rel_bias[bk * 12 + 4 + h] * LOG2E; }
        } else { for (int h = 0; h < 8; ++h) sc[h * 256 + j] = -INFINITY; }
    }
    WAVE_SYNC();
    for (int h = 0; h < 8; ++h) { float v0 = sc[h * 256 + lane], v1 = sc[h * 256 + 64 + lane], v2 = sc[h * 256 + 128 + lane], v3 = sc[h * 256 + 192 + lane];
        const float mx = wave_max(fmaxf(fmaxf(v0, v1), fmaxf(v2, v3)));
        v0 = __builtin_amdgcn_exp2f(v0 - mx); v1 = __builtin_amdgcn_exp2f(v1 - mx); v2 = __builtin_amdgcn_exp2f(v2 - mx); v3 = __builtin_amdgcn_exp2f(v3 - mx);
        const float inv = 1.0f / wave_sum((v0 + v1) + (v2 + v3));
        sc[h * 256 + lane] = v0 * inv; sc[h * 256 + 64 + lane] = v1 * inv; sc[h * 256 + 128 + lane] = v2 * inv; sc[h * 256 + 192 + lane] = v3 * inv; }
    WAVE_SYNC();
    { const int hc = lane * 8, h = lane >> 3; float acc[8];
#pragma unroll
      for (int e = 0; e < 8; ++e) acc[e] = 0.f;
      for (int j = 0; j < cnt; ++j) { const float p = sc[h * 256 + j]; const int s = ssel[j];
          const u32x4_t vv = *(const u32x4_t*)(P + (PL_BV + (hc >> 8)) * PLANE + (size_t)(b * SEQ + s) * 256 + (hc & 255));
          acc[0] += p * bflo(vv.x); acc[1] += p * bfhi(vv.x); acc[2] += p * bflo(vv.y); acc[3] += p * bfhi(vv.y); acc[4] += p * bflo(vv.z); acc[5] += p * bfhi(vv.z); acc[6] += p * bflo(vv.w); acc[7] += p * bfhi(vv.w); }
      const u32x4_t g = *(const u32x4_t*)(P + (PL_BG + (hc >> 8)) * PLANE + (size_t)m * 256 + (hc & 255));
      u32x4_t o; o.x = pk2(acc[0] * bflo(g.x), acc[1] * bfhi(g.x)); o.y = pk2(acc[2] * bflo(g.y), acc[3] * bfhi(g.y)); o.z = pk2(acc[4] * bflo(g.z), acc[5] * bfhi(g.z)); o.w = pk2(acc[6] * bflo(g.w), acc[7] * bfhi(g.w));
      *(u32x4_t*)(AOBO + (size_t)m * DM + 512 + hc) = o; }
    WAVE_SYNC();
}
__device__ __forceinline__ float diff_lambda(int lane, const float* lq1, const float* lk1, const float* lq2, const float* lk2) {
    return expf(wave_sum(lq1[lane] * lk1[lane])) - expf(wave_sum(lq2[lane] * lk2[lane])) + LAMBDA_INIT; }
__device__ __forceinline__ void diff_naive_one(int m, int h, int lane, float* s1, float* s2, float* sq, float lam, unsigned char* ws, const float* __restrict__ rel_bias, const float* __restrict__ subln_w) {
    const bf16_t* P = (const bf16_t*)(ws + WS_P); bf16_t* AOBO = (bf16_t*)(ws + WS_AOBO);
    const int b = m / SEQ, tpos = m % SEQ, N = ((tpos >> 6) + 1) << 6;
    const int pq = h >> 1, co = (h & 1) * 128;
    { const unsigned q = *(const unsigned*)(P + (PL_AQ + pq) * PLANE + (size_t)m * 256 + co + lane * 2); sq[lane * 2] = bflo(q); sq[lane * 2 + 1] = bfhi(q); }
    WAVE_SYNC();
    float mx1 = -INFINITY, mx2 = -INFINITY;
    for (int i = 0; i < N / 64; ++i) { asm volatile("" ::: "memory"); const int s = i * 64 + lane; const bf16_t* kr = P + (PL_AK + pq) * PLANE + (size_t)(b * SEQ + s) * 256 + co;
        float d1 = 0.f, d2 = 0.f;
#pragma unroll
        for (int c = 0; c < 8; ++c) { const u32x4_t kv = *(const u32x4_t*)(kr + c * 8); const float* q = &sq[c * 8];
            d1 += q[0] * bflo(kv.x) + q[1] * bfhi(kv.x) + q[2] * bflo(kv.y) + q[3] * bfhi(kv.y) + q[4] * bflo(kv.z) + q[5] * bfhi(kv.z) + q[6] * bflo(kv.w) + q[7] * bfhi(kv.w); }
#pragma unroll
        for (int c = 0; c < 8; ++c) { const u32x4_t kv = *(const u32x4_t*)(kr + 64 + c * 8); const float* q = &sq[64 + c * 8];
            d2 += q[0] * bflo(kv.x) + q[1] * bfhi(kv.x) + q[2] * bflo(kv.y) + q[3] * bfhi(kv.y) + q[4] * bflo(kv.z) + q[5] * bfhi(kv.z) + q[6] * bflo(kv.w) + q[7] * bfhi(kv.w); }
        const float bias = rel_bias[t5_bucket(s - tpos) * 12 + h] * LOG2E;
        d1 += bias; d2 += bias; s1[s] = d1; s2[s] = d2; mx1 = fmaxf(mx1, d1); mx2 = fmaxf(mx2, d2); }
    mx1 = wave_max(mx1); mx2 = wave_max(mx2);
    float l1 = 0.f, l2 = 0.f;
    for (int i = 0; i < N / 64; ++i) { const int s = i * 64 + lane; const float p1 = __builtin_amdgcn_exp2f(s1[s] - mx1), p2 = __builtin_amdgcn_exp2f(s2[s] - mx2); s1[s] = p1; s2[s] = p2; l1 += p1; l2 += p2; }
    l1 = wave_sum(l1); l2 = wave_sum(l2);
    const float i1 = 1.0f / l1, i2 = lam / l2;
    for (int i = 0; i < N / 64; ++i) { const int s = i * 64 + lane; s1[s] = s1[s] * i1 - s2[s] * i2; }
    WAVE_SYNC();
    float a0 = 0.f, a1 = 0.f;
    const bf16_t* vb = P + (PL_AV + pq) * PLANE + (size_t)(b * SEQ) * 256 + co + lane * 2;
    for (int s = 0; s < N; ++s) { const float wv = s1[s]; const unsigned vv = *(const unsigned*)(vb + (size_t)s * 256); a0 += wv * bflo(vv); a1 += wv * bfhi(vv); }
    const float rstd = 1.0f / sqrtf(wave_sum(a0 * a0 + a1 * a1) * (1.0f / 128.0f) + EPS);
    const unsigned g = *(const unsigned*)(P + (PL_AG + pq) * PLANE + (size_t)m * 256 + co + lane * 2);
    const float o0 = a0 * rstd * subln_w[lane * 2] * ONE_M_LAMBDA * bflo(g), o1 = a1 * rstd * subln_w[lane * 2 + 1] * ONE_M_LAMBDA * bfhi(g);
    *(unsigned*)(AOBO + (size_t)m * DM + h * 128 + lane * 2) = pk2(o0, o1);
    WAVE_SYNC();
}
namespace dfa {
typedef short bf16x8 __attribute__((ext_vector_type(8)));
typedef short s16x4 __attribute__((ext_vector_type(4)));
typedef float f32x16 __attribute__((ext_vector_type(16)));
typedef LAS const char* lds_cptr;
constexpr int KBUF = 16384, VBUF = 16384;
constexpr int OFF_K = 0, OFF_V = 2 * KBUF, OFF_LUT = OFF_V + 2 * VBUF, OFF_X = OFF_LUT + 1024, LDS_NEED = OFF_X + 65536;
constexpr float THR = 8.0f;
__device__ __forceinline__ int crow(int r, int hi) { return (r & 3) + 8 * (r >> 2) + 4 * hi; }
__device__ __forceinline__ s16x4 vtr(lds_cptr p) { return __builtin_bit_cast(s16x4, __builtin_amdgcn_ds_read_tr16_b64_v4i16((LAS s16x4*)p)); }
__device__ __forceinline__ float swap_other_half(float v) { auto rr = __builtin_amdgcn_permlane32_swap(__float_as_uint(v), __float_as_uint(v), false, false); return __uint_as_float((threadIdx.x & 32) ? rr[0] : rr[1]); }

__device__ __forceinline__ void unit(unsigned char* lds, int b, int h, int cc, const bf16_t* P, bf16_t* AOBO, const float* __restrict__ rel_bias, const float* __restrict__ subln_w, float lam) {
    const int tid = threadIdx.x, lane = tid & 63, r32 = lane & 31, hi = lane >> 5;
    const int w = __builtin_amdgcn_readfirstlane(tid >> 6), j = w & 1, qs = w >> 1;
    const int cw = 2 * cc + (qs >> 1);
    const int NT = 2 * cc + 2, NTw = cw + 1;
    const size_t rowb = (size_t)b * SEQ;
    const bf16_t* Kg = P + (size_t)(PL_AK + (h >> 1)) * PLANE + rowb * 256 + (h & 1) * 128;
    const bf16_t* Vg = P + (size_t)(PL_AV + (h >> 1)) * PLANE + rowb * 256 + (h & 1) * 128;
    const bf16_t* Qg = P + (size_t)(PL_AQ + (h >> 1)) * PLANE + rowb * 256 + (h & 1) * 128;
    const bf16_t* Gg = P + (size_t)(PL_AG + (h >> 1)) * PLANE + rowb * 256 + (h & 1) * 128;
    LAS unsigned char* L = (LAS unsigned char*)lds;
    LAS float* lut = (LAS float*)(L + OFF_LUT);
    if (tid < 256) { const int rel = tid - 192; const float far = rel_bias[15 * 12 + h]; lut[tid] = (rel_bias[t5_bucket(rel) * 12 + h] - far) * LOG2E; }
#define DFA_DMA(t, buf) do { \
        _Pragma("unroll") for (int i_ = 0; i_ < 2; ++i_) { const int ch_ = 2 * w + i_; \
            __builtin_amdgcn_global_load_lds((const unsigned*)(Kg + (size_t)((t) * 64 + lane) * 256 + ch_ * 8), (LAS unsigned*)(L + OFF_K + (buf) * KBUF + ch_ * 1024), 16, 0, 0); } \
        _Pragma("unroll") for (int i_ = 0; i_ < 2; ++i_) { const int ii_ = 2 * w + i_, dq_ = ii_ >> 2, g_ = ii_ & 3; \
            __builtin_amdgcn_global_load_lds((const unsigned*)(Vg + (size_t)((t) * 64 + 16 * g_ + (lane >> 2)) * 256 + dq_ * 32 + (lane & 3) * 8), (LAS unsigned*)(L + OFF_V + (buf) * VBUF + dq_ * 4096 + g_ * 1024), 16, 0, 0); } \
    } while (0)
    DFA_DMA(0, 0);
    bf16x8 qf[4];
    { const bf16_t* qp = Qg + (size_t)(128 * cc + 32 * qs + r32) * 256 + 64 * j + 8 * hi;
#pragma unroll
      for (int d0 = 0; d0 < 4; ++d0) qf[d0] = *(const bf16x8*)(qp + 16 * d0); }
    f32x16 o[4];
#pragma unroll
    for (int dq = 0; dq < 4; ++dq)
#pragma unroll
        for (int r = 0; r < 16; ++r) o[dq][r] = 0.f;
    f32x16 negm;
#pragma unroll
    for (int r = 0; r < 16; ++r) negm[r] = 0.f;
    float mrun = 0.f, lsum = 0.f;
    const int koff = (8 * j + hi) * 1024 + r32 * 16;
    const int voff = ((lane >> 4) & 1) * 32 + (lane & 3) * 8 + (4 * hi + ((lane & 15) >> 2)) * 64;
    asm volatile("s_waitcnt vmcnt(0)" ::: "memory");
    __syncthreads();
    for (int t = 0; t < NT; ++t) {
        const int buf = t & 1;
        if (t + 1 < NT) DFA_DMA(t + 1, buf ^ 1);
        if (t < NTw) {
            const lds_cptr kb = (lds_cptr)(L + OFF_K + buf * KBUF + koff);
            f32x16 s0 = negm, s1 = negm;
#pragma unroll
            for (int d0 = 0; d0 < 4; ++d0) {
                const bf16x8 a0 = *(const LAS bf16x8*)(kb + d0 * 2048), a1 = *(const LAS bf16x8*)(kb + d0 * 2048 + 512);
                s0 = __builtin_amdgcn_mfma_f32_32x32x16_bf16(a0, qf[d0], s0, 0, 0, 0);
                s1 = __builtin_amdgcn_mfma_f32_32x32x16_bf16(a1, qf[d0], s1, 0, 0, 0);
            }
            if (t >= cw - 2) {
                const int base = 192 + 64 * (t - cw) - 32 * (qs & 1) - r32 + 4 * hi;
#pragma unroll
                for (int r = 0; r < 16; ++r) { const int kk = (r & 3) + 8 * (r >> 2); s0[r] += lut[base + kk]; s1[r] += lut[base + 32 + kk]; }
            }
            float tm = fmaxf(s0[0], s1[0]);
#pragma unroll
            for (int r = 1; r < 16; ++r) tm = fmaxf(tm, fmaxf(s0[r], s1[r]));
            tm = fmaxf(tm, swap_other_half(tm));
            const bool first = (t == 0);
            if (first || __any(tm > THR)) {
                const float dl = first ? tm : fmaxf(tm, 0.f);
                mrun += dl;
#pragma unroll
                for (int r = 0; r < 16; ++r) { s0[r] -= dl; s1[r] -= dl; negm[r] = -mrun; }
                const float al = __builtin_amdgcn_exp2f(-dl);
                lsum *= al;
                if (!first) {
#pragma unroll
                    for (int dq = 0; dq < 4; ++dq)
#pragma unroll
                        for (int r = 0; r < 16; ++r) o[dq][r] *= al;
                }
            }
            float ps = 0.f;
#pragma unroll
            for (int r = 0; r < 16; ++r) { s0[r] = __builtin_amdgcn_exp2f(s0[r]); s1[r] = __builtin_amdgcn_exp2f(s1[r]); ps += s0[r] + s1[r]; }
            lsum += ps;
            bf16x8 pf[4];
#pragma unroll
            for (int ks = 0; ks < 2; ++ks) {
                u32x4_t a, c;
                a.x = pk2(s0[8 * ks + 0], s0[8 * ks + 1]); a.y = pk2(s0[8 * ks + 2], s0[8 * ks + 3]); a.z = pk2(s0[8 * ks + 4], s0[8 * ks + 5]); a.w = pk2(s0[8 * ks + 6], s0[8 * ks + 7]);
                c.x = pk2(s1[8 * ks + 0], s1[8 * ks + 1]); c.y = pk2(s1[8 * ks + 2], s1[8 * ks + 3]); c.z = pk2(s1[8 * ks + 4], s1[8 * ks + 5]); c.w = pk2(s1[8 * ks + 6], s1[8 * ks + 7]);
                pf[ks] = __builtin_bit_cast(bf16x8, a); pf[2 + ks] = __builtin_bit_cast(bf16x8, c);
            }
            const lds_cptr vp = (lds_cptr)(L + OFF_V + buf * VBUF + voff);
#pragma unroll
            for (int dq = 0; dq < 4; ++dq)
#pragma unroll
                for (int ks = 0; ks < 4; ++ks) {
                    const s16x4 lo = vtr(vp + dq * 4096 + ks * 1024), hh = vtr(vp + dq * 4096 + ks * 1024 + 512);
                    const bf16x8 vf = {lo[0], lo[1], lo[2], lo[3], hh[0], hh[1], hh[2], hh[3]};
                    o[dq] = __builtin_amdgcn_mfma_f32_32x32x16_bf16(vf, pf[ks], o[dq], 0, 0, 0);
                }
        }
        asm volatile("s_waitcnt vmcnt(0)" ::: "memory");
        __syncthreads();
    }
#undef DFA_DMA
    const float ltot = lsum + swap_other_half(lsum);
    LAS float* X = (LAS float*)(L + OFF_X) + qs * 4096;
    if (j == 1) {
        const float sc = lam / ltot;
#pragma unroll
        for (int dq = 0; dq < 4; ++dq)
#pragma unroll
            for (int r = 0; r < 16; ++r) X[(dq * 16 + r) * 64 + lane] = o[dq][r] * sc;
    }
    __syncthreads();
    if (j == 0) {
        const float inv = 1.0f / ltot; float ss = 0.f;
#pragma unroll
        for (int dq = 0; dq < 4; ++dq)
#pragma unroll
            for (int r = 0; r < 16; ++r) { const float v = o[dq][r] * inv - X[(dq * 16 + r) * 64 + lane]; o[dq][r] = v; ss += v * v; }
        ss += swap_other_half(ss);
        const float rstd = ONE_M_LAMBDA / sqrtf(ss * (1.0f / 128.0f) + EPS);
        const size_t m = rowb + (size_t)(128 * cc + 32 * qs + r32);
        const bf16_t* gp = Gg + (m - rowb) * 256;
        bf16_t* op = AOBO + m * DM + h * 128;
#pragma unroll
        for (int dq = 0; dq < 4; ++dq)
#pragma unroll
            for (int g = 0; g < 4; ++g) { const int dv = 32 * dq + 8 * g + 4 * hi;
                const u32x2_t gv = *(const u32x2_t*)(gp + dv); const f32x4_t sw = *(const f32x4_t*)(subln_w + dv);
                u32x2_t ov; ov.x = pk2(o[dq][4 * g + 0] * rstd * sw.x * bflo(gv.x), o[dq][4 * g + 1] * rstd * sw.y * bfhi(gv.x));
                ov.y = pk2(o[dq][4 * g + 2] * rstd * sw.z * bflo(gv.y), o[dq][4 * g + 3] * rstd * sw.w * bfhi(gv.y));
                *(u32x2_t*)(op + dv) = ov; }
    }
    __syncthreads();
}
__device__ __forceinline__ void phase(unsigned char* lds, int blk, int G, const bf16_t* P, bf16_t* AOBO, const float* rel_bias, const float* subln_w, float lam) {
    if (G == 256) {
        const int x = blk & 7, i = blk >> 3;
        for (int k = 0; k < 4; ++k) { const int id = 4 * x + k; unit(lds, id >> 2, id & 3, (k & 1) ? 31 - i : i, P, AOBO, rel_bias, subln_w, lam); }
    } else {
        for (int u = blk; u < 32 * 32; u += G) unit(lds, (u >> 5) >> 2, (u >> 5) & 3, u & 31, P, AOBO, rel_bias, subln_w, lam);
    }
}
}
namespace dsa {
typedef short bf16x8 __attribute__((ext_vector_type(8)));
typedef short s16x4 __attribute__((ext_vector_type(4)));
typedef float f32x16 __attribute__((ext_vector_type(16)));
typedef LAS const char* lds_cptr;
constexpr int KBUF = 16384, VBUF = 16384;
constexpr int OFF_K = 0, OFF_V = 2 * KBUF, OFF_LUT = OFF_V + 2 * VBUF, LDS_NEED = OFF_LUT + 2048;
constexpr float THR = 8.0f;
__device__ __forceinline__ s16x4 vtr(lds_cptr p) { return __builtin_bit_cast(s16x4, __builtin_amdgcn_ds_read_tr16_b64_v4i16((LAS s16x4*)p)); }
__device__ __forceinline__ float swap_other_half(float v) { auto rr = __builtin_amdgcn_permlane32_swap(__float_as_uint(v), __float_as_uint(v), false, false); return __uint_as_float((threadIdx.x & 32) ? rr[0] : rr[1]); }

__device__ __forceinline__ void unit(unsigned char* lds, int b, int hg, int cc, const bf16_t* P, const unsigned* MASK, bf16_t* AOBO, const float* __restrict__ rel_bias) {
    const int tid = threadIdx.x, lane = tid & 63, r32 = lane & 31, hi = lane >> 5;
    const int w = __builtin_amdgcn_readfirstlane(tid >> 6), hl = w & 1, qs = w >> 1;
    const int cw = 2 * cc + (qs >> 1);
    const int NT = 2 * cc + 2, NTw = cw + 1;
    const int h = 2 * hg + hl;
    const size_t rowb = (size_t)b * SEQ;
    const int pl = hg >> 1, co = (hg & 1) * 128;
    const bf16_t* Kg = P + (size_t)(PL_BK + pl) * PLANE + rowb * 256 + co;
    const bf16_t* Vg = P + (size_t)(PL_BV + pl) * PLANE + rowb * 256 + co;
    const bf16_t* Qg = P + (size_t)(PL_BQ + pl) * PLANE + rowb * 256 + co;
    const bf16_t* Gg = P + (size_t)(PL_BG + pl) * PLANE + rowb * 256 + co;
    LAS unsigned char* L = (LAS unsigned char*)lds;
    LAS float* lut = (LAS float*)(L + OFF_LUT) + hl * 256;
    { const int hh = tid >> 8, rel = (tid & 255) - 192, hd = 4 + 2 * hg + hh; const float far = rel_bias[15 * 12 + hd];
      ((LAS float*)(L + OFF_LUT))[tid] = (rel_bias[t5_bucket(rel) * 12 + hd] - far) * LOG2E; }
#define DSA_DMA(t, buf) do { \
        _Pragma("unroll") for (int i_ = 0; i_ < 2; ++i_) { const int ch_ = 2 * w + i_; \
            __builtin_amdgcn_global_load_lds((const unsigned*)(Kg + (size_t)((t) * 64 + lane) * 256 + ch_ * 8), (LAS unsigned*)(L + OFF_K + (buf) * KBUF + ch_ * 1024), 16, 0, 0); } \
        _Pragma("unroll") for (int i_ = 0; i_ < 2; ++i_) { const int ii_ = 2 * w + i_, dq_ = ii_ >> 2, g_ = ii_ & 3; \
            __builtin_amdgcn_global_load_lds((const unsigned*)(Vg + (size_t)((t) * 64 + 16 * g_ + (lane >> 2)) * 256 + dq_ * 32 + (lane & 3) * 8), (LAS unsigned*)(L + OFF_V + (buf) * VBUF + dq_ * 4096 + g_ * 1024), 16, 0, 0); } \
    } while (0)
    DSA_DMA(0, 0);
    bf16x8 qf[4];
    { const bf16_t* qp = Qg + (size_t)(128 * cc + 32 * qs + r32) * 256 + 64 * hl + 8 * hi;
#pragma unroll
      for (int d0 = 0; d0 < 4; ++d0) qf[d0] = *(const bf16x8*)(qp + 16 * d0); }
    f32x16 o[2];
#pragma unroll
    for (int dq = 0; dq < 2; ++dq)
#pragma unroll
        for (int r = 0; r < 16; ++r) o[dq][r] = 0.f;
    f32x16 negm;
#pragma unroll
    for (int r = 0; r < 16; ++r) negm[r] = 0.f;
    float mrun = 0.f, lsum = 0.f;
    const int koff = (8 * hl + hi) * 1024 + r32 * 16;
    const int voff = ((lane >> 4) & 1) * 32 + (lane & 3) * 8 + (4 * hi + ((lane & 15) >> 2)) * 64 + 2 * hl * 4096;
    const u32x4_t* mrow = (const u32x4_t*)MASK + ((size_t)(b * 64 + cw) * 32) * 64 + (32 * (qs & 1) + r32);
    asm volatile("s_waitcnt vmcnt(0)" ::: "memory");
    __syncthreads();
    u32x4_t mw = {0u, 0u, 0u, 0u};
    for (int t = 0; t < NT; ++t) {
        const int buf = t & 1;
        if (t + 1 < NT) DSA_DMA(t + 1, buf ^ 1);
        if (t < NTw) {
            if ((t & 1) == 0) mw = mrow[(size_t)(t >> 1) * 64];
            const unsigned w0 = ((t & 1) ? mw.z : mw.x) >> (4 * hi), w1 = ((t & 1) ? mw.w : mw.y) >> (4 * hi);
            const lds_cptr kb = (lds_cptr)(L + OFF_K + buf * KBUF + koff);
            f32x16 s0 = negm, s1 = negm;
#pragma unroll
            for (int d0 = 0; d0 < 4; ++d0) {
                const bf16x8 a0 = *(const LAS bf16x8*)(kb + d0 * 2048), a1 = *(const LAS bf16x8*)(kb + d0 * 2048 + 512);
                s0 = __builtin_amdgcn_mfma_f32_32x32x16_bf16(a0, qf[d0], s0, 0, 0, 0);
                s1 = __builtin_amdgcn_mfma_f32_32x32x16_bf16(a1, qf[d0], s1, 0, 0, 0);
            }
            if (t >= cw - 2) {
                const int base = 192 + 64 * (t - cw) - 32 * (qs & 1) - r32 + 4 * hi;
#pragma unroll
                for (int r = 0; r < 16; ++r) { const int kk = (r & 3) + 8 * (r >> 2); s0[r] += lut[base + kk]; s1[r] += lut[base + 32 + kk]; }
            }
            float tm = fmaxf(s0[0], s1[0]);
#pragma unroll
            for (int r = 1; r < 16; ++r) tm = fmaxf(tm, fmaxf(s0[r], s1[r]));
            tm = fmaxf(tm, swap_other_half(tm));
            const bool first = (t == 0);
            if (first || __any(tm > THR)) {
                const float dl = first ? tm : fmaxf(tm, 0.f);
                mrun += dl;
#pragma unroll
                for (int r = 0; r < 16; ++r) { s0[r] -= dl; s1[r] -= dl; negm[r] = -mrun; }
                const float al = __builtin_amdgcn_exp2f(-dl);
                lsum *= al;
                if (!first) {
#pragma unroll
                    for (int dq = 0; dq < 2; ++dq)
#pragma unroll
                        for (int r = 0; r < 16; ++r) o[dq][r] *= al;
                }
            }
            float ps = 0.f;
#pragma unroll
            for (int r = 0; r < 16; ++r) { const int kk = (r & 3) + 8 * (r >> 2);
                const float e0 = __builtin_amdgcn_exp2f(s0[r]), e1 = __builtin_amdgcn_exp2f(s1[r]);
                s0[r] = ((w0 >> kk) & 1u) ? e0 : 0.f; s1[r] = ((w1 >> kk) & 1u) ? e1 : 0.f; ps += s0[r] + s1[r]; }
            lsum += ps;
            bf16x8 pf[4];
#pragma unroll
            for (int ks = 0; ks < 2; ++ks) {
                u32x4_t a, c;
                a.x = pk2(s0[8 * ks + 0], s0[8 * ks + 1]); a.y = pk2(s0[8 * ks + 2], s0[8 * ks + 3]); a.z = pk2(s0[8 * ks + 4], s0[8 * ks + 5]); a.w = pk2(s0[8 * ks + 6], s0[8 * ks + 7]);
                c.x = pk2(s1[8 * ks + 0], s1[8 * ks + 1]); c.y = pk2(s1[8 * ks + 2], s1[8 * ks + 3]); c.z = pk2(s1[8 * ks + 4], s1[8 * ks + 5]); c.w = pk2(s1[8 * ks + 6], s1[8 * ks + 7]);
                pf[ks] = __builtin_bit_cast(bf16x8, a); pf[2 + ks] = __builtin_bit_cast(bf16x8, c);
            }
            const lds_cptr vp = (lds_cptr)(L + OFF_V + buf * VBUF + voff);
#pragma unroll
            for (int dq = 0; dq < 2; ++dq)
#pragma unroll
                for (int ks = 0; ks < 4; ++ks) {
                    const s16x4 lo = vtr(vp + dq * 4096 + ks * 1024), hh = vtr(vp + dq * 4096 + ks * 1024 + 512);
                    const bf16x8 vf = {lo[0], lo[1], lo[2], lo[3], hh[0], hh[1], hh[2], hh[3]};
                    o[dq] = __builtin_amdgcn_mfma_f32_32x32x16_bf16(vf, pf[ks], o[dq], 0, 0, 0);
                }
        }
        asm volatile("s_waitcnt vmcnt(0)" ::: "memory");
        __syncthreads();
    }
#undef DSA_DMA
    {
        const float inv = 1.0f / (lsum + swap_other_half(lsum));
        const size_t m = rowb + (size_t)(128 * cc + 32 * qs + r32);
        const bf16_t* gp = Gg + (m - rowb) * 256 + 64 * hl;
        bf16_t* op = AOBO + m * DM + 512 + h * 64;
#pragma unroll
        for (int dq = 0; dq < 2; ++dq)
#pragma unroll
            for (int g = 0; g < 4; ++g) { const int dv = 32 * dq + 8 * g + 4 * hi;
                const u32x2_t gv = *(const u32x2_t*)(gp + dv);
                u32x2_t ov; ov.x = pk2(o[dq][4 * g + 0] * inv * bflo(gv.x), o[dq][4 * g + 1] * inv * bfhi(gv.x));
                ov.y = pk2(o[dq][4 * g + 2] * inv * bflo(gv.y), o[dq][4 * g + 3] * inv * bfhi(gv.y));
                *(u32x2_t*)(op + dv) = ov; }
    }
    __syncthreads();
}
__device__ __forceinline__ void phase(unsigned char* lds, int blk, int G, const bf16_t* P, const unsigned* MASK, bf16_t* AOBO, const float* rel_bias) {
    if (G == 256) {
        const int x = blk & 7, i = blk >> 3;
        for (int k = 0; k < 4; ++k) { const int id = 4 * x + k; unit(lds, id >> 2, id & 3, (k & 1) ? 31 - i : i, P, MASK, AOBO, rel_bias); }
    } else {
        for (int u = blk; u < 32 * 32; u += G) unit(lds, (u >> 5) >> 2, (u >> 5) & 3, u & 31, P, MASK, AOBO, rel_bias);
    }
}
}
constexpr int LDS_MAIN = 139264;
constexpr int MISC_OFF = LDS_MAIN, LDS_BYTES = LDS_MAIN + 64;
constexpr size_t BAR_BYTES = (size_t)XCD_BAR_WORDS * 4;
struct Args { const float* in[11]; float* out; unsigned char* ws; };

__global__ void __launch_bounds__(512, 2) fwd(Args a) {
    extern __shared__ __attribute__((aligned(16))) unsigned char lds[];
    const int tid = threadIdx.x, lane = tid & 63, wave = __builtin_amdgcn_readfirstlane(tid >> 6);
    volatile LAS unsigned* misc = (volatile LAS unsigned*)((LAS unsigned char*)lds + MISC_OFF);
    if (tid < 16) misc[tid] = 0u;
    __syncthreads();
    XcdBarrier bar = xcd_barrier_post((unsigned*)a.ws, misc);
    const int G = gridDim.x, gw = blockIdx.x * 8 + wave, ngw = G * 8;
    unsigned char* ws = a.ws;
    const float* x = a.in[0]; const float* rel_bias = a.in[9];
    prologue_body(gw, ngw, lane, x, a.in[1], a.in[2], a.in[3], (bf16_t*)(ws + WS_H), (float*)(ws + WS_IW), (bf16_t*)(ws + WS_WINT), (bf16_t*)(ws + WS_WOUTT));
    xcd_barrier(bar);
    { pg8::Gemm g{(const bf16_t*)(ws + WS_H), (const bf16_t*)(ws + WS_WINT), MT, NPAD, DM}; pg8::StaticOrder S; S.init(MT, NPAD, G, (int)blockIdx.x);
      pg8::EpiProj E{(bf16_t*)(ws + WS_P)};
      pg8::gemm_phase<pg8::EpiProj, pg8::StaticOrder, true, true>((PG8_LAS unsigned char*)lds, g, S, E); }
    xcd_barrier(bar);
    { unsigned* skey = (unsigned*)(lds + wave * 17408); float* sq = (float*)(lds + wave * 17408 + 16384);
      for (int m = gw; m < MT; m += ngw) sel_naive_one(m, lane, skey, sq, ws); }
    xcd_barrier(bar);
    dsa::phase(lds, (int)blockIdx.x, G, (const bf16_t*)(ws + WS_P), (const unsigned*)(ws + WS_MASK), (bf16_t*)(ws + WS_AOBO), rel_bias);
    __syncthreads();
    { const float lam = diff_lambda(lane, a.in[4], a.in[5], a.in[6], a.in[7]);
      dfa::phase(lds, (int)blockIdx.x, G, (const bf16_t*)(ws + WS_P), (bf16_t*)(ws + WS_AOBO), rel_bias, a.in[8], lam); }
    xcd_barrier(bar);
    { pg8::Gemm g{(const bf16_t*)(ws + WS_AOBO), (const bf16_t*)(ws + WS_WOUTT), MT, DM, DM}; pg8::StaticOrder S; S.init(MT, DM, G, (int)blockIdx.x);
      pg8::EpiOut E{x, a.out};
      pg8::gemm_phase<pg8::EpiOut, pg8::StaticOrder, true, true>((PG8_LAS unsigned char*)lds, g, S, E); }
    xcd_barrier(bar);
    final_norm_body(gw, ngw, lane, a.out, a.in[10]);
}

extern "C" void kernel_launch(void* const* d_in, const int* in_sizes, int n_in, void* d_out, int out_size, void* d_ws, size_t ws_size, hipStream_t stream) {
    static int grid = 0;
    if (grid == 0) {
        if (n_in != 11 || out_size != MT * DM || ws_size < WS_END) { fprintf(stderr, "kernel_launch: unexpected shapes (n_in %d out %d ws %zu need %zu)\n", n_in, out_size, ws_size, (size_t)WS_END); grid = -1; return; }
        int dev = 0, cus = 0, per_cu = 0;
        if (hipGetDevice(&dev) != hipSuccess || hipDeviceGetAttribute(&cus, hipDeviceAttributeMultiprocessorCount, dev) != hipSuccess) { grid = -1; return; }
        if (hipFuncSetAttribute((const void*)fwd, hipFuncAttributeMaxDynamicSharedMemorySize, LDS_BYTES) != hipSuccess) { fprintf(stderr, "kernel_launch: hipFuncSetAttribute failed\n"); grid = -1; return; }
        if (hipOccupancyMaxActiveBlocksPerMultiprocessor(&per_cu, (const void*)fwd, 512, LDS_BYTES) != hipSuccess || per_cu < 1) { fprintf(stderr, "kernel_launch: occupancy query says %d blocks per CU\n", per_cu); (void)hipGetLastError(); }
        grid = cus;
    }
    if (grid < 0) return;
    if (hipMemsetAsync(d_ws, 0, BAR_BYTES, stream) != hipSuccess) { fprintf(stderr, "kernel_launch: memset failed\n"); return; }
    Args a; memset(&a, 0, sizeof(a));
    for (int i = 0; i < 11; ++i) a.in[i] = (const float*)d_in[i];
    a.out = (float*)d_out; a.ws = (unsigned char*)d_ws;
    hipLaunchKernelGGL(fwd, dim3(grid), dim3(512), LDS_BYTES, stream, a);
}
```

```cpp
#include <hip/hip_runtime.h>
#include <cstdio>
#include <cstdint>
#include <cstring>
#include <cmath>
#define LAS __attribute__((address_space(3)))
typedef unsigned short bf16_t;
typedef unsigned u32x4_t __attribute__((ext_vector_type(4)));
typedef unsigned u32x2_t __attribute__((ext_vector_type(2)));
typedef float f32x4_t __attribute__((ext_vector_type(4)));

constexpr int DM = 1024, NBATCH = 8, SEQ = 4096, MT = NBATCH * SEQ;
constexpr int D_IN = 4420, NPAD = 4608, NPLANES = 18;
constexpr float EPS = 1e-6f, LOG2E = 1.4426950408889634f;
constexpr float C2 = 0.125f * LOG2E;
constexpr float IDX_SCALE = 0.0625f;
constexpr float LAMBDA_INIT = 0.2f, ONE_M_LAMBDA = 0.8f;
constexpr size_t PLANE = (size_t)MT * 256;
constexpr int PL_AQ = 0, PL_AK = 2, PL_AV = 4, PL_AG = 6, PL_BQ = 8, PL_BK = 10, PL_BV = 12, PL_BG = 14, PL_IQ = 16, PL_IK = 17;

constexpr size_t WS_CTL = 0;
constexpr size_t WS_WINT = 65536;
constexpr size_t WS_WOUTT = WS_WINT + (size_t)NPAD * DM * 2;
constexpr size_t WS_H = WS_WOUTT + (size_t)DM * DM * 2;
constexpr size_t WS_P = WS_H + (size_t)MT * DM * 2;
constexpr size_t WS_IW = WS_P + (size_t)NPLANES * PLANE * 2;
constexpr size_t WS_THR = WS_IW + (size_t)MT * 16;
constexpr size_t WS_KCUT = WS_THR + (size_t)MT * 4;
constexpr size_t WS_SELCNT = WS_KCUT + (size_t)MT * 4;
constexpr size_t WS_AOBO = WS_SELCNT + (size_t)MT * 4;
constexpr size_t WS_SEL = WS_AOBO + (size_t)MT * DM * 2;
constexpr size_t WS_MASK = WS_SEL + (size_t)MT * 256 * 4;
constexpr size_t WS_END = WS_MASK + (size_t)NBATCH * 64 * 32 * 64 * 16;

__device__ __forceinline__ float bf2f(bf16_t v) { return __uint_as_float(((unsigned)v) << 16); }
__device__ __forceinline__ float bflo(unsigned w) { return __uint_as_float(w << 16); }
__device__ __forceinline__ float bfhi(unsigned w) { return __uint_as_float(w & 0xffff0000u); }
__device__ __forceinline__ unsigned pk2(float lo, float hi) {
    typedef float f2 __attribute__((ext_vector_type(2))); typedef __bf16 b2 __attribute__((ext_vector_type(2)));
    f2 v = {lo, hi}; b2 b = __builtin_convertvector(v, b2); return __builtin_bit_cast(unsigned, b); }
__device__ __forceinline__ float wave_sum(float v) {
#pragma unroll
    for (int o = 1; o < 64; o <<= 1) v += __shfl_xor(v, o);
    return v; }
__device__ __forceinline__ int wave_sum_i(int v) {
#pragma unroll
    for (int o = 1; o < 64; o <<= 1) v += __shfl_xor(v, o);
    return v; }
__device__ __forceinline__ float wave_max(float v) {
#pragma unroll
    for (int o = 1; o < 64; o <<= 1) v = fmaxf(v, __shfl_xor(v, o));
    return v; }
__device__ __forceinline__ int t5_bucket(int rel) {
    const int ret = rel > 0 ? 16 : 0; const int n = rel < 0 ? -rel : rel;
    if (n < 8) return ret + n;
    int large = 2 + (31 - __builtin_clz((unsigned)(n * n))); large = large > 15 ? 15 : large;
    return ret + large; }
__device__ __forceinline__ unsigned f2key(float f) { const unsigned u = __float_as_uint(f); return (u & 0x80000000u) ? ~u : (u | 0x80000000u); }
__device__ __forceinline__ float key2f(unsigned k) { return __uint_as_float((k & 0x80000000u) ? (k ^ 0x80000000u) : ~k); }
__device__ __forceinline__ float silu_f(float v) { return v * __builtin_amdgcn_rcpf(1.0f + __builtin_amdgcn_exp2f(-v * LOG2E)); }
namespace pg8 {
#define PG8_LAS __attribute__((address_space(3)))
typedef unsigned short bf16_t;
typedef short bf16x8 __attribute__((ext_vector_type(8)));
typedef float f32x4 __attribute__((ext_vector_type(4)));
typedef unsigned u32x4 __attribute__((ext_vector_type(4)));
constexpr int BM = 256, BK = 64, HALF = 128, HTB = HALF * BK * 2  , STAGE_BYTES = 8 * HTB, NXCD = 8, WGM = 8;

__host__ __device__ __forceinline__ int lds_byte(int r, int c) { const int st = (r >> 4) * 2 + (c >> 5), rr = r & 15, cc = c & 31, ob = rr * 64 + cc * 2; return st * 1024 + (ob ^ (((ob >> 9) & 1) << 5)); }
__host__ __device__ __forceinline__ void stage_rc(int b, int& R, int& C) { const int st = b / 1024, sb = b % 1024, swz = sb ^ (((sb >> 9) & 1) << 5); R = (st >> 1) * 16 + swz / 64; C = (st & 1) * 32 + (swz % 64) / 2; }
__host__ __device__ __forceinline__ int perm32(int rho) { const int n = rho >> 4, i = rho & 15; return 8 * (i >> 2) + 4 * n + (i & 3); }

struct Unit { int pm, pn; };
struct Gemm { const bf16_t* A; const bf16_t* Bt; int M, N, K; };

struct StaticOrder {
    int nM, nN, nwg, G, c;
    __host__ __device__ void init(int M, int N, int G_, int c_) { nM = M / BM; nN = N / BM; nwg = nM * nN; G = G_; c = c_; }
    __host__ __device__ bool next(int i, Unit& u) const {
        const long L = (long)i * G + c; if (L >= nwg) return false;
        int wgid = (int)L; { const int q = nwg / NXCD, r = nwg % NXCD, xcd = wgid % NXCD, off = wgid / NXCD; wgid = (xcd < r ? xcd * (q + 1) : r * (q + 1) + (xcd - r) * q) + off; }
        const int nig = WGM * nN, gid = wgid / nig, fm = gid * WGM, gsz = (nM - fm) < WGM ? (nM - fm) : WGM;
        u.pm = fm + ((wgid % nig) % gsz); u.pn = (wgid % nig) / gsz; return true;
    }
    __device__ __forceinline__ void a_ready(const Unit&) const {}
    __device__ __forceinline__ void done(const Unit&) const {}
};

__device__ __forceinline__ unsigned cvt_pk_bf16(float lo, float hi) { unsigned r; asm volatile("v_cvt_pk_bf16_f32 %0, %1, %2" : "=v"(r) : "v"(lo), "v"(hi)); return r; }
template <class Epi, class Sched, bool ALIGN_EPI = false, bool SP2 = false>
__device__ __forceinline__ void gemm_phase(PG8_LAS unsigned char* lds, const Gemm g, const Sched& S, const Epi& E) {
    const int tid = threadIdx.x, wid = __builtin_amdgcn_readfirstlane(tid >> 6), lane = tid & 63, wr = wid >> 2, wc = wid & 3, fr = lane & 15, fq = lane >> 4;
    const int K = g.K, nt = K / BK;
    unsigned voffA[2], voffB[2];
#pragma unroll
    for (int i = 0; i < 2; ++i) { int R, C; stage_rc(tid * 16 + i * 8192, R, C); const int Rb = Epi::PERM ? ((R & ~31) + perm32(R & 31)) : R;
        voffA[i] = (unsigned)(R * K + C) * 2u; voffB[i] = (unsigned)(Rb * K + C) * 2u; }
    const size_t kstep = (size_t)(BK * 2);
    const size_t hstep = (size_t)HALF * K * 2;
    const size_t tstep = 2 * hstep;
    const unsigned ldsw = (unsigned)wid * 1024u;
    const int aoff = lds_byte(wr * 64 + fr, fq * 8), boff = lds_byte(wc * 32 + fr, fq * 8);
#define PG8_SA(b, h) (((b) * 2 + (h)) * HTB)
#define PG8_SB(b, h) ((4 + (b) * 2 + (h)) * HTB)
#define PG8_STAGE(bufoff, gbase, voff) do { _Pragma("unroll") for (int _i = 0; _i < 2; ++_i) \
        __builtin_amdgcn_global_load_lds((const unsigned*)((const char*)(gbase) + (voff)[_i]), (PG8_LAS unsigned*)(lds + (bufoff) + ldsw + _i * 8192), 16, 0, 0); } while (0)
#define PG8_LDA(dst, b, h) do { _Pragma("unroll") for (int m = 0; m < 4; ++m) _Pragma("unroll") for (int k = 0; k < 2; ++k) dst[m][k] = *(const PG8_LAS bf16x8*)(lds + PG8_SA(b, h) + aoff + m * 2048 + k * 1024); } while (0)
#define PG8_LDB(dst, b, h) do { _Pragma("unroll") for (int n = 0; n < 2; ++n) _Pragma("unroll") for (int k = 0; k < 2; ++k) dst[n][k] = *(const PG8_LAS bf16x8*)(lds + PG8_SB(b, h) + boff + n * 2048 + k * 1024); } while (0)
#define PG8_MMA(ai, bj, At, Bt) do { __builtin_amdgcn_s_setprio(1); _Pragma("unroll") for (int m = 0; m < 4; ++m) _Pragma("unroll") for (int n = 0; n < 2; ++n) _Pragma("unroll") for (int k = 0; k < 2; ++k) \
        acc[ai][bj][m][n] = __builtin_amdgcn_mfma_f32_16x16x32_bf16(Bt[n][k], At[m][k], acc[ai][bj][m][n], 0, 0, 0); __builtin_amdgcn_s_setprio(0); } while (0)
#define PG8_WAIT_V(n) asm volatile("s_waitcnt vmcnt(" #n ")" ::: "memory")
#define PG8_WAIT_L(n) asm volatile("s_waitcnt lgkmcnt(" #n ")" ::: "memory")
#define PG8_BAR __builtin_amdgcn_s_barrier()
#define PG8_SCHED __builtin_amdgcn_sched_barrier(0)
    Unit cur, nxt; int ui = 0;
    if (!S.next(0, cur)) return;
    f32x4 acc[2][2][4][2];
#pragma unroll
    for (int a = 0; a < 2; ++a)
#pragma unroll
        for (int b = 0; b < 2; ++b)
#pragma unroll
            for (int m = 0; m < 4; ++m)
#pragma unroll
                for (int n = 0; n < 2; ++n) acc[a][b][m][n] = (f32x4){0.f, 0.f, 0.f, 0.f};
    bf16x8 At[4][2], B0[2][2], B1[2][2];
    const char* cA = (const char*)g.A + (size_t)cur.pm * tstep; const char* cB = (const char*)g.Bt + (size_t)cur.pn * tstep;
    S.a_ready(cur);
    if constexpr (SP2) {
        PG8_STAGE(PG8_SB(0, 0), cB, voffB); PG8_STAGE(PG8_SB(0, 1), cB + hstep, voffB); PG8_STAGE(PG8_SA(0, 0), cA, voffA); PG8_STAGE(PG8_SA(0, 1), cA + hstep, voffA);
        if (wr == 1) PG8_BAR;
        PG8_WAIT_V(2); PG8_BAR;
        PG8_STAGE(PG8_SB(1, 0), cB + kstep, voffB); PG8_STAGE(PG8_SA(1, 0), cA + kstep, voffA); PG8_STAGE(PG8_SB(1, 1), cB + hstep + kstep, voffB);
        PG8_WAIT_V(6); PG8_BAR;
    } else {
        PG8_STAGE(PG8_SB(0, 0), cB, voffB); PG8_STAGE(PG8_SA(0, 0), cA, voffA); PG8_STAGE(PG8_SB(0, 1), cB + hstep, voffB); PG8_STAGE(PG8_SA(0, 1), cA + hstep, voffA);
        if (wr == 1) PG8_BAR;
        PG8_WAIT_V(4); PG8_BAR;
        PG8_STAGE(PG8_SB(1, 0), cB + kstep, voffB); PG8_STAGE(PG8_SA(1, 0), cA + kstep, voffA); PG8_STAGE(PG8_SB(1, 1), cB + hstep + kstep, voffB);
        PG8_WAIT_V(6); PG8_BAR;
    }
    for (;;) {
        const bool has_next = S.next(ui + 1, nxt);
        const char* nA = has_next ? (const char*)g.A + (size_t)nxt.pm * tstep : cA; const char* nB = has_next ? (const char*)g.Bt + (size_t)nxt.pn * tstep : cB;
        for (int t = 0; t < nt; t += 2) {
            const bool last = (t == nt - 2);
            const char* a1 = cA + (size_t)(t + 1) * kstep;
            const char* a2 = last ? nA : cA + (size_t)(t + 2) * kstep; const char* b2 = last ? nB : cB + (size_t)(t + 2) * kstep;
            const char* a3 = a2 + kstep; const char* b3 = b2 + kstep;
            if (last && has_next) S.a_ready(nxt);
            if constexpr (SP2) {
            PG8_LDB(B0, 0, 0); PG8_LDB(B1, 0, 1); PG8_SCHED; PG8_LDA(At, 0, 0); PG8_STAGE(PG8_SA(1, 1), a1 + hstep, voffA);
            PG8_WAIT_V(8); PG8_WAIT_L(0); PG8_BAR; PG8_MMA(0, 0, At, B0); PG8_MMA(0, 1, At, B1); PG8_BAR; PG8_SCHED;
            PG8_LDA(At, 0, 1); PG8_STAGE(PG8_SB(0, 0), b2, voffB); PG8_STAGE(PG8_SB(0, 1), b2 + hstep, voffB); PG8_STAGE(PG8_SA(0, 0), a2, voffA);
            PG8_WAIT_V(8); PG8_WAIT_L(0); PG8_BAR; PG8_MMA(1, 0, At, B0); PG8_MMA(1, 1, At, B1); PG8_BAR; PG8_SCHED;
            PG8_LDB(B0, 1, 0); PG8_LDB(B1, 1, 1); PG8_SCHED; PG8_LDA(At, 1, 0); PG8_STAGE(PG8_SA(0, 1), a2 + hstep, voffA);
            PG8_WAIT_V(8); PG8_WAIT_L(0); PG8_BAR; PG8_MMA(0, 0, At, B0); PG8_MMA(0, 1, At, B1); PG8_BAR; PG8_SCHED;
            PG8_LDA(At, 1, 1); PG8_STAGE(PG8_SB(1, 0), b3, voffB); PG8_STAGE(PG8_SB(1, 1), b3 + hstep, voffB); PG8_STAGE(PG8_SA(1, 0), a3, voffA);
            PG8_WAIT_V(8); PG8_WAIT_L(0); PG8_BAR; PG8_MMA(1, 0, At, B0); PG8_MMA(1, 1, At, B1); PG8_BAR; PG8_SCHED;
            } else {
            PG8_LDB(B0, 0, 0); PG8_SCHED; PG8_LDA(At, 0, 0); PG8_STAGE(PG8_SA(1, 1), a1 + hstep, voffA);
            PG8_WAIT_L(8); PG8_BAR; PG8_WAIT_L(0); PG8_MMA(0, 0, At, B0); PG8_BAR; PG8_SCHED;
            PG8_LDB(B1, 0, 1); PG8_STAGE(PG8_SB(0, 0), b2, voffB);
            PG8_BAR; PG8_WAIT_L(0); PG8_MMA(0, 1, At, B1); PG8_BAR;
            PG8_LDA(At, 0, 1); PG8_STAGE(PG8_SA(0, 0), a2, voffA);
            PG8_BAR; PG8_WAIT_L(0); PG8_MMA(1, 0, At, B0); PG8_BAR; PG8_SCHED;
            PG8_STAGE(PG8_SB(0, 1), b2 + hstep, voffB);
            PG8_WAIT_V(6); PG8_BAR; PG8_MMA(1, 1, At, B1); PG8_BAR;
            PG8_LDB(B0, 1, 0); PG8_SCHED; PG8_LDA(At, 1, 0); PG8_STAGE(PG8_SA(0, 1), a2 + hstep, voffA);
            PG8_WAIT_L(8); PG8_BAR; PG8_WAIT_L(0); PG8_MMA(0, 0, At, B0); PG8_BAR; PG8_SCHED;
            PG8_LDB(B1, 1, 1); PG8_STAGE(PG8_SB(1, 0), b3, voffB);
            PG8_BAR; PG8_WAIT_L(0); PG8_MMA(0, 1, At, B1); PG8_BAR;
            PG8_LDA(At, 1, 1); PG8_STAGE(PG8_SA(1, 0), a3, voffA);
            PG8_BAR; PG8_WAIT_L(0); PG8_MMA(1, 0, At, B0); PG8_BAR; PG8_SCHED;
            PG8_STAGE(PG8_SB(1, 1), b3 + hstep, voffB);
            PG8_WAIT_V(6); PG8_BAR; PG8_MMA(1, 1, At, B1); PG8_BAR;
            }
        }
        if constexpr (ALIGN_EPI) { if (wr == 0) PG8_BAR; }
        if constexpr (!Epi::AFTER_DRAIN) { E(acc, cur, wr, wc, fr, fq); S.done(cur); }
        if (!has_next) break;
#pragma unroll
        for (int a = 0; a < 2; ++a)
#pragma unroll
            for (int b = 0; b < 2; ++b)
#pragma unroll
                for (int m = 0; m < 4; ++m)
#pragma unroll
                    for (int n = 0; n < 2; ++n) acc[a][b][m][n] = (f32x4){0.f, 0.f, 0.f, 0.f};
        cur = nxt; cA = nA; cB = nB; ++ui;
        if constexpr (ALIGN_EPI) { if (wr == 1) PG8_BAR; }
    }
    PG8_WAIT_V(0);
    if constexpr (!ALIGN_EPI) { if (wr == 0) PG8_BAR; }
    PG8_BAR;
    if constexpr (Epi::AFTER_DRAIN) { E.fused(acc, cur, wr, wc, fr, fq, lds, wid, lane); S.done(cur); }
#undef PG8_SA
#undef PG8_SB
#undef PG8_STAGE
#undef PG8_LDA
#undef PG8_LDB
#undef PG8_MMA
#undef PG8_WAIT_V
#undef PG8_WAIT_L
#undef PG8_BAR
#undef PG8_SCHED
}
}
namespace pg8 {
struct EpiProj {
    static constexpr bool PERM = true, AFTER_DRAIN = false;
    bf16_t* P;
    __device__ __forceinline__ void operator()(const f32x4 (&acc)[2][2][4][2], const Unit& u, int wr, int wc, int fr, int fq) const {
        const int row0 = u.pm * BM + wr * 64 + fr, col0 = wc * 32 + 8 * fq, pl = u.pn;
        bf16_t* base = P + (size_t)pl * ((size_t)MT * 256);
        const int mode = (pl < 2 || pl == 8 || pl == 9) ? 1 : ((pl == 6 || pl == 7 || pl == 14 || pl == 15) ? 2 : 0);
#pragma unroll
        for (int ai = 0; ai < 2; ++ai)
#pragma unroll
            for (int m = 0; m < 4; ++m) { bf16_t* rowp = base + (size_t)(row0 + ai * HALF + m * 16) * 256 + col0;
#pragma unroll
                for (int bj = 0; bj < 2; ++bj) { f32x4 v0 = acc[ai][bj][m][0], v1 = acc[ai][bj][m][1];
                    if (mode == 1) { v0 = v0 * C2; v1 = v1 * C2; }
                    if (mode == 2) {
#pragma unroll
                        for (int j = 0; j < 4; ++j) { v0[j] = silu_f(v0[j]); v1[j] = silu_f(v1[j]); } }
                    u32x4 w; w.x = cvt_pk_bf16(v0[0], v0[1]); w.y = cvt_pk_bf16(v0[2], v0[3]); w.z = cvt_pk_bf16(v1[0], v1[1]); w.w = cvt_pk_bf16(v1[2], v1[3]);
                    *(u32x4*)(rowp + bj * HALF) = w; } }
    }
};
struct EpiOut {
    static constexpr bool PERM = false, AFTER_DRAIN = false;
    const float* X; float* O;
    __device__ __forceinline__ void operator()(const f32x4 (&acc)[2][2][4][2], const Unit& u, int wr, int wc, int fr, int fq) const {
        const int row0 = u.pm * BM + wr * 64 + fr, col0 = u.pn * BM + wc * 32 + 4 * fq;
#pragma unroll
        for (int ai = 0; ai < 2; ++ai)
#pragma unroll
            for (int m = 0; m < 4; ++m) { const size_t off = (size_t)(row0 + ai * HALF + m * 16) * DM + col0;
#pragma unroll
                for (int bj = 0; bj < 2; ++bj)
#pragma unroll
                    for (int n = 0; n < 2; ++n) { const f32x4 xv = *(const f32x4*)(X + off + bj * HALF + n * 16); *(f32x4*)(O + off + bj * HALF + n * 16) = xv + acc[ai][bj][m][n]; } }
    }
};
}
#include <cstdlib>
#include <vector>

#define XB_TMO      128
#define XB_XCNT(j)  (256  + 64 * (j))
#define XB_XSUB(j)  (1280 + 64 * (j))
#define XB_XGEN(j)  (2304 + 64 * (j))
#define XB_TOP      3328
#define XB_TOPGEN   3392
#define XCD_BAR_WORDS 3456
#define XB_SPIN_CAP (1u << 18)
#define LAS __attribute__((address_space(3)))

__device__ __forceinline__ unsigned xb_ld(unsigned* p)              { return __hip_atomic_load(p, __ATOMIC_RELAXED, __HIP_MEMORY_SCOPE_AGENT); }
__device__ __forceinline__ unsigned xb_add(unsigned* p, unsigned v) { return __hip_atomic_fetch_add(p, v, __ATOMIC_RELAXED, __HIP_MEMORY_SCOPE_AGENT); }
__device__ __forceinline__ unsigned xb_xcc_id() { return (unsigned)__builtin_amdgcn_s_getreg((3 << 11) | 20) & 0xFu; }
#define XB_SPIN(cond, bar) do { unsigned _sp = 0; while (cond) { __builtin_amdgcn_s_sleep(1); \
    if ((++_sp & 255u) == 0u) { if (xb_ld(&(bar)[XB_TMO])) break; if (_sp > XB_SPIN_CAP) { atomicAdd(&(bar)[XB_TMO], 1u); break; } } } } while (0)

struct XcdBarrier {
    unsigned* bar; unsigned x;
    volatile LAS unsigned* st;
};

__device__ __forceinline__ XcdBarrier xcd_barrier_post(unsigned* bar, volatile LAS unsigned* st) {
    XcdBarrier b; b.bar = bar; b.x = xb_xcc_id(); b.st = st;
    if (threadIdx.x == 0) (void)xb_add(&bar[XB_XCNT(b.x)], 1u);
    return b;
}
__device__ __forceinline__ void xcd_barrier_complete(unsigned* bar, unsigned x, unsigned& nloc, unsigned& nx) {
    const unsigned G = gridDim.x * gridDim.y * gridDim.z;
    unsigned sum, cnt, mine, sp = 0u;
    for (;;) {
        sum = 0u; cnt = 0u; mine = 0u;
#pragma unroll
        for (unsigned j = 0; j < 16; ++j) { const unsigned c = xb_ld(&bar[XB_XCNT(j)]); sum += c; cnt += (c > 0u) ? 1u : 0u; mine = (j == x) ? c : mine; }
        if (sum == G) break;
        __builtin_amdgcn_s_sleep(1);
        if ((++sp & 255u) == 0u) { if (xb_ld(&bar[XB_TMO])) break; if (sp > XB_SPIN_CAP) { atomicAdd(&bar[XB_TMO], 1u); break; } }
    }
    nloc = mine > 0u ? mine : 1u; nx = cnt > 0u ? cnt : 1u;
}

__device__ __forceinline__ void xcd_barrier(const XcdBarrier& b) {
    asm volatile("s_waitcnt vmcnt(0)" ::: "memory");
    __syncthreads();
    if (threadIdx.x == 0) {
        unsigned* bar = b.bar;
        __builtin_amdgcn_s_waitcnt(0);
        unsigned nloc = b.st[0], nx = b.st[1];
        if (nloc == 0u) { xcd_barrier_complete(bar, b.x, nloc, nx); b.st[0] = nloc; b.st[1] = nx; }
        const unsigned old = xb_add(&bar[XB_XSUB(b.x)], 1u);
        const unsigned gen = old / nloc;
        if (old + 1u == (gen + 1u) * nloc) {
            __builtin_amdgcn_fence(__ATOMIC_RELEASE, "agent");
            asm volatile("s_waitcnt vmcnt(0)" ::: "memory");
            const unsigned og = xb_add(&bar[XB_TOP], 1u);
            const unsigned tg = og / nx;
            if (og + 1u == (tg + 1u) * nx) xb_add(&bar[XB_TOPGEN], 1u);
            else XB_SPIN(xb_ld(&bar[XB_TOPGEN]) == tg, bar);
            __builtin_amdgcn_fence(__ATOMIC_ACQUIRE, "agent");
            xb_add(&bar[XB_XGEN(b.x)], 1u);
            asm volatile("s_waitcnt vmcnt(0)" ::: "memory");
        } else {
            XB_SPIN(xb_ld(&bar[XB_XGEN(b.x)]) == gen, bar);
            __builtin_amdgcn_fence(__ATOMIC_ACQUIRE, "agent");
            asm volatile("s_waitcnt vmcnt(0)" ::: "memory");
        }
    }
    __syncthreads();
}
__device__ __forceinline__ void prologue_body(int gw, int ngw, int lane, const float* __restrict__ x, const float* __restrict__ norm_w, const float* __restrict__ w_in,
                                              const float* __restrict__ w_out, bf16_t* H, float* IW, bf16_t* WinT, bf16_t* WoutT) {
    for (int m = gw; m < MT; m += ngw) {
        const f32x4_t* xr = (const f32x4_t*)(x + (size_t)m * DM) + lane;
        f32x4_t v[4]; float s = 0.f;
#pragma unroll
        for (int j = 0; j < 4; ++j) { v[j] = xr[64 * j]; s += (v[j].x * v[j].x + v[j].y * v[j].y) + (v[j].z * v[j].z + v[j].w * v[j].w); }
        const float rstd = 1.0f / sqrtf(wave_sum(s) * (1.0f / DM) + EPS);
        float a0 = 0.f, a1 = 0.f, a2 = 0.f, a3 = 0.f;
        u32x2_t* o8 = (u32x2_t*)(H + (size_t)m * DM) + lane;
#pragma unroll
        for (int j = 0; j < 4; ++j) {
            const f32x4_t w = ((const f32x4_t*)norm_w)[64 * j + lane];
            f32x4_t hv; hv.x = v[j].x * rstd * w.x; hv.y = v[j].y * rstd * w.y; hv.z = v[j].z * rstd * w.z; hv.w = v[j].w * rstd * w.w;
            const int d = 256 * j + 4 * lane;
            const f32x4_t w0 = *(const f32x4_t*)(w_in + (size_t)(d + 0) * D_IN + 4416), w1 = *(const f32x4_t*)(w_in + (size_t)(d + 1) * D_IN + 4416);
            const f32x4_t w2 = *(const f32x4_t*)(w_in + (size_t)(d + 2) * D_IN + 4416), w3 = *(const f32x4_t*)(w_in + (size_t)(d + 3) * D_IN + 4416);
            a0 += hv.x * w0.x + hv.y * w1.x + hv.z * w2.x + hv.w * w3.x;
            a1 += hv.x * w0.y + hv.y * w1.y + hv.z * w2.y + hv.w * w3.y;
            a2 += hv.x * w0.z + hv.y * w1.z + hv.z * w2.z + hv.w * w3.z;
            a3 += hv.x * w0.w + hv.y * w1.w + hv.z * w2.w + hv.w * w3.w;
            u32x2_t o; o.x = pk2(hv.x, hv.y); o.y = pk2(hv.z, hv.w); o8[64 * j] = o;
        }
        a0 = wave_sum(a0); a1 = wave_sum(a1); a2 = wave_sum(a2); a3 = wave_sum(a3);
        if (lane == 0) { f32x4_t o = {a0, a1, a2, a3}; *(f32x4_t*)(IW + (size_t)m * 4) = o; }
    }
    const long tid = (long)gw * 64 + lane, nth = (long)ngw * 64;
    for (long i = tid; i < (long)NPAD * (DM / 8); i += nth) {
        const int n = (int)(i % NPAD), k8 = (int)(i / NPAD);
        float e[8];
#pragma unroll
        for (int q = 0; q < 8; ++q) e[q] = (n < D_IN) ? w_in[(size_t)(k8 * 8 + q) * D_IN + n] : 0.f;
        u32x4_t o; o.x = pk2(e[0], e[1]); o.y = pk2(e[2], e[3]); o.z = pk2(e[4], e[5]); o.w = pk2(e[6], e[7]);
        *(u32x4_t*)(WinT + (size_t)n * DM + k8 * 8) = o;
    }
    for (long i = tid; i < (long)DM * (DM / 8); i += nth) {
        const int n = (int)(i % DM), k8 = (int)(i / DM);
        float e[8];
#pragma unroll
        for (int q = 0; q < 8; ++q) e[q] = w_out[(size_t)(k8 * 8 + q) * DM + n];
        u32x4_t o; o.x = pk2(e[0], e[1]); o.y = pk2(e[2], e[3]); o.z = pk2(e[4], e[5]); o.w = pk2(e[6], e[7]);
        *(u32x4_t*)(WoutT + (size_t)n * DM + k8 * 8) = o;
    }
}
__device__ __forceinline__ void final_norm_body(int gw, int ngw, int lane, float* out, const float* __restrict__ fw) {
    for (int m = gw; m < MT; m += ngw) {
        f32x4_t* xr = (f32x4_t*)(out + (size_t)m * DM) + lane;
        f32x4_t v[4]; float s = 0.f;
#pragma unroll
        for (int j = 0; j < 4; ++j) { v[j] = xr[64 * j]; s += (v[j].x * v[j].x + v[j].y * v[j].y) + (v[j].z * v[j].z + v[j].w * v[j].w); }
        const float rstd = 1.0f / sqrtf(wave_sum(s) * (1.0f / DM) + EPS);
#pragma unroll
        for (int j = 0; j < 4; ++j) { const f32x4_t w = ((const f32x4_t*)fw)[64 * j + lane]; f32x4_t o;
            o.x = v[j].x * rstd * w.x; o.y = v[j].y * rstd * w.y; o.z = v[j].z * rstd * w.z; o.w = v[j].w * rstd * w.w; xr[64 * j] = o; }
    }
}

#define WAVE_SYNC() asm volatile("s_waitcnt vmcnt(0) lgkmcnt(0)" ::: "memory")
__device__ __forceinline__ void sel_naive_one(int m, int lane, unsigned* skey, float* sq, unsigned char* ws) {
    const bf16_t* P = (const bf16_t*)(ws + WS_P); const float* IW = (const float*)(ws + WS_IW);
    float* THR = (float*)(ws + WS_THR); int* KCUT = (int*)(ws + WS_KCUT); int* SELCNT = (int*)(ws + WS_SELCNT); int* SEL = (int*)(ws + WS_SEL);
    const int b = m / SEQ, tpos = m % SEQ, N = ((tpos >> 6) + 1) << 6;
    int* sel = SEL + (size_t)m * 256;
    unsigned* MASKW = (unsigned*)(ws + WS_MASK) + ((size_t)(b * 64 + (tpos >> 6)) * 32 * 64 + (tpos & 63)) * 4;
    if (N <= 256) {
        for (int j = lane; j < N; j += 64) sel[j] = j;
        if (lane < N / 64) { u32x2_t o = {0xffffffffu, 0xffffffffu}; *(u32x2_t*)(MASKW + (size_t)(lane >> 1) * 256 + (lane & 1) * 2) = o; }
        if (lane == 0) { THR[m] = -INFINITY; KCUT[m] = 0x7fffffff; SELCNT[m] = N; }
        return;
    }
    { const u32x2_t q = *(const u32x2_t*)(P + PL_IQ * PLANE + (size_t)m * 256 + lane * 4);
      sq[lane * 4 + 0] = bflo(q.x); sq[lane * 4 + 1] = bfhi(q.x); sq[lane * 4 + 2] = bflo(q.y); sq[lane * 4 + 3] = bfhi(q.y); }
    const f32x4_t iw = *(const f32x4_t*)(IW + (size_t)m * 4);
    const float wg0 = iw.x * IDX_SCALE, wg1 = iw.y * IDX_SCALE, wg2 = iw.z * IDX_SCALE, wg3 = iw.w * IDX_SCALE;
    WAVE_SYNC();
    for (int i = 0; i < N / 64; ++i) {
        asm volatile("" ::: "memory");
        const int s = i * 64 + lane; const bf16_t* kr = P + PL_IK * PLANE + (size_t)(b * SEQ + s) * 256;
        float l0 = 0.f, l1 = 0.f, l2 = 0.f, l3 = 0.f;
#pragma unroll
        for (int c = 0; c < 8; ++c) { const u32x4_t kv = *(const u32x4_t*)(kr + c * 8);
            const float k[8] = {bflo(kv.x), bfhi(kv.x), bflo(kv.y), bfhi(kv.y), bflo(kv.z), bfhi(kv.z), bflo(kv.w), bfhi(kv.w)};
#pragma unroll
            for (int e = 0; e < 8; ++e) { const int d = c * 8 + e; l0 += sq[d] * k[e]; l1 += sq[64 + d] * k[e]; l2 += sq[128 + d] * k[e]; l3 += sq[192 + d] * k[e]; } }
        float sc = wg0 * fmaxf(l0, 0.f) + wg1 * fmaxf(l1, 0.f) + wg2 * fmaxf(l2, 0.f) + wg3 * fmaxf(l3, 0.f);
        sc += 0.0f;
        skey[s] = f2key(sc);
    }
    WAVE_SYNC();
    unsigned prefix = 0u;
    for (int bit = 31; bit >= 0; --bit) { const unsigned cand = prefix | (1u << bit); int c = 0;
        for (int i = 0; i < N / 64; ++i) c += (skey[i * 64 + lane] >= cand) ? 1 : 0;
        c = wave_sum_i(c); if (c >= 256) prefix = cand; }
    int cgt = 0; for (int i = 0; i < N / 64; ++i) cgt += (skey[i * 64 + lane] > prefix) ? 1 : 0;
    cgt = wave_sum_i(cgt);
    const int r = 256 - cgt;
    int run = 0, kcut = 0x7fffffff;
    for (int i = 0; i < N / 64; ++i) { const unsigned long long bm = __ballot(skey[i * 64 + lane] == prefix); const int c = __popcll(bm);
        if (run + c >= r) { unsigned long long t = bm; for (int q = 0; q < r - run - 1; ++q) t &= t - 1; kcut = i * 64 + (int)__builtin_ctzll(t); break; }
        run += c; }
    int base = 0;
    for (int i = 0; i < N / 64; ++i) { const unsigned k = skey[i * 64 + lane]; const int idx = i * 64 + lane; const bool f = (k > prefix) || (k == prefix && idx <= kcut);
        const unsigned long long bm = __ballot(f); const int pos = base + __popcll(bm & ((1ull << lane) - 1ull)); if (f && pos < 256) sel[pos] = idx; base += __popcll(bm);
        if (lane == 0) { u32x2_t o = {(unsigned)bm, (unsigned)(bm >> 32)}; *(u32x2_t*)(MASKW + (size_t)(i >> 1) * 256 + (i & 1) * 2) = o; } }
    if (lane == 0) { THR[m] = key2f(prefix); KCUT[m] = kcut; SELCNT[m] = 256; }
    WAVE_SYNC();
}
__device__ __forceinline__ void dsa_naive_one(int m, int lane, float* sq, float* sc, int* ssel, unsigned char* ws, const float* __restrict__ rel_bias) {
    const bf16_t* P = (const bf16_t*)(ws + WS_P); const int* SELCNT = (const int*)(ws + WS_SELCNT); const int* SEL = (const int*)(ws + WS_SEL);
    bf16_t* AOBO = (bf16_t*)(ws + WS_AOBO);
    const int b = m / SEQ, tpos = m % SEQ; const int cnt = SELCNT[m];
    { const int hc = lane * 8; const u32x4_t q = *(const u32x4_t*)(P + (PL_BQ + (hc >> 8)) * PLANE + (size_t)m * 256 + (hc & 255));
      sq[hc + 0] = bflo(q.x); sq[hc + 1] = bfhi(q.x); sq[hc + 2] = bflo(q.y); sq[hc + 3] = bfhi(q.y); sq[hc + 4] = bflo(q.z); sq[hc + 5] = bfhi(q.z); sq[hc + 6] = bflo(q.w); sq[hc + 7] = bfhi(q.w); }
    for (int j = lane; j < 256; j += 64) ssel[j] = (j < cnt) ? SEL[(size_t)m * 256 + j] : 0;
    WAVE_SYNC();
    for (int jj = 0; jj < 4; ++jj) { const int j = jj * 64 + lane;
        if (j < cnt) { const int s = ssel[j]; const size_t ms = (size_t)(b * SEQ + s); const int bk = t5_bucket(s - tpos);
            for (int h = 0; h < 8; ++h) { const bf16_t* kr = P + (PL_BK + (h >> 2)) * PLANE + ms * 256 + (h & 3) * 64; float a = 0.f;
#pragma unroll
                for (int c = 0; c < 8; ++c) { const u32x4_t kv = *(const u32x4_t*)(kr + c * 8); const float* q = &sq[h * 64 + c * 8];
                    a += q[0] * bflo(kv.x) + q[1] * bfhi(kv.x) + q[2] * bflo(kv.y) + q[3] * bfhi(kv.y) + q[4] * bflo(kv.z) + q[5] * bfhi(kv.z) + q[6] * bflo(kv.w) + q[7] * bfhi(kv.w); }
                sc[h * 256 + j] = a + rel_bias[bk * 12 + 4 + h] * LOG2E; }
        } else { for (int h = 0; h < 8; ++h) sc[h * 256 + j] = -INFINITY; }
    }
    WAVE_SYNC();
    for (int h = 0; h < 8; ++h) { float v0 = sc[h * 256 + lane], v1 = sc[h * 256 + 64 + lane], v2 = sc[h * 256 + 128 + lane], v3 = sc[h * 256 + 192 + lane];
        const float mx = wave_max(fmaxf(fmaxf(v0, v1), fmaxf(v2, v3)));
        v0 = __builtin_amdgcn_exp2f(v0 - mx); v1 = __builtin_amdgcn_exp2f(v1 - mx); v2 = __builtin_amdgcn_exp2f(v2 - mx); v3 = __builtin_amdgcn_exp2f(v3 - mx);
        const float inv = 1.0f / wave_sum((v0 + v1) + (v2 + v3));
        sc[h * 256 + lane] = v0 * inv; sc[h * 256 + 64 + lane] = v1 * inv; sc[h * 256 + 128 + lane] = v2 * inv; sc[h * 256 + 192 + lane] = v3 * inv; }
    WAVE_SYNC();
    { const int hc = lane * 8, h = lane >> 3; float acc[8];
#pragma unroll
      for (int e = 0; e < 8; ++e) acc[e] = 0.f;
      for (int j = 0; j < cnt; ++j) { const float p = sc[h * 256 + j]; const int s = ssel[j];
          const u32x4_t vv = *(const u32x4_t*)(P + (PL_BV + (hc >> 8)) * PLANE + (size_t)(b * SEQ + s) * 256 + (hc & 255));
          acc[0] += p * bflo(vv.x); acc[1] += p * bfhi(vv.x); acc[2] += p * bflo(vv.y); acc[3] += p * bfhi(vv.y); acc[4] += p * bflo(vv.z); acc[5] += p * bfhi(vv.z); acc[6] += p * bflo(vv.w); acc[7] += p * bfhi(vv.w); }
      const u32x4_t g = *(const u32x4_t*)(P + (PL_BG + (hc >> 8)) * PLANE + (size_t)m * 256 + (hc & 255));
      u32x4_t o; o.x = pk2(acc[0] * bflo(g.x), acc[1] * bfhi(g.x)); o.y = pk2(acc[2] * bflo(g.y), acc[3] * bfhi(g.y)); o.z = pk2(acc[4] * bflo(g.z), acc[5] * bfhi(g.z)); o.w = pk2(acc[6] * bflo(g.w), acc[7] * bfhi(g.w));
      *(u32x4_t*)(AOBO + (size_t)m * DM + 512 + hc) = o; }
    WAVE_SYNC();
}
__device__ __forceinline__ float diff_lambda(int lane, const float* lq1, const float* lk1, const float* lq2, const float* lk2) {
    return expf(wave_sum(lq1[lane] * lk1[lane])) - expf(wave_sum(lq2[lane] * lk2[lane])) + LAMBDA_INIT; }
__device__ __forceinline__ void diff_naive_one(int m, int h, int lane, float* s1, float* s2, float* sq, float lam, unsigned char* ws, const float* __restrict__ rel_bias, const float* __restrict__ subln_w) {
    const bf16_t* P = (const bf16_t*)(ws + WS_P); bf16_t* AOBO = (bf16_t*)(ws + WS_AOBO);
    const int b = m / SEQ, tpos = m % SEQ, N = ((tpos >> 6) + 1) << 6;
    const int pq = h >> 1, co = (h & 1) * 128;
    { const unsigned q = *(const unsigned*)(P + (PL_AQ + pq) * PLANE + (size_t)m * 256 + co + lane * 2); sq[lane * 2] = bflo(q); sq[lane * 2 + 1] = bfhi(q); }
    WAVE_SYNC();
    float mx1 = -INFINITY, mx2 = -INFINITY;
    for (int i = 0; i < N / 64; ++i) { asm volatile("" ::: "memory"); const int s = i * 64 + lane; const bf16_t* kr = P + (PL_AK + pq) * PLANE + (size_t)(b * SEQ + s) * 256 + co;
        float d1 = 0.f, d2 = 0.f;
#pragma unroll
        for (int c = 0; c < 8; ++c) { const u32x4_t kv = *(const u32x4_t*)(kr + c * 8); const float* q = &sq[c * 8];
            d1 += q[0] * bflo(kv.x) + q[1] * bfhi(kv.x) + q[2] * bflo(kv.y) + q[3] * bfhi(kv.y) + q[4] * bflo(kv.z) + q[5] * bfhi(kv.z) + q[6] * bflo(kv.w) + q[7] * bfhi(kv.w); }
#pragma unroll
        for (int c = 0; c < 8; ++c) { const u32x4_t kv = *(const u32x4_t*)(kr + 64 + c * 8); const float* q = &sq[64 + c * 8];
            d2 += q[0] * bflo(kv.x) + q[1] * bfhi(kv.x) + q[2] * bflo(kv.y) + q[3] * bfhi(kv.y) + q[4] * bflo(kv.z) + q[5] * bfhi(kv.z) + q[6] * bflo(kv.w) + q[7] * bfhi(kv.w); }
        const float bias = rel_bias[t5_bucket(s - tpos) * 12 + h] * LOG2E;
        d1 += bias; d2 += bias; s1[s] = d1; s2[s] = d2; mx1 = fmaxf(mx1, d1); mx2 = fmaxf(mx2, d2); }
    mx1 = wave_max(mx1); mx2 = wave_max(mx2);
    float l1 = 0.f, l2 = 0.f;
    for (int i = 0; i < N / 64; ++i) { const int s = i * 64 + lane; const float p1 = __builtin_amdgcn_exp2f(s1[s] - mx1), p2 = __builtin_amdgcn_exp2f(s2[s] - mx2); s1[s] = p1; s2[s] = p2; l1 += p1; l2 += p2; }
    l1 = wave_sum(l1); l2 = wave_sum(l2);
    const float i1 = 1.0f / l1, i2 = lam / l2;
    for (int i = 0; i < N / 64; ++i) { const int s = i * 64 + lane; s1[s] = s1[s] * i1 - s2[s] * i2; }
    WAVE_SYNC();
    float a0 = 0.f, a1 = 0.f;
    const bf16_t* vb = P + (PL_AV + pq) * PLANE + (size_t)(b * SEQ) * 256 + co + lane * 2;
    for (int s = 0; s < N; ++s) { const float wv = s1[s]; const unsigned vv = *(const unsigned*)(vb + (size_t)s * 256); a0 += wv * bflo(vv); a1 += wv * bfhi(vv); }
    const float rstd = 1.0f / sqrtf(wave_sum(a0 * a0 + a1 * a1) * (1.0f / 128.0f) + EPS);
    const unsigned g = *(const unsigned*)(P + (PL_AG + pq) * PLANE + (size_t)m * 256 + co + lane * 2);
    const float o0 = a0 * rstd * subln_w[lane * 2] * ONE_M_LAMBDA * bflo(g), o1 = a1 * rstd * subln_w[lane * 2 + 1] * ONE_M_LAMBDA * bfhi(g);
    *(unsigned*)(AOBO + (size_t)m * DM + h * 128 + lane * 2) = pk2(o0, o1);
    WAVE_SYNC();
}
namespace dfa {
typedef short bf16x8 __attribute__((ext_vector_type(8)));
typedef short s16x4 __attribute__((ext_vector_type(4)));
typedef float f32x16 __attribute__((ext_vector_type(16)));
typedef LAS const char* lds_cptr;
constexpr int KBUF = 16384, VBUF = 16384;
constexpr int OFF_K = 0, OFF_V = 2 * KBUF, OFF_LUT = OFF_V + 2 * VBUF, OFF_X = OFF_LUT + 1024, LDS_NEED = OFF_X + 65536;
constexpr float THR = 8.0f;
__device__ __forceinline__ int crow(int r, int hi) { return (r & 3) + 8 * (r >> 2) + 4 * hi; }
__device__ __forceinline__ s16x4 vtr(lds_cptr p) { return __builtin_bit_cast(s16x4, __builtin_amdgcn_ds_read_tr16_b64_v4i16((LAS s16x4*)p)); }
__device__ __forceinline__ float swap_other_half(float v) { auto rr = __builtin_amdgcn_permlane32_swap(__float_as_uint(v), __float_as_uint(v), false, false); return __uint_as_float((threadIdx.x & 32) ? rr[0] : rr[1]); }

__device__ __forceinline__ void unit(unsigned char* lds, int b, int h, int cc, const bf16_t* P, bf16_t* AOBO, const float* __restrict__ rel_bias, const float* __restrict__ subln_w, float lam) {
    const int tid = threadIdx.x, lane = tid & 63, r32 = lane & 31, hi = lane >> 5;
    const int w = __builtin_amdgcn_readfirstlane(tid >> 6), j = w & 1, qs = w >> 1;
    const int cw = 2 * cc + (qs >> 1);
    const int NT = 2 * cc + 2, NTw = cw + 1;
    const size_t rowb = (size_t)b * SEQ;
    const bf16_t* Kg = P + (size_t)(PL_AK + (h >> 1)) * PLANE + rowb * 256 + (h & 1) * 128;
    const bf16_t* Vg = P + (size_t)(PL_AV + (h >> 1)) * PLANE + rowb * 256 + (h & 1) * 128;
    const bf16_t* Qg = P + (size_t)(PL_AQ + (h >> 1)) * PLANE + rowb * 256 + (h & 1) * 128;
    const bf16_t* Gg = P + (size_t)(PL_AG + (h >> 1)) * PLANE + rowb * 256 + (h & 1) * 128;
    LAS unsigned char* L = (LAS unsigned char*)lds;
    LAS float* lut = (LAS float*)(L + OFF_LUT);
    if (tid < 256) { const int rel = tid - 192; const float far = rel_bias[15 * 12 + h]; lut[tid] = (rel_bias[t5_bucket(rel) * 12 + h] - far) * LOG2E; }
#define DFA_DMA(t, buf) do { \
        _Pragma("unroll") for (int i_ = 0; i_ < 2; ++i_) { const int ch_ = 2 * w + i_; \
            __builtin_amdgcn_global_load_lds((const unsigned*)(Kg + (size_t)((t) * 64 + lane) * 256 + ch_ * 8), (LAS unsigned*)(L + OFF_K + (buf) * KBUF + ch_ * 1024), 16, 0, 0); } \
        _Pragma("unroll") for (int i_ = 0; i_ < 2; ++i_) { const int ii_ = 2 * w + i_, dq_ = ii_ >> 2, g_ = ii_ & 3; \
            __builtin_amdgcn_global_load_lds((const unsigned*)(Vg + (size_t)((t) * 64 + 16 * g_ + (lane >> 2)) * 256 + dq_ * 32 + (lane & 3) * 8), (LAS unsigned*)(L + OFF_V + (buf) * VBUF + dq_ * 4096 + g_ * 1024), 16, 0, 0); } \
    } while (0)
    DFA_DMA(0, 0);
    bf16x8 qf[4];
    { const bf16_t* qp = Qg + (size_t)(128 * cc + 32 * qs + r32) * 256 + 64 * j + 8 * hi;
#pragma unroll
      for (int d0 = 0; d0 < 4; ++d0) qf[d0] = *(const bf16x8*)(qp + 16 * d0); }
    f32x16 o[4];
#pragma unroll
    for (int dq = 0; dq < 4; ++dq)
#pragma unroll
        for (int r = 0; r < 16; ++r) o[dq][r] = 0.f;
    f32x16 negm;
#pragma unroll
    for (int r = 0; r < 16; ++r) negm[r] = 0.f;
    float mrun = 0.f, lsum = 0.f;
    const int koff = (8 * j + hi) * 1024 + r32 * 16;
    const int voff = ((lane >> 4) & 1) * 32 + (lane & 3) * 8 + (4 * hi + ((lane & 15) >> 2)) * 64;
    asm volatile("s_waitcnt vmcnt(0)" ::: "memory");
    __syncthreads();
    for (int t = 0; t < NT; ++t) {
        const int buf = t & 1;
        if (t + 1 < NT) DFA_DMA(t + 1, buf ^ 1);
        if (t < NTw) {
            const lds_cptr kb = (lds_cptr)(L + OFF_K + buf * KBUF + koff);
            f32x16 s0 = negm, s1 = negm;
#pragma unroll
            for (int d0 = 0; d0 < 4; ++d0) {
                const bf16x8 a0 = *(const LAS bf16x8*)(kb + d0 * 2048), a1 = *(const LAS bf16x8*)(kb + d0 * 2048 + 512);
                s0 = __builtin_amdgcn_mfma_f32_32x32x16_bf16(a0, qf[d0], s0, 0, 0, 0);
                s1 = __builtin_amdgcn_mfma_f32_32x32x16_bf16(a1, qf[d0], s1, 0, 0, 0);
            }
            if (t >= cw - 2) {
                const int base = 192 + 64 * (t - cw) - 32 * (qs & 1) - r32 + 4 * hi;
#pragma unroll
                for (int r = 0; r < 16; ++r) { const int kk = (r & 3) + 8 * (r >> 2); s0[r] += lut[base + kk]; s1[r] += lut[base + 32 + kk]; }
            }
            float tm = fmaxf(s0[0], s1[0]);
#pragma unroll
            for (int r = 1; r < 16; ++r) tm = fmaxf(tm, fmaxf(s0[r], s1[r]));
            tm = fmaxf(tm, swap_other_half(tm));
            const bool first = (t == 0);
            if (first || __any(tm > THR)) {
                const float dl = first ? tm : fmaxf(tm, 0.f);
                mrun += dl;
#pragma unroll
                for (int r = 0; r < 16; ++r) { s0[r] -= dl; s1[r] -= dl; negm[r] = -mrun; }
                const float al = __builtin_amdgcn_exp2f(-dl);
                lsum *= al;
                if (!first) {
#pragma unroll
                    for (int dq = 0; dq < 4; ++dq)
#pragma unroll
                        for (int r = 0; r < 16; ++r) o[dq][r] *= al;
                }
            }
            float ps = 0.f;
#pragma unroll
            for (int r = 0; r < 16; ++r) { s0[r] = __builtin_amdgcn_exp2f(s0[r]); s1[r] = __builtin_amdgcn_exp2f(s1[r]); ps += s0[r] + s1[r]; }
            lsum += ps;
            bf16x8 pf[4];
#pragma unroll
            for (int ks = 0; ks < 2; ++ks) {
                u32x4_t a, c;
                a.x = pk2(s0[8 * ks + 0], s0[8 * ks + 1]); a.y = pk2(s0[8 * ks + 2], s0[8 * ks + 3]); a.z = pk2(s0[8 * ks + 4], s0[8 * ks + 5]); a.w = pk2(s0[8 * ks + 6], s0[8 * ks + 7]);
                c.x = pk2(s1[8 * ks + 0], s1[8 * ks + 1]); c.y = pk2(s1[8 * ks + 2], s1[8 * ks + 3]); c.z = pk2(s1[8 * ks + 4], s1[8 * ks + 5]); c.w = pk2(s1[8 * ks + 6], s1[8 * ks + 7]);
                pf[ks] = __builtin_bit_cast(bf16x8, a); pf[2 + ks] = __builtin_bit_cast(bf16x8, c);
            }
            const lds_cptr vp = (lds_cptr)(L + OFF_V + buf * VBUF + voff);
#pragma unroll
            for (int dq = 0; dq < 4; ++dq)
#pragma unroll
                for (int ks = 0; ks < 4; ++ks) {
                    const s16x4 lo = vtr(vp + dq * 4096 + ks * 1024), hh = vtr(vp + dq * 4096 + ks * 1024 + 512);
                    const bf16x8 vf = {lo[0], lo[1], lo[2], lo[3], hh[0], hh[1], hh[2], hh[3]};
                    o[dq] = __builtin_amdgcn_mfma_f32_32x32x16_bf16(vf, pf[ks], o[dq], 0, 0, 0);
                }
        }
        asm volatile("s_waitcnt vmcnt(0)" ::: "memory");
        __syncthreads();
    }
#undef DFA_DMA
    const float ltot = lsum + swap_other_half(lsum);
    LAS float* X = (LAS float*)(L + OFF_X) + qs * 4096;
    if (j == 1) {
        const float sc = lam / ltot;
#pragma unroll
        for (int dq = 0; dq < 4; ++dq)
#pragma unroll
            for (int r = 0; r < 16; ++r) X[(dq * 16 + r) * 64 + lane] = o[dq][r] * sc;
    }
    __syncthreads();
    if (j == 0) {
        const float inv = 1.0f / ltot; float ss = 0.f;
#pragma unroll
        for (int dq = 0; dq < 4; ++dq)
#pragma unroll
            for (int r = 0; r < 16; ++r) { const float v = o[dq][r] * inv - X[(dq * 16 + r) * 64 + lane]; o[dq][r] = v; ss += v * v; }
        ss += swap_other_half(ss);
        const float rstd = ONE_M_LAMBDA / sqrtf(ss * (1.0f / 128.0f) + EPS);
        const size_t m = rowb + (size_t)(128 * cc + 32 * qs + r32);
        const bf16_t* gp = Gg + (m - rowb) * 256;
        bf16_t* op = AOBO + m * DM + h * 128;
#pragma unroll
        for (int dq = 0; dq < 4; ++dq)
#pragma unroll
            for (int g = 0; g < 4; ++g) { const int dv = 32 * dq + 8 * g + 4 * hi;
                const u32x2_t gv = *(const u32x2_t*)(gp + dv); const f32x4_t sw = *(const f32x4_t*)(subln_w + dv);
                u32x2_t ov; ov.x = pk2(o[dq][4 * g + 0] * rstd * sw.x * bflo(gv.x), o[dq][4 * g + 1] * rstd * sw.y * bfhi(gv.x));
                ov.y = pk2(o[dq][4 * g + 2] * rstd * sw.z * bflo(gv.y), o[dq][4 * g + 3] * rstd * sw.w * bfhi(gv.y));
                *(u32x2_t*)(op + dv) = ov; }
    }
    __syncthreads();
}
__device__ __forceinline__ void phase(unsigned char* lds, int blk, int G, const bf16_t* P, bf16_t* AOBO, const float* rel_bias, const float* subln_w, float lam) {
    if (G == 256) {
        const int x = blk & 7, i = blk >> 3;
        for (int k = 0; k < 4; ++k) { const int id = 4 * x + k; unit(lds, id >> 2, id & 3, (k & 1) ? 31 - i : i, P, AOBO, rel_bias, subln_w, lam); }
    } else {
        for (int u = blk; u < 32 * 32; u += G) unit(lds, (u >> 5) >> 2, (u >> 5) & 3, u & 31, P, AOBO, rel_bias, subln_w, lam);
    }
}
}
namespace dsa {
typedef short bf16x8 __attribute__((ext_vector_type(8)));
typedef short s16x4 __attribute__((ext_vector_type(4)));
typedef float f32x16 __attribute__((ext_vector_type(16)));
typedef LAS const char* lds_cptr;
constexpr int KBUF = 16384, VBUF = 16384;
constexpr int OFF_K = 0, OFF_V = 2 * KBUF, OFF_LUT = OFF_V + 2 * VBUF, LDS_NEED = OFF_LUT + 2048;
constexpr float THR = 8.0f;
__device__ __forceinline__ s16x4 vtr(lds_cptr p) { return __builtin_bit_cast(s16x4, __builtin_amdgcn_ds_read_tr16_b64_v4i16((LAS s16x4*)p)); }
__device__ __forceinline__ float swap_other_half(float v) { auto rr = __builtin_amdgcn_permlane32_swap(__float_as_uint(v), __float_as_uint(v), false, false); return __uint_as_float((threadIdx.x & 32) ? rr[0] : rr[1]); }

__device__ __forceinline__ void unit(unsigned char* lds, int b, int hg, int cc, const bf16_t* P, const unsigned* MASK, bf16_t* AOBO, const float* __restrict__ rel_bias) {
    const int tid = threadIdx.x, lane = tid & 63, r32 = lane & 31, hi = lane >> 5;
    const int w = __builtin_amdgcn_readfirstlane(tid >> 6), hl = w & 1, qs = w >> 1;
    const int cw = 2 * cc + (qs >> 1);
    const int NT = 2 * cc + 2, NTw = cw + 1;
    const int h = 2 * hg + hl;
    const size_t rowb = (size_t)b * SEQ;
    const int pl = hg >> 1, co = (hg & 1) * 128;
    const bf16_t* Kg = P + (size_t)(PL_BK + pl) * PLANE + rowb * 256 + co;
    const bf16_t* Vg = P + (size_t)(PL_BV + pl) * PLANE + rowb * 256 + co;
    const bf16_t* Qg = P + (size_t)(PL_BQ + pl) * PLANE + rowb * 256 + co;
    const bf16_t* Gg = P + (size_t)(PL_BG + pl) * PLANE + rowb * 256 + co;
    LAS unsigned char* L = (LAS unsigned char*)lds;
    LAS float* lut = (LAS float*)(L + OFF_LUT) + hl * 256;
    { const int hh = tid >> 8, rel = (tid & 255) - 192, hd = 4 + 2 * hg + hh; const float far = rel_bias[15 * 12 + hd];
      ((LAS float*)(L + OFF_LUT))[tid] = (rel_bias[t5_bucket(rel) * 12 + hd] - far) * LOG2E; }
#define DSA_DMA(t, buf) do { \
        _Pragma("unroll") for (int i_ = 0; i_ < 2; ++i_) { const int ch_ = 2 * w + i_; \
            __builtin_amdgcn_global_load_lds((const unsigned*)(Kg + (size_t)((t) * 64 + lane) * 256 + ch_ * 8), (LAS unsigned*)(L + OFF_K + (buf) * KBUF + ch_ * 1024), 16, 0, 0); } \
        _Pragma("unroll") for (int i_ = 0; i_ < 2; ++i_) { const int ii_ = 2 * w + i_, dq_ = ii_ >> 2, g_ = ii_ & 3; \
            __builtin_amdgcn_global_load_lds((const unsigned*)(Vg + (size_t)((t) * 64 + 16 * g_ + (lane >> 2)) * 256 + dq_ * 32 + (lane & 3) * 8), (LAS unsigned*)(L + OFF_V + (buf) * VBUF + dq_ * 4096 + g_ * 1024), 16, 0, 0); } \
    } while (0)
    DSA_DMA(0, 0);
    bf16x8 qf[4];
    { const bf16_t* qp = Qg + (size_t)(128 * cc + 32 * qs + r32) * 256 + 64 * hl + 8 * hi;
#pragma unroll
      for (int d0 = 0; d0 < 4; ++d0) qf[d0] = *(const bf16x8*)(qp + 16 * d0); }
    f32x16 o[2];
#pragma unroll
    for (int dq = 0; dq < 2; ++dq)
#pragma unroll
        for (int r = 0; r < 16; ++r) o[dq][r] = 0.f;
    f32x16 negm;
#pragma unroll
    for (int r = 0; r < 16; ++r) negm[r] = 0.f;
    float mrun = 0.f, lsum = 0.f;
    const int koff = (8 * hl + hi) * 1024 + r32 * 16;
    const int voff = ((lane >> 4) & 1) * 32 + (lane & 3) * 8 + (4 * hi + ((lane & 15) >> 2)) * 64 + 2 * hl * 4096;
    const u32x4_t* mrow = (const u32x4_t*)MASK + ((size_t)(b * 64 + cw) * 32) * 64 + (32 * (qs & 1) + r32);
    asm volatile("s_waitcnt vmcnt(0)" ::: "memory");
    __syncthreads();
    u32x4_t mw = {0u, 0u, 0u, 0u};
    for (int t = 0; t < NT; ++t) {
        const int buf = t & 1;
        if (t + 1 < NT) DSA_DMA(t + 1, buf ^ 1);
        if (t < NTw) {
            if ((t & 1) == 0) mw = mrow[(size_t)(t >> 1) * 64];
            const unsigned w0 = ((t & 1) ? mw.z : mw.x) >> (4 * hi), w1 = ((t & 1) ? mw.w : mw.y) >> (4 * hi);
            const lds_cptr kb = (lds_cptr)(L + OFF_K + buf * KBUF + koff);
            f32x16 s0 = negm, s1 = negm;
#pragma unroll
            for (int d0 = 0; d0 < 4; ++d0) {
                const bf16x8 a0 = *(const LAS bf16x8*)(kb + d0 * 2048), a1 = *(const LAS bf16x8*)(kb + d0 * 2048 + 512);
                s0 = __builtin_amdgcn_mfma_f32_32x32x16_bf16(a0, qf[d0], s0, 0, 0, 0);
                s1 = __builtin_amdgcn_mfma_f32_32x32x16_bf16(a1, qf[d0], s1, 0, 0, 0);
            }
            if (t >= cw - 2) {
                const int base = 192 + 64 * (t - cw) - 32 * (qs & 1) - r32 + 4 * hi;
#pragma unroll
                for (int r = 0; r < 16; ++r) { const int kk = (r & 3) + 8 * (r >> 2); s0[r] += lut[base + kk]; s1[r] += lut[base + 32 + kk]; }
            }
            float tm = fmaxf(s0[0], s1[0]);
#pragma unroll
            for (int r = 1; r < 16; ++r) tm = fmaxf(tm, fmaxf(s0[r], s1[r]));
            tm = fmaxf(tm, swap_other_half(tm));
            const bool first = (t == 0);
            if (first || __any(tm > THR)) {
                const float dl = first ? tm : fmaxf(tm, 0.f);
                mrun += dl;
#pragma unroll
                for (int r = 0; r < 16; ++r) { s0[r] -= dl; s1[r] -= dl; negm[r] = -mrun; }
                const float al = __builtin_amdgcn_exp2f(-dl);
                lsum *= al;
                if (!first) {
#pragma unroll
                    for (int dq = 0; dq < 2; ++dq)
#pragma unroll
                        for (int r = 0; r < 16; ++r) o[dq][r] *= al;
                }
            }
            float ps = 0.f;
#pragma unroll
            for (int r = 0; r < 16; ++r) { const int kk = (r & 3) + 8 * (r >> 2);
                const float e0 = __builtin_amdgcn_exp2f(s0[r]), e1 = __builtin_amdgcn_exp2f(s1[r]);
                s0[r] = ((w0 >> kk) & 1u) ? e0 : 0.f; s1[r] = ((w1 >> kk) & 1u) ? e1 : 0.f; ps += s0[r] + s1[r]; }
            lsum += ps;
            bf16x8 pf[4];
#pragma unroll
            for (int ks = 0; ks < 2; ++ks) {
                u32x4_t a, c;
                a.x = pk2(s0[8 * ks + 0], s0[8 * ks + 1]); a.y = pk2(s0[8 * ks + 2], s0[8 * ks + 3]); a.z = pk2(s0[8 * ks + 4], s0[8 * ks + 5]); a.w = pk2(s0[8 * ks + 6], s0[8 * ks + 7]);
                c.x = pk2(s1[8 * ks + 0], s1[8 * ks + 1]); c.y = pk2(s1[8 * ks + 2], s1[8 * ks + 3]); c.z = pk2(s1[8 * ks + 4], s1[8 * ks + 5]); c.w = pk2(s1[8 * ks + 6], s1[8 * ks + 7]);
                pf[ks] = __builtin_bit_cast(bf16x8, a); pf[2 + ks] = __builtin_bit_cast(bf16x8, c);
            }
            const lds_cptr vp = (lds_cptr)(L + OFF_V + buf * VBUF + voff);
#pragma unroll
            for (int dq = 0; dq < 2; ++dq)
#pragma unroll
                for (int ks = 0; ks < 4; ++ks) {
                    const s16x4 lo = vtr(vp + dq * 4096 + ks * 1024), hh = vtr(vp + dq * 4096 + ks * 1024 + 512);
                    const bf16x8 vf = {lo[0], lo[1], lo[2], lo[3], hh[0], hh[1], hh[2], hh[3]};
                    o[dq] = __builtin_amdgcn_mfma_f32_32x32x16_bf16(vf, pf[ks], o[dq], 0, 0, 0);
                }
        }
        asm volatile("s_waitcnt vmcnt(0)" ::: "memory");
        __syncthreads();
    }
#undef DSA_DMA
    {
        const float inv = 1.0f / (lsum + swap_other_half(lsum));
        const size_t m = rowb + (size_t)(128 * cc + 32 * qs + r32);
        const bf16_t* gp = Gg + (m - rowb) * 256 + 64 * hl;
        bf16_t* op = AOBO + m * DM + 512 + h * 64;
#pragma unroll
        for (int dq = 0; dq < 2; ++dq)
#pragma unroll
            for (int g = 0; g < 4; ++g) { const int dv = 32 * dq + 8 * g + 4 * hi;
                const u32x2_t gv = *(const u32x2_t*)(gp + dv);
                u32x2_t ov; ov.x = pk2(o[dq][4 * g + 0] * inv * bflo(gv.x), o[dq][4 * g + 1] * inv * bfhi(gv.x));
                ov.y = pk2(o[dq][4 * g + 2] * inv * bflo(gv.y), o[dq][4 * g + 3] * inv * bfhi(gv.y));
                *(u32x2_t*)(op + dv) = ov; }
    }
    __syncthreads();
}
__device__ __forceinline__ void phase(unsigned char* lds, int blk, int G, const bf16_t* P, const unsigned* MASK, bf16_t* AOBO, const float* rel_bias) {
    if (G == 256) {
        const int x = blk & 7, i = blk >> 3;
        for (int k = 0; k < 4; ++k) { const int id = 4 * x + k; unit(lds, id >> 2, id & 3, (k & 1) ? 31 - i : i, P, MASK, AOBO, rel_bias); }
    } else {
        for (int u = blk; u < 32 * 32; u += G) unit(lds, (u >> 5) >> 2, (u >> 5) & 3, u & 31, P, MASK, AOBO, rel_bias);
    }
}
}
namespace sel {
typedef short bf16x8 __attribute__((ext_vector_type(8)));
typedef float f32x16 __attribute__((ext_vector_type(16)));
constexpr int B1 = 256, HS = 257, CAP = 32;
constexpr int OFF_HIST = 0, OFF_TW = 0, OFF_CLS = 32768, OFF_CLI = 40960, OFF_PAR = 71680, OFF_SLOW = 73728, OFF_IQ = 98304, LDS_NEED = OFF_IQ + 32768;
constexpr int P_KMIN = 0, P_KMAX = 64, P_INV = 128, P_KNEG = 192, P_EST = 256, P_R = 320, P_CC = 384, P_MODE = 448;

__device__ __forceinline__ float other_half(float v) { auto rr = __builtin_amdgcn_permlane32_swap(__float_as_uint(v), __float_as_uint(v), false, false); return __uint_as_float((threadIdx.x & 32) ? rr[0] : rr[1]); }
__device__ __forceinline__ unsigned other_half_u(unsigned v) { auto rr = __builtin_amdgcn_permlane32_swap(v, v, false, false); return (threadIdx.x & 32) ? rr[0] : rr[1]; }

struct Tile { bf16x8 a[4]; };
__device__ __forceinline__ void load_tile(Tile& t, const bf16_t* ikrow) {
#pragma unroll
    for (int d0 = 0; d0 < 4; ++d0) t.a[d0] = *(const bf16x8*)(ikrow + 16 * d0);
}
__device__ __forceinline__ void score_tile(f32x16& sc, const Tile& t, LAS const char* iqb, const float (&wg)[4]) {
    asm volatile("" ::: "memory");
#pragma unroll
    for (int h = 0; h < 4; ++h) {
        __builtin_amdgcn_sched_barrier(0);
        f32x16 l;
#pragma unroll
        for (int r = 0; r < 16; ++r) l[r] = 0.f;
#pragma unroll
        for (int d0 = 0; d0 < 4; ++d0) { const bf16x8 bqf = *(const LAS bf16x8*)(iqb + (8 * h + 2 * d0) * 1024); l = __builtin_amdgcn_mfma_f32_32x32x16_bf16(t.a[d0], bqf, l, 0, 0, 0); }
#pragma unroll
        for (int r = 0; r < 16; ++r) sc[r] = (h == 0) ? wg[0] * fmaxf(l[r], 0.f) : fmaf(wg[h], fmaxf(l[r], 0.f), sc[r]);
    }
#pragma unroll
    for (int r = 0; r < 16; ++r) sc[r] = sc[r] + 0.0f;
}
__device__ __forceinline__ int bin_of(float s, float inv, int kneg) {
    const int fl = (int)floorf(fabsf(s) * inv);
    const int sm = __float_as_int(s) >> 31;
    int b = kneg + (fl ^ sm);
    b = b < 0 ? 0 : (b > B1 - 1 ? B1 - 1 : b);
    return b;
}
__device__ __forceinline__ void sel_slow_one(int b, int c, int q, int lane, unsigned* skey, float* sq, const bf16_t* P, const float* IW, unsigned* MW) {
    const int m = b * SEQ + 64 * c + q, N = 64 * (c + 1);
    { const u32x2_t qv = *(const u32x2_t*)(P + PL_IQ * PLANE + (size_t)m * 256 + lane * 4);
      sq[lane * 4 + 0] = bflo(qv.x); sq[lane * 4 + 1] = bfhi(qv.x); sq[lane * 4 + 2] = bflo(qv.y); sq[lane * 4 + 3] = bfhi(qv.y); }
    const f32x4_t iw = *(const f32x4_t*)(IW + (size_t)m * 4);
    const float wg0 = iw.x * IDX_SCALE, wg1 = iw.y * IDX_SCALE, wg2 = iw.z * IDX_SCALE, wg3 = iw.w * IDX_SCALE;
    WAVE_SYNC();
    for (int i = 0; i < N / 64; ++i) {
        asm volatile("" ::: "memory");
        const int s = i * 64 + lane; const bf16_t* kr = P + PL_IK * PLANE + (size_t)(b * SEQ + s) * 256;
        float l0 = 0.f, l1 = 0.f, l2 = 0.f, l3 = 0.f;
#pragma unroll
        for (int cc = 0; cc < 8; ++cc) { const u32x4_t kv = *(const u32x4_t*)(kr + cc * 8);
            const float k[8] = {bflo(kv.x), bfhi(kv.x), bflo(kv.y), bfhi(kv.y), bflo(kv.z), bfhi(kv.z), bflo(kv.w), bfhi(kv.w)};
#pragma unroll
            for (int e = 0; e < 8; ++e) { const int d = cc * 8 + e; l0 += sq[d] * k[e]; l1 += sq[64 + d] * k[e]; l2 += sq[128 + d] * k[e]; l3 += sq[192 + d] * k[e]; } }
        float sc = wg0 * fmaxf(l0, 0.f); sc = fmaf(wg1, fmaxf(l1, 0.f), sc); sc = fmaf(wg2, fmaxf(l2, 0.f), sc); sc = fmaf(wg3, fmaxf(l3, 0.f), sc);
        sc += 0.0f;
        skey[s] = f2key(sc);
    }
    WAVE_SYNC();
    unsigned prefix = 0u;
    for (int bit = 31; bit >= 0; --bit) { const unsigned cand = prefix | (1u << bit); int cn = 0;
        for (int i = 0; i < N / 64; ++i) cn += (skey[i * 64 + lane] >= cand) ? 1 : 0;
        cn = wave_sum_i(cn); if (cn >= 256) prefix = cand; }
    int cgt = 0; for (int i = 0; i < N / 64; ++i) cgt += (skey[i * 64 + lane] > prefix) ? 1 : 0;
    cgt = wave_sum_i(cgt);
    const int r = 256 - cgt;
    int run = 0, kcut = 0x7fffffff;
    for (int i = 0; i < N / 64; ++i) { const unsigned long long bm = __ballot(skey[i * 64 + lane] == prefix); const int cn = __popcll(bm);
        if (run + cn >= r) { unsigned long long t = bm; for (int z = 0; z < r - run - 1; ++z) t &= t - 1; kcut = i * 64 + (int)__builtin_ctzll(t); break; }
        run += cn; }
    for (int i = 0; i < N / 64; ++i) { const unsigned k = skey[i * 64 + lane]; const int idx = i * 64 + lane; const bool f = (k > prefix) || (k == prefix && idx <= kcut);
        const unsigned long long bm = __ballot(f);
        if (lane == 0) { u32x2_t o = {(unsigned)bm, (unsigned)(bm >> 32)}; *(u32x2_t*)(MW + ((size_t)(i >> 1) * 64 + q) * 4 + (i & 1) * 2) = o; } }
    WAVE_SYNC();
}

__device__ __forceinline__ void unit(unsigned char* lds, int b, int c, const bf16_t* P, const float* IW, unsigned* MASK) {
    const int tid = threadIdx.x, lane = tid & 63, r32 = lane & 31, hi = lane >> 5;
    const int w = __builtin_amdgcn_readfirstlane(tid >> 6), qs = w & 1, ks = w >> 1;
    const int N = 64 * (c + 1), NT32 = N / 32;
    unsigned* MW = MASK + ((size_t)(b * 64 + c) * 32 * 64) * 4;
    if (c < 4) {
        for (int idx = tid; idx < 64 * NT32; idx += 512) { const int q = idx & 63, kt = idx >> 6; MW[((size_t)(kt >> 2) * 64 + q) * 4 + (kt & 3)] = 0xffffffffu; }
        return;
    }
    LAS unsigned* hist = (LAS unsigned*)((LAS unsigned char*)lds + OFF_HIST);
    LAS unsigned* TW = (LAS unsigned*)((LAS unsigned char*)lds + OFF_TW);
    LAS float* CLS = (LAS float*)((LAS unsigned char*)lds + OFF_CLS);
    LAS unsigned* CLI = (LAS unsigned*)((LAS unsigned char*)lds + OFF_CLI);
    LAS unsigned* PAR = (LAS unsigned*)((LAS unsigned char*)lds + OFF_PAR);
    const int q = 32 * qs + r32;
    const size_t m = (size_t)b * SEQ + 64 * c + q;
    {
        const bf16_t* qrow = P + (size_t)PL_IQ * PLANE + ((size_t)b * SEQ + 64 * c) * 256;
#pragma unroll
        for (int i = 0; i < 4; ++i) { const int p = tid + 512 * i, qq = p >> 5, ch = p & 31;
            *(LAS u32x4_t*)((LAS unsigned char*)lds + OFF_IQ + ch * 1024 + qq * 16) = *(const u32x4_t*)(qrow + (size_t)qq * 256 + ch * 8); }
    }
    LAS const char* iqb = (LAS const char*)((LAS unsigned char*)lds + OFF_IQ + hi * 1024 + q * 16);
    float wg[4];
    { const f32x4_t iw = *(const f32x4_t*)(IW + m * 4); wg[0] = iw.x * IDX_SCALE; wg[1] = iw.y * IDX_SCALE; wg[2] = iw.z * IDX_SCALE; wg[3] = iw.w * IDX_SCALE; }
    const bf16_t* ikl = P + (size_t)PL_IK * PLANE + ((size_t)b * SEQ + r32) * 256 + 8 * hi;
    for (int i = tid; i < 64 * HS; i += 512) hist[i] = 0u;
    if (tid < 64) { PAR[P_KMIN + tid] = 0xffffffffu; PAR[P_KMAX + tid] = 0u; PAR[P_CC + tid] = 0u; }
    __syncthreads();
    {   float mn = INFINITY, mx = -INFINITY;
        for (int kt = ks; kt < NT32; kt += 32) { Tile t; load_tile(t, ikl + (size_t)kt * 32 * 256); f32x16 sc; score_tile(sc, t, iqb, wg);
#pragma unroll
            for (int r = 0; r < 16; ++r) { mn = fminf(mn, sc[r]); mx = fmaxf(mx, sc[r]); } }
        mn = fminf(mn, other_half(mn)); mx = fmaxf(mx, other_half(mx));
        if (hi == 0 && mn <= mx) { atomicMin((unsigned*)&PAR[P_KMIN + q], f2key(mn)); atomicMax((unsigned*)&PAR[P_KMAX + q], f2key(mx)); }
    }
    __syncthreads();
    if (tid < 64) {
        float lo = key2f(PAR[P_KMIN + tid]), hh = key2f(PAR[P_KMAX + tid]);
        lo = fminf(lo, 0.f) * 1.125f - 1e-30f; hh = fmaxf(hh, 0.f) * 1.125f + 1e-30f;
        const float inv = (float)(B1 - 2) / (hh - lo);
        int kneg = (int)ceilf(-lo * inv) + 1; kneg = kneg < 1 ? 1 : (kneg > B1 - 1 ? B1 - 1 : kneg);
        PAR[P_INV + tid] = __float_as_uint(inv); PAR[P_KNEG + tid] = (unsigned)kneg;
    }
    __syncthreads();
    const float inv = __uint_as_float(PAR[P_INV + q]); const int kneg = (int)PAR[P_KNEG + q];
    {   Tile t0, t1;
        if (ks < NT32) load_tile(t0, ikl + (size_t)ks * 32 * 256);
        for (int kt = ks; kt < NT32; kt += 8) {
            if (kt + 4 < NT32) load_tile(t1, ikl + (size_t)(kt + 4) * 32 * 256);
            { f32x16 sc; score_tile(sc, t0, iqb, wg);
#pragma unroll
              for (int r = 0; r < 16; ++r) { int bn = bin_of(sc[r], inv, kneg); bn = (sc[r] != 0.f) ? bn : B1; atomicAdd((unsigned*)&hist[q * HS + bn], 1u); } }
            if (kt + 4 < NT32) {
                if (kt + 8 < NT32) load_tile(t0, ikl + (size_t)(kt + 8) * 32 * 256);
                f32x16 sc; score_tile(sc, t1, iqb, wg);
#pragma unroll
                for (int r = 0; r < 16; ++r) { int bn = bin_of(sc[r], inv, kneg); bn = (sc[r] != 0.f) ? bn : B1; atomicAdd((unsigned*)&hist[q * HS + bn], 1u); }
            }
        }
    }
    __syncthreads();
    if (tid < 64) {
        const LAS unsigned* hq = hist + tid * HS; const int kn = (int)PAR[P_KNEG + tid];
        const int cntZ = (int)hq[B1];
        asm volatile("" ::: "memory");
        int cum = 0, est = -1, mode = 0, R = 0;
#pragma nounroll
        for (int bn = B1 - 1; bn >= kn; --bn) { const int hcount = (int)hq[bn]; if (cum + hcount >= 256) { est = 2 * bn + 1; R = 256 - cum; break; } cum += hcount; }
        if (est < 0) {
            if (cum + cntZ >= 256) { est = 2 * kn; R = 256 - cum; mode = 1; }
            else { cum += cntZ;
#pragma nounroll
                for (int bn = kn - 1; bn >= 0; --bn) { const int hcount = (int)hq[bn]; if (cum + hcount >= 256) { est = 2 * bn + 1; R = 256 - cum; break; } cum += hcount; } }
        }
        if (est < 0) { est = 1; R = 256 - cum; mode = 2; }
        PAR[P_EST + tid] = (unsigned)est; PAR[P_R + tid] = (unsigned)R; PAR[P_MODE + tid] = (unsigned)mode;
    }
    __syncthreads();
    const int est = (int)PAR[P_EST + q]; const bool normal = (PAR[P_MODE + q] == 0u);
    {   Tile t0, t1;
        if (ks < NT32) load_tile(t0, ikl + (size_t)ks * 32 * 256);
#define SEL_FINAL_TILE(T, KT) do { f32x16 sc; score_tile(sc, T, iqb, wg); unsigned gp = 0u, ep = 0u; \
            _Pragma("unroll") for (int r = 0; r < 16; ++r) { const int bn = bin_of(sc[r], inv, kneg); const int e = 2 * bn + (sc[r] != 0.f ? 1 : 0); const int pos = (r & 3) + 8 * (r >> 2); \
                gp |= (e > est ? 1u : 0u) << pos; ep |= (e == est ? 1u : 0u) << pos; } \
            unsigned cb = normal ? ep : 0u; \
            while (__any(cb != 0u)) { \
                if (cb != 0u) { const int pos = __builtin_ctz(cb); cb &= cb - 1u; const int rr = (pos & 3) + 4 * (pos >> 3); float val = sc[0]; \
                    _Pragma("unroll") for (int r = 1; r < 16; ++r) val = (rr == r) ? sc[r] : val; \
                    const unsigned slot = atomicAdd((unsigned*)&PAR[P_CC + q], 1u); \
                    if (slot < (unsigned)CAP) { CLS[q * CAP + slot] = val; CLI[q * CAP + slot] = (unsigned)((KT) * 32 + pos + 4 * hi); } } } \
            gp <<= 4 * hi; ep <<= 4 * hi; gp |= other_half_u(gp); ep |= other_half_u(ep); \
            if (hi == 0) { MW[((size_t)((KT) >> 2) * 64 + q) * 4 + ((KT) & 3)] = gp; TW[q * 128 + (KT)] = ep; } } while (0)
        for (int kt = ks; kt < NT32; kt += 8) {
            if (kt + 4 < NT32) load_tile(t1, ikl + (size_t)(kt + 4) * 32 * 256);
            SEL_FINAL_TILE(t0, kt);
            if (kt + 4 < NT32) {
                if (kt + 8 < NT32) load_tile(t0, ikl + (size_t)(kt + 8) * 32 * 256);
                SEL_FINAL_TILE(t1, kt + 4);
            }
        }
#undef SEL_FINAL_TILE
    }
    asm volatile("s_waitcnt vmcnt(0) lgkmcnt(0)" ::: "memory");
    __syncthreads();
    for (int qq = w; qq < 64; qq += 8) {
        const unsigned mode = PAR[P_MODE + qq]; const int R = (int)PAR[P_R + qq];
        if (mode == 0u) {
            const int n = (int)PAR[P_CC + qq];
            if (n > CAP) { if (lane == 0) PAR[P_MODE + qq] = 2u; }
            else {
                const float sj = lane < n ? CLS[qq * CAP + lane] : 0.f; const unsigned ij = lane < n ? CLI[qq * CAP + lane] : 0u;
                int rank = 0;
                for (int i = 0; i < n; ++i) { const float si = CLS[qq * CAP + i]; const unsigned ii = CLI[qq * CAP + i]; rank += ((si > sj) || (si == sj && ii < ij)) ? 1 : 0; }
                if (lane < n && rank < R) atomicOr(&MW[((size_t)(ij >> 7) * 64 + qq) * 4 + ((ij >> 5) & 3)], 1u << (ij & 31));
            }
        } else if (mode == 1u) {
            const unsigned w0 = lane < NT32 ? TW[qq * 128 + lane] : 0u, w1 = (lane + 64) < NT32 ? TW[qq * 128 + 64 + lane] : 0u;
            const int c0 = __popc(w0), c1 = __popc(w1);
            int p0 = c0, p1 = c1;
#pragma unroll
            for (int o = 1; o < 64; o <<= 1) { const int t0 = __shfl_up(p0, o), t1 = __shfl_up(p1, o); if (lane >= o) { p0 += t0; p1 += t1; } }
            const int tot0 = __shfl(p0, 63);
            const int before0 = p0 - c0, before1 = tot0 + p1 - c1;
#pragma unroll
            for (int half = 0; half < 2; ++half) {
                unsigned wv = half ? w1 : w0; const int cnt = half ? c1 : c0; const int before = half ? before1 : before0; const int kt = lane + 64 * half;
                int take = R - before; take = take < 0 ? 0 : (take > cnt ? cnt : take);
                if (take > 0) { unsigned res = 0u; for (int z = 0; z < take; ++z) { const unsigned low = wv & (0u - wv); res |= low; wv ^= low; }
                    atomicOr(&MW[((size_t)(kt >> 2) * 64 + qq) * 4 + (kt & 3)], res); }
            }
        }
    }
    asm volatile("s_waitcnt vmcnt(0) lgkmcnt(0)" ::: "memory");
    __syncthreads();
    if (w < 3) {
        unsigned* skey = (unsigned*)(lds + OFF_SLOW + w * 17408); float* sq = (float*)(lds + OFF_SLOW + w * 17408 + 16384);
        int seen = 0;
        for (int qq = 0; qq < 64; ++qq) if (PAR[P_MODE + qq] == 2u) { if ((seen % 3) == w) sel_slow_one(b, c, qq, lane, skey, sq, P, IW, MW); ++seen; }
    }
    asm volatile("s_waitcnt vmcnt(0) lgkmcnt(0)" ::: "memory");
    __syncthreads();
}
__device__ __forceinline__ void phase(unsigned char* lds, int blk, int G, const bf16_t* P, const float* IW, unsigned* MASK) {
    if (G == 256) { const int b = blk & 7, i = blk >> 3; unit(lds, b, i, P, IW, MASK); unit(lds, b, 63 - i, P, IW, MASK); }
    else { for (int u = blk; u < NBATCH * 64; u += G) unit(lds, u >> 6, u & 63, P, IW, MASK); }
}
}
constexpr int LDS_MAIN = 139264;
constexpr int MISC_OFF = LDS_MAIN, LDS_BYTES = LDS_MAIN + 64;
constexpr size_t BAR_BYTES = (size_t)XCD_BAR_WORDS * 4;
struct Args { const float* in[11]; float* out; unsigned char* ws; };

__global__ void __launch_bounds__(512, 2) fwd(Args a) {
    extern __shared__ __attribute__((aligned(16))) unsigned char lds[];
    const int tid = threadIdx.x, lane = tid & 63, wave = __builtin_amdgcn_readfirstlane(tid >> 6);
    volatile LAS unsigned* misc = (volatile LAS unsigned*)((LAS unsigned char*)lds + MISC_OFF);
    if (tid < 16) misc[tid] = 0u;
    __syncthreads();
    XcdBarrier bar = xcd_barrier_post((unsigned*)a.ws, misc);
    const int G = gridDim.x, gw = blockIdx.x * 8 + wave, ngw = G * 8;
    unsigned char* ws = a.ws;
    const float* x = a.in[0]; const float* rel_bias = a.in[9];
    prologue_body(gw, ngw, lane, x, a.in[1], a.in[2], a.in[3], (bf16_t*)(ws + WS_H), (float*)(ws + WS_IW), (bf16_t*)(ws + WS_WINT), (bf16_t*)(ws + WS_WOUTT));
    xcd_barrier(bar);
    { pg8::Gemm g{(const bf16_t*)(ws + WS_H), (const bf16_t*)(ws + WS_WINT), MT, NPAD, DM}; pg8::StaticOrder S; S.init(MT, NPAD, G, (int)blockIdx.x);
      pg8::EpiProj E{(bf16_t*)(ws + WS_P)};
      pg8::gemm_phase<pg8::EpiProj, pg8::StaticOrder, true, true>((PG8_LAS unsigned char*)lds, g, S, E); }
    xcd_barrier(bar);
    sel::phase(lds, (int)blockIdx.x, G, (const bf16_t*)(ws + WS_P), (const float*)(ws + WS_IW), (unsigned*)(ws + WS_MASK));
    xcd_barrier(bar);
    dsa::phase(lds, (int)blockIdx.x, G, (const bf16_t*)(ws + WS_P), (const unsigned*)(ws + WS_MASK), (bf16_t*)(ws + WS_AOBO), rel_bias);
    __syncthreads();
    { const float lam = diff_lambda(lane, a.in[4], a.in[5], a.in[6], a.in[7]);
      dfa::phase(lds, (int)blockIdx.x, G, (const bf16_t*)(ws + WS_P), (bf16_t*)(ws + WS_AOBO), rel_bias, a.in[8], lam); }
    xcd_barrier(bar);
    { pg8::Gemm g{(const bf16_t*)(ws + WS_AOBO), (const bf16_t*)(ws + WS_WOUTT), MT, DM, DM}; pg8::StaticOrder S; S.init(MT, DM, G, (int)blockIdx.x);
      pg8::EpiOut E{x, a.out};
      pg8::gemm_phase<pg8::EpiOut, pg8::StaticOrder, true, true>((PG8_LAS unsigned char*)lds, g, S, E); }
    xcd_barrier(bar);
    final_norm_body(gw, ngw, lane, a.out, a.in[10]);
}

extern "C" void kernel_launch(void* const* d_in, const int* in_sizes, int n_in, void* d_out, int out_size, void* d_ws, size_t ws_size, hipStream_t stream) {
    static int grid = 0;
    if (grid == 0) {
        if (n_in != 11 || out_size != MT * DM || ws_size < WS_END) { fprintf(stderr, "kernel_launch: unexpected shapes (n_in %d out %d ws %zu need %zu)\n", n_in, out_size, ws_size, (size_t)WS_END); grid = -1; return; }
        int dev = 0, cus = 0, per_cu = 0;
        if (hipGetDevice(&dev) != hipSuccess || hipDeviceGetAttribute(&cus, hipDeviceAttributeMultiprocessorCount, dev) != hipSuccess) { grid = -1; return; }
        if (hipFuncSetAttribute((const void*)fwd, hipFuncAttributeMaxDynamicSharedMemorySize, LDS_BYTES) != hipSuccess) { fprintf(stderr, "kernel_launch: hipFuncSetAttribute failed\n"); grid = -1; return; }
        if (hipOccupancyMaxActiveBlocksPerMultiprocessor(&per_cu, (const void*)fwd, 512, LDS_BYTES) != hipSuccess || per_cu < 1) { fprintf(stderr, "kernel_launch: occupancy query says %d blocks per CU\n", per_cu); (void)hipGetLastError(); }
        grid = cus;
    }
    if (grid < 0) return;
    if (hipMemsetAsync(d_ws, 0, BAR_BYTES, stream) != hipSuccess) { fprintf(stderr, "kernel_launch: memset failed\n"); return; }
    Args a; memset(&a, 0, sizeof(a));
    for (int i = 0; i < 11; ++i) a.in[i] = (const float*)d_in[i];
    a.out = (float*)d_out; a.ws = (unsigned char*)d_ws;
    hipLaunchKernelGGL(fwd, dim3(grid), dim3(512), LDS_BYTES, stream, a);
}
```

```cpp
#include <hip/hip_runtime.h>
#include <cstdio>
#include <cstdint>
#include <cstring>
#include <cmath>
#define LAS __attribute__((address_space(3)))
typedef unsigned short bf16_t;
typedef unsigned u32x4_t __attribute__((ext_vector_type(4)));
typedef unsigned u32x2_t __attribute__((ext_vector_type(2)));
typedef float f32x4_t __attribute__((ext_vector_type(4)));

constexpr int DM = 1024, NBATCH = 8, SEQ = 4096, MT = NBATCH * SEQ;
constexpr int D_IN = 4420, NPAD = 4608, NPLANES = 18;
constexpr float EPS = 1e-6f, LOG2E = 1.4426950408889634f;
constexpr float C2 = 0.125f * LOG2E;
constexpr float IDX_SCALE = 0.0625f;
constexpr float LAMBDA_INIT = 0.2f, ONE_M_LAMBDA = 0.8f;
constexpr size_t PLANE = (size_t)MT * 256;
constexpr int PL_AQ = 0, PL_AK = 2, PL_AV = 4, PL_AG = 6, PL_BQ = 8, PL_BK = 10, PL_BV = 12, PL_BG = 14, PL_IQ = 16, PL_IK = 17;

constexpr size_t WS_CTL = 0;
constexpr size_t WS_WINT = 65536;
constexpr size_t WS_WOUTT = WS_WINT + (size_t)NPAD * DM * 2;
constexpr size_t WS_H = WS_WOUTT + (size_t)DM * DM * 2;
constexpr size_t WS_P = WS_H + (size_t)MT * DM * 2;
constexpr size_t WS_IW = WS_P + (size_t)NPLANES * PLANE * 2;
constexpr size_t WS_THR = WS_IW + (size_t)MT * 16;
constexpr size_t WS_KCUT = WS_THR + (size_t)MT * 4;
constexpr size_t WS_SELCNT = WS_KCUT + (size_t)MT * 4;
constexpr size_t WS_AOBO = WS_SELCNT + (size_t)MT * 4;
constexpr size_t WS_SEL = WS_AOBO + (size_t)MT * DM * 2;
constexpr size_t WS_MASK = WS_SEL + (size_t)MT * 256 * 4;
constexpr size_t WS_END = WS_MASK + (size_t)NBATCH * 64 * 32 * 64 * 16;

__device__ __forceinline__ float bf2f(bf16_t v) { return __uint_as_float(((unsigned)v) << 16); }
__device__ __forceinline__ float bflo(unsigned w) { return __uint_as_float(w << 16); }
__device__ __forceinline__ float bfhi(unsigned w) { return __uint_as_float(w & 0xffff0000u); }
__device__ __forceinline__ unsigned pk2(float lo, float hi) {
    typedef float f2 __attribute__((ext_vector_type(2))); typedef __bf16 b2 __attribute__((ext_vector_type(2)));
    f2 v = {lo, hi}; b2 b = __builtin_convertvector(v, b2); return __builtin_bit_cast(unsigned, b); }
__device__ __forceinline__ float wave_sum(float v) {
#pragma unroll
    for (int o = 1; o < 64; o <<= 1) v += __shfl_xor(v, o);
    return v; }
__device__ __forceinline__ int wave_sum_i(int v) {
#pragma unroll
    for (int o = 1; o < 64; o <<= 1) v += __shfl_xor(v, o);
    return v; }
__device__ __forceinline__ float wave_max(float v) {
#pragma unroll
    for (int o = 1; o < 64; o <<= 1) v = fmaxf(v, __shfl_xor(v, o));
    return v; }
__device__ __forceinline__ int t5_bucket(int rel) {
    const int ret = rel > 0 ? 16 : 0; const int n = rel < 0 ? -rel : rel;
    if (n < 8) return ret + n;
    int large = 2 + (31 - __builtin_clz((unsigned)(n * n))); large = large > 15 ? 15 : large;
    return ret + large; }
__device__ __forceinline__ unsigned f2key(float f) { const unsigned u = __float_as_uint(f); return (u & 0x80000000u) ? ~u : (u | 0x80000000u); }
__device__ __forceinline__ float key2f(unsigned k) { return __uint_as_float((k & 0x80000000u) ? (k ^ 0x80000000u) : ~k); }
__device__ __forceinline__ float silu_f(float v) { return v * __builtin_amdgcn_rcpf(1.0f + __builtin_amdgcn_exp2f(-v * LOG2E)); }
namespace pg8 {
#define PG8_LAS __attribute__((address_space(3)))
typedef unsigned short bf16_t;
typedef short bf16x8 __attribute__((ext_vector_type(8)));
typedef float f32x4 __attribute__((ext_vector_type(4)));
typedef unsigned u32x4 __attribute__((ext_vector_type(4)));
constexpr int BM = 256, BK = 64, HALF = 128, HTB = HALF * BK * 2  , STAGE_BYTES = 8 * HTB, NXCD = 8, WGM = 8;

__host__ __device__ __forceinline__ int lds_byte(int r, int c) { const int st = (r >> 4) * 2 + (c >> 5), rr = r & 15, cc = c & 31, ob = rr * 64 + cc * 2; return st * 1024 + (ob ^ (((ob >> 9) & 1) << 5)); }
__host__ __device__ __forceinline__ void stage_rc(int b, int& R, int& C) { const int st = b / 1024, sb = b % 1024, swz = sb ^ (((sb >> 9) & 1) << 5); R = (st >> 1) * 16 + swz / 64; C = (st & 1) * 32 + (swz % 64) / 2; }
__host__ __device__ __forceinline__ int perm32(int rho) { const int n = rho >> 4, i = rho & 15; return 8 * (i >> 2) + 4 * n + (i & 3); }

struct Unit { int pm, pn; };
struct Gemm { const bf16_t* A; const bf16_t* Bt; int M, N, K; };

struct StaticOrder {
    int nM, nN, nwg, G, c;
    __host__ __device__ void init(int M, int N, int G_, int c_) { nM = M / BM; nN = N / BM; nwg = nM * nN; G = G_; c = c_; }
    __host__ __device__ bool next(int i, Unit& u) const {
        const long L = (long)i * G + c; if (L >= nwg) return false;
        int wgid = (int)L; { const int q = nwg / NXCD, r = nwg % NXCD, xcd = wgid % NXCD, off = wgid / NXCD; wgid = (xcd < r ? xcd * (q + 1) : r * (q + 1) + (xcd - r) * q) + off; }
        const int nig = WGM * nN, gid = wgid / nig, fm = gid * WGM, gsz = (nM - fm) < WGM ? (nM - fm) : WGM;
        u.pm = fm + ((wgid % nig) % gsz); u.pn = (wgid % nig) / gsz; return true;
    }
    __device__ __forceinline__ void a_ready(const Unit&) const {}
    __device__ __forceinline__ void done(const Unit&) const {}
};

__device__ __forceinline__ unsigned cvt_pk_bf16(float lo, float hi) { unsigned r; asm volatile("v_cvt_pk_bf16_f32 %0, %1, %2" : "=v"(r) : "v"(lo), "v"(hi)); return r; }
template <class Epi, class Sched, bool ALIGN_EPI = false, bool SP2 = false>
__device__ __forceinline__ void gemm_phase(PG8_LAS unsigned char* lds, const Gemm g, const Sched& S, const Epi& E) {
    const int tid = threadIdx.x, wid = __builtin_amdgcn_readfirstlane(tid >> 6), lane = tid & 63, wr = wid >> 2, wc = wid & 3, fr = lane & 15, fq = lane >> 4;
    const int K = g.K, nt = K / BK;
    unsigned voffA[2], voffB[2];
#pragma unroll
    for (int i = 0; i < 2; ++i) { int R, C; stage_rc(tid * 16 + i * 8192, R, C); const int Rb = Epi::PERM ? ((R & ~31) + perm32(R & 31)) : R;
        voffA[i] = (unsigned)(R * K + C) * 2u; voffB[i] = (unsigned)(Rb * K + C) * 2u; }
    const size_t kstep = (size_t)(BK * 2);
    const size_t hstep = (size_t)HALF * K * 2;
    const size_t tstep = 2 * hstep;
    const unsigned ldsw = (unsigned)wid * 1024u;
    const int aoff = lds_byte(wr * 64 + fr, fq * 8), boff = lds_byte(wc * 32 + fr, fq * 8);
#define PG8_SA(b, h) (((b) * 2 + (h)) * HTB)
#define PG8_SB(b, h) ((4 + (b) * 2 + (h)) * HTB)
#define PG8_STAGE(bufoff, gbase, voff) do { _Pragma("unroll") for (int _i = 0; _i < 2; ++_i) \
        __builtin_amdgcn_global_load_lds((const unsigned*)((const char*)(gbase) + (voff)[_i]), (PG8_LAS unsigned*)(lds + (bufoff) + ldsw + _i * 8192), 16, 0, 0); } while (0)
#define PG8_LDA(dst, b, h) do { _Pragma("unroll") for (int m = 0; m < 4; ++m) _Pragma("unroll") for (int k = 0; k < 2; ++k) dst[m][k] = *(const PG8_LAS bf16x8*)(lds + PG8_SA(b, h) + aoff + m * 2048 + k * 1024); } while (0)
#define PG8_LDB(dst, b, h) do { _Pragma("unroll") for (int n = 0; n < 2; ++n) _Pragma("unroll") for (int k = 0; k < 2; ++k) dst[n][k] = *(const PG8_LAS bf16x8*)(lds + PG8_SB(b, h) + boff + n * 2048 + k * 1024); } while (0)
#define PG8_MMA(ai, bj, At, Bt) do { __builtin_amdgcn_s_setprio(1); _Pragma("unroll") for (int m = 0; m < 4; ++m) _Pragma("unroll") for (int n = 0; n < 2; ++n) _Pragma("unroll") for (int k = 0; k < 2; ++k) \
        acc[ai][bj][m][n] = __builtin_amdgcn_mfma_f32_16x16x32_bf16(Bt[n][k], At[m][k], acc[ai][bj][m][n], 0, 0, 0); __builtin_amdgcn_s_setprio(0); } while (0)
#define PG8_WAIT_V(n) asm volatile("s_waitcnt vmcnt(" #n ")" ::: "memory")
#define PG8_WAIT_L(n) asm volatile("s_waitcnt lgkmcnt(" #n ")" ::: "memory")
#define PG8_BAR __builtin_amdgcn_s_barrier()
#define PG8_SCHED __builtin_amdgcn_sched_barrier(0)
    Unit cur, nxt; int ui = 0;
    if (!S.next(0, cur)) return;
    f32x4 acc[2][2][4][2];
#pragma unroll
    for (int a = 0; a < 2; ++a)
#pragma unroll
        for (int b = 0; b < 2; ++b)
#pragma unroll
            for (int m = 0; m < 4; ++m)
#pragma unroll
                for (int n = 0; n < 2; ++n) acc[a][b][m][n] = (f32x4){0.f, 0.f, 0.f, 0.f};
    bf16x8 At[4][2], B0[2][2], B1[2][2];
    const char* cA = (const char*)g.A + (size_t)cur.pm * tstep; const char* cB = (const char*)g.Bt + (size_t)cur.pn * tstep;
    S.a_ready(cur);
    if constexpr (SP2) {
        PG8_STAGE(PG8_SB(0, 0), cB, voffB); PG8_STAGE(PG8_SB(0, 1), cB + hstep, voffB); PG8_STAGE(PG8_SA(0, 0), cA, voffA); PG8_STAGE(PG8_SA(0, 1), cA + hstep, voffA);
        if (wr == 1) PG8_BAR;
        PG8_WAIT_V(2); PG8_BAR;
        PG8_STAGE(PG8_SB(1, 0), cB + kstep, voffB); PG8_STAGE(PG8_SA(1, 0), cA + kstep, voffA); PG8_STAGE(PG8_SB(1, 1), cB + hstep + kstep, voffB);
        PG8_WAIT_V(6); PG8_BAR;
    } else {
        PG8_STAGE(PG8_SB(0, 0), cB, voffB); PG8_STAGE(PG8_SA(0, 0), cA, voffA); PG8_STAGE(PG8_SB(0, 1), cB + hstep, voffB); PG8_STAGE(PG8_SA(0, 1), cA + hstep, voffA);
        if (wr == 1) PG8_BAR;
        PG8_WAIT_V(4); PG8_BAR;
        PG8_STAGE(PG8_SB(1, 0), cB + kstep, voffB); PG8_STAGE(PG8_SA(1, 0), cA + kstep, voffA); PG8_STAGE(PG8_SB(1, 1), cB + hstep + kstep, voffB);
        PG8_WAIT_V(6); PG8_BAR;
    }
    for (;;) {
        const bool has_next = S.next(ui + 1, nxt);
        const char* nA = has_next ? (const char*)g.A + (size_t)nxt.pm * tstep : cA; const char* nB = has_next ? (const char*)g.Bt + (size_t)nxt.pn * tstep : cB;
        for (int t = 0; t < nt; t += 2) {
            const bool last = (t == nt - 2);
            const char* a1 = cA + (size_t)(t + 1) * kstep;
            const char* a2 = last ? nA : cA + (size_t)(t + 2) * kstep; const char* b2 = last ? nB : cB + (size_t)(t + 2) * kstep;
            const char* a3 = a2 + kstep; const char* b3 = b2 + kstep;
            if (last && has_next) S.a_ready(nxt);
            if constexpr (SP2) {
            PG8_LDB(B0, 0, 0); PG8_LDB(B1, 0, 1); PG8_SCHED; PG8_LDA(At, 0, 0); PG8_STAGE(PG8_SA(1, 1), a1 + hstep, voffA);
            PG8_WAIT_V(8); PG8_WAIT_L(0); PG8_BAR; PG8_MMA(0, 0, At, B0); PG8_MMA(0, 1, At, B1); PG8_BAR; PG8_SCHED;
            PG8_LDA(At, 0, 1); PG8_STAGE(PG8_SB(0, 0), b2, voffB); PG8_STAGE(PG8_SB(0, 1), b2 + hstep, voffB); PG8_STAGE(PG8_SA(0, 0), a2, voffA);
            PG8_WAIT_V(8); PG8_WAIT_L(0); PG8_BAR; PG8_MMA(1, 0, At, B0); PG8_MMA(1, 1, At, B1); PG8_BAR; PG8_SCHED;
            PG8_LDB(B0, 1, 0); PG8_LDB(B1, 1, 1); PG8_SCHED; PG8_LDA(At, 1, 0); PG8_STAGE(PG8_SA(0, 1), a2 + hstep, voffA);
            PG8_WAIT_V(8); PG8_WAIT_L(0); PG8_BAR; PG8_MMA(0, 0, At, B0); PG8_MMA(0, 1, At, B1); PG8_BAR; PG8_SCHED;
            PG8_LDA(At, 1, 1); PG8_STAGE(PG8_SB(1, 0), b3, voffB); PG8_STAGE(PG8_SB(1, 1), b3 + hstep, voffB); PG8_STAGE(PG8_SA(1, 0), a3, voffA);
            PG8_WAIT_V(8); PG8_WAIT_L(0); PG8_BAR; PG8_MMA(1, 0, At, B0); PG8_MMA(1, 1, At, B1); PG8_BAR; PG8_SCHED;
            } else {
            PG8_LDB(B0, 0, 0); PG8_SCHED; PG8_LDA(At, 0, 0); PG8_STAGE(PG8_SA(1, 1), a1 + hstep, voffA);
            PG8_WAIT_L(8); PG8_BAR; PG8_WAIT_L(0); PG8_MMA(0, 0, At, B0); PG8_BAR; PG8_SCHED;
            PG8_LDB(B1, 0, 1); PG8_STAGE(PG8_SB(0, 0), b2, voffB);
            PG8_BAR; PG8_WAIT_L(0); PG8_MMA(0, 1, At, B1); PG8_BAR;
            PG8_LDA(At, 0, 1); PG8_STAGE(PG8_SA(0, 0), a2, voffA);
            PG8_BAR; PG8_WAIT_L(0); PG8_MMA(1, 0, At, B0); PG8_BAR; PG8_SCHED;
            PG8_STAGE(PG8_SB(0, 1), b2 + hstep, voffB);
            PG8_WAIT_V(6); PG8_BAR; PG8_MMA(1, 1, At, B1); PG8_BAR;
            PG8_LDB(B0, 1, 0); PG8_SCHED; PG8_LDA(At, 1, 0); PG8_STAGE(PG8_SA(0, 1), a2 + hstep, voffA);
            PG8_WAIT_L(8); PG8_BAR; PG8_WAIT_L(0); PG8_MMA(0, 0, At, B0); PG8_BAR; PG8_SCHED;
            PG8_LDB(B1, 1, 1); PG8_STAGE(PG8_SB(1, 0), b3, voffB);
            PG8_BAR; PG8_WAIT_L(0); PG8_MMA(0, 1, At, B1); PG8_BAR;
            PG8_LDA(At, 1, 1); PG8_STAGE(PG8_SA(1, 0), a3, voffA);
            PG8_BAR; PG8_WAIT_L(0); PG8_MMA(1, 0, At, B0); PG8_BAR; PG8_SCHED;
            PG8_STAGE(PG8_SB(1, 1), b3 + hstep, voffB);
            PG8_WAIT_V(6); PG8_BAR; PG8_MMA(1, 1, At, B1); PG8_BAR;
            }
        }
        if constexpr (ALIGN_EPI) { if (wr == 0) PG8_BAR; }
        if constexpr (!Epi::AFTER_DRAIN) { E(acc, cur, wr, wc, fr, fq); S.done(cur); }
        if (!has_next) break;
#pragma unroll
        for (int a = 0; a < 2; ++a)
#pragma unroll
            for (int b = 0; b < 2; ++b)
#pragma unroll
                for (int m = 0; m < 4; ++m)
#pragma unroll
                    for (int n = 0; n < 2; ++n) acc[a][b][m][n] = (f32x4){0.f, 0.f, 0.f, 0.f};
        cur = nxt; cA = nA; cB = nB; ++ui;
        if constexpr (ALIGN_EPI) { if (wr == 1) PG8_BAR; }
    }
    PG8_WAIT_V(0);
    if constexpr (!ALIGN_EPI) { if (wr == 0) PG8_BAR; }
    PG8_BAR;
    if constexpr (Epi::AFTER_DRAIN) { E.fused(acc, cur, wr, wc, fr, fq, lds, wid, lane); S.done(cur); }
#undef PG8_SA
#undef PG8_SB
#undef PG8_STAGE
#undef PG8_LDA
#undef PG8_LDB
#undef PG8_MMA
#undef PG8_WAIT_V
#undef PG8_WAIT_L
#undef PG8_BAR
#undef PG8_SCHED
}
}
namespace pg8 {
struct EpiProj {
    static constexpr bool PERM = true, AFTER_DRAIN = false;
    bf16_t* P;
    __device__ __forceinline__ void operator()(const f32x4 (&acc)[2][2][4][2], const Unit& u, int wr, int wc, int fr, int fq) const {
        const int row0 = u.pm * BM + wr * 64 + fr, col0 = wc * 32 + 8 * fq, pl = u.pn;
        bf16_t* base = P + (size_t)pl * ((size_t)MT * 256);
        const int mode = (pl < 2 || pl == 8 || pl == 9) ? 1 : ((pl == 6 || pl == 7 || pl == 14 || pl == 15) ? 2 : 0);
#pragma unroll
        for (int ai = 0; ai < 2; ++ai)
#pragma unroll
            for (int m = 0; m < 4; ++m) { bf16_t* rowp = base + (size_t)(row0 + ai * HALF + m * 16) * 256 + col0;
#pragma unroll
                for (int bj = 0; bj < 2; ++bj) { f32x4 v0 = acc[ai][bj][m][0], v1 = acc[ai][bj][m][1];
                    if (mode == 1) { v0 = v0 * C2; v1 = v1 * C2; }
                    if (mode == 2) {
#pragma unroll
                        for (int j = 0; j < 4; ++j) { v0[j] = silu_f(v0[j]); v1[j] = silu_f(v1[j]); } }
                    u32x4 w; w.x = cvt_pk_bf16(v0[0], v0[1]); w.y = cvt_pk_bf16(v0[2], v0[3]); w.z = cvt_pk_bf16(v1[0], v1[1]); w.w = cvt_pk_bf16(v1[2], v1[3]);
                    *(u32x4*)(rowp + bj * HALF) = w; } }
    }
};
struct EpiOut {
    static constexpr bool PERM = false, AFTER_DRAIN = false;
    const float* X; float* O;
    __device__ __forceinline__ void operator()(const f32x4 (&acc)[2][2][4][2], const Unit& u, int wr, int wc, int fr, int fq) const {
        const int row0 = u.pm * BM + wr * 64 + fr, col0 = u.pn * BM + wc * 32 + 4 * fq;
#pragma unroll
        for (int ai = 0; ai < 2; ++ai)
#pragma unroll
            for (int m = 0; m < 4; ++m) { const size_t off = (size_t)(row0 + ai * HALF + m * 16) * DM + col0;
#pragma unroll
                for (int bj = 0; bj < 2; ++bj)
#pragma unroll
                    for (int n = 0; n < 2; ++n) { const f32x4 xv = *(const f32x4*)(X + off + bj * HALF + n * 16); *(f32x4*)(O + off + bj * HALF + n * 16) = xv + acc[ai][bj][m][n]; } }
    }
};
}
#include <cstdlib>
#include <vector>

#define XB_TMO      128
#define XB_XCNT(j)  (256  + 64 * (j))
#define XB_XSUB(j)  (1280 + 64 * (j))
#define XB_XGEN(j)  (2304 + 64 * (j))
#define XB_TOP      3328
#define XB_TOPGEN   3392
#define XCD_BAR_WORDS 3456
#define XB_SPIN_CAP (1u << 18)
#define LAS __attribute__((address_space(3)))

__device__ __forceinline__ unsigned xb_ld(unsigned* p)              { return __hip_atomic_load(p, __ATOMIC_RELAXED, __HIP_MEMORY_SCOPE_AGENT); }
__device__ __forceinline__ unsigned xb_add(unsigned* p, unsigned v) { return __hip_atomic_fetch_add(p, v, __ATOMIC_RELAXED, __HIP_MEMORY_SCOPE_AGENT); }
__device__ __forceinline__ unsigned xb_xcc_id() { return (unsigned)__builtin_amdgcn_s_getreg((3 << 11) | 20) & 0xFu; }
#define XB_SPIN(cond, bar) do { unsigned _sp = 0; while (cond) { __builtin_amdgcn_s_sleep(1); \
    if ((++_sp & 255u) == 0u) { if (xb_ld(&(bar)[XB_TMO])) break; if (_sp > XB_SPIN_CAP) { atomicAdd(&(bar)[XB_TMO], 1u); break; } } } } while (0)

struct XcdBarrier {
    unsigned* bar; unsigned x;
    volatile LAS unsigned* st;
};

__device__ __forceinline__ XcdBarrier xcd_barrier_post(unsigned* bar, volatile LAS unsigned* st) {
    XcdBarrier b; b.bar = bar; b.x = xb_xcc_id(); b.st = st;
    if (threadIdx.x == 0) (void)xb_add(&bar[XB_XCNT(b.x)], 1u);
    return b;
}
__device__ __forceinline__ void xcd_barrier_complete(unsigned* bar, unsigned x, unsigned& nloc, unsigned& nx) {
    const unsigned G = gridDim.x * gridDim.y * gridDim.z;
    unsigned sum, cnt, mine, sp = 0u;
    for (;;) {
        sum = 0u; cnt = 0u; mine = 0u;
#pragma unroll
        for (unsigned j = 0; j < 16; ++j) { const unsigned c = xb_ld(&bar[XB_XCNT(j)]); sum += c; cnt += (c > 0u) ? 1u : 0u; mine = (j == x) ? c : mine; }
        if (sum == G) break;
        __builtin_amdgcn_s_sleep(1);
        if ((++sp & 255u) == 0u) { if (xb_ld(&bar[XB_TMO])) break; if (sp > XB_SPIN_CAP) { atomicAdd(&bar[XB_TMO], 1u); break; } }
    }
    nloc = mine > 0u ? mine : 1u; nx = cnt > 0u ? cnt : 1u;
}

__device__ __forceinline__ void xcd_barrier(const XcdBarrier& b) {
    asm volatile("s_waitcnt vmcnt(0)" ::: "memory");
    __syncthreads();
    if (threadIdx.x == 0) {
        unsigned* bar = b.bar;
        __builtin_amdgcn_s_waitcnt(0);
        unsigned nloc = b.st[0], nx = b.st[1];
        if (nloc == 0u) { xcd_barrier_complete(bar, b.x, nloc, nx); b.st[0] = nloc; b.st[1] = nx; }
        const unsigned old = xb_add(&bar[XB_XSUB(b.x)], 1u);
        const unsigned gen = old / nloc;
        if (old + 1u == (gen + 1u) * nloc) {
            __builtin_amdgcn_fence(__ATOMIC_RELEASE, "agent");
            asm volatile("s_waitcnt vmcnt(0)" ::: "memory");
            const unsigned og = xb_add(&bar[XB_TOP], 1u);
            const unsigned tg = og / nx;
            if (og + 1u == (tg + 1u) * nx) xb_add(&bar[XB_TOPGEN], 1u);
            else XB_SPIN(xb_ld(&bar[XB_TOPGEN]) == tg, bar);
            __builtin_amdgcn_fence(__ATOMIC_ACQUIRE, "agent");
            xb_add(&bar[XB_XGEN(b.x)], 1u);
            asm volatile("s_waitcnt vmcnt(0)" ::: "memory");
        } else {
            XB_SPIN(xb_ld(&bar[XB_XGEN(b.x)]) == gen, bar);
            __builtin_amdgcn_fence(__ATOMIC_ACQUIRE, "agent");
            asm volatile("s_waitcnt vmcnt(0)" ::: "memory");
        }
    }
    __syncthreads();
}
__device__ __forceinline__ void prologue_body(int gw, int ngw, int lane, const float* __restrict__ x, const float* __restrict__ norm_w, const float* __restrict__ w_in,
                                              const float* __restrict__ w_out, bf16_t* H, float* IW, bf16_t* WinT, bf16_t* WoutT) {
    for (int m = gw; m < MT; m += ngw) {
        const f32x4_t* xr = (const f32x4_t*)(x + (size_t)m * DM) + lane;
        f32x4_t v[4]; float s = 0.f;
#pragma unroll
        for (int j = 0; j < 4; ++j) { v[j] = xr[64 * j]; s += (v[j].x * v[j].x + v[j].y * v[j].y) + (v[j].z * v[j].z + v[j].w * v[j].w); }
        const float rstd = 1.0f / sqrtf(wave_sum(s) * (1.0f / DM) + EPS);
        float a0 = 0.f, a1 = 0.f, a2 = 0.f, a3 = 0.f;
        u32x2_t* o8 = (u32x2_t*)(H + (size_t)m * DM) + lane;
#pragma unroll
        for (int j = 0; j < 4; ++j) {
            const f32x4_t w = ((const f32x4_t*)norm_w)[64 * j + lane];
            f32x4_t hv; hv.x = v[j].x * rstd * w.x; hv.y = v[j].y * rstd * w.y; hv.z = v[j].z * rstd * w.z; hv.w = v[j].w * rstd * w.w;
            const int d = 256 * j + 4 * lane;
            const f32x4_t w0 = *(const f32x4_t*)(w_in + (size_t)(d + 0) * D_IN + 4416), w1 = *(const f32x4_t*)(w_in + (size_t)(d + 1) * D_IN + 4416);
            const f32x4_t w2 = *(const f32x4_t*)(w_in + (size_t)(d + 2) * D_IN + 4416), w3 = *(const f32x4_t*)(w_in + (size_t)(d + 3) * D_IN + 4416);
            a0 += hv.x * w0.x + hv.y * w1.x + hv.z * w2.x + hv.w * w3.x;
            a1 += hv.x * w0.y + hv.y * w1.y + hv.z * w2.y + hv.w * w3.y;
            a2 += hv.x * w0.z + hv.y * w1.z + hv.z * w2.z + hv.w * w3.z;
            a3 += hv.x * w0.w + hv.y * w1.w + hv.z * w2.w + hv.w * w3.w;
            u32x2_t o; o.x = pk2(hv.x, hv.y); o.y = pk2(hv.z, hv.w); o8[64 * j] = o;
        }
        a0 = wave_sum(a0); a1 = wave_sum(a1); a2 = wave_sum(a2); a3 = wave_sum(a3);
        if (lane == 0) { f32x4_t o = {a0, a1, a2, a3}; *(f32x4_t*)(IW + (size_t)m * 4) = o; }
    }
    const long tid = (long)gw * 64 + lane, nth = (long)ngw * 64;
    for (long i = tid; i < (long)NPAD * (DM / 8); i += nth) {
        const int n = (int)(i % NPAD), k8 = (int)(i / NPAD);
        float e[8];
#pragma unroll
        for (int q = 0; q < 8; ++q) e[q] = (n < D_IN) ? w_in[(size_t)(k8 * 8 + q) * D_IN + n] : 0.f;
        u32x4_t o; o.x = pk2(e[0], e[1]); o.y = pk2(e[2], e[3]); o.z = pk2(e[4], e[5]); o.w = pk2(e[6], e[7]);
        *(u32x4_t*)(WinT + (size_t)n * DM + k8 * 8) = o;
    }
    for (long i = tid; i < (long)DM * (DM / 8); i += nth) {
        const int n = (int)(i % DM), k8 = (int)(i / DM);
        float e[8];
#pragma unroll
        for (int q = 0; q < 8; ++q) e[q] = w_out[(size_t)(k8 * 8 + q) * DM + n];
        u32x4_t o; o.x = pk2(e[0], e[1]); o.y = pk2(e[2], e[3]); o.z = pk2(e[4], e[5]); o.w = pk2(e[6], e[7]);
        *(u32x4_t*)(WoutT + (size_t)n * DM + k8 * 8) = o;
    }
}
__device__ __forceinline__ void final_norm_body(int gw, int ngw, int lane, float* out, const float* __restrict__ fw) {
    for (int m = gw; m < MT; m += ngw) {
        f32x4_t* xr = (f32x4_t*)(out + (size_t)m * DM) + lane;
        f32x4_t v[4]; float s = 0.f;
#pragma unroll
        for (int j = 0; j < 4; ++j) { v[j] = xr[64 * j]; s += (v[j].x * v[j].x + v[j].y * v[j].y) + (v[j].z * v[j].z + v[j].w * v[j].w); }
        const float rstd = 1.0f / sqrtf(wave_sum(s) * (1.0f / DM) + EPS);
#pragma unroll
        for (int j = 0; j < 4; ++j) { const f32x4_t w = ((const f32x4_t*)fw)[64 * j + lane]; f32x4_t o;
            o.x = v[j].x * rstd * w.x; o.y = v[j].y * rstd * w.y; o.z = v[j].z * rstd * w.z; o.w = v[j].w * rstd * w.w; xr[64 * j] = o; }
    }
}

#define WAVE_SYNC() asm volatile("s_waitcnt vmcnt(0) lgkmcnt(0)" ::: "memory")
__device__ __forceinline__ void sel_naive_one(int m, int lane, unsigned* skey, float* sq, unsigned char* ws) {
    const bf16_t* P = (const bf16_t*)(ws + WS_P); const float* IW = (const float*)(ws + WS_IW);
    float* THR = (float*)(ws + WS_THR); int* KCUT = (int*)(ws + WS_KCUT); int* SELCNT = (int*)(ws + WS_SELCNT); int* SEL = (int*)(ws + WS_SEL);
    const int b = m / SEQ, tpos = m % SEQ, N = ((tpos >> 6) + 1) << 6;
    int* sel = SEL + (size_t)m * 256;
    unsigned* MASKW = (unsigned*)(ws + WS_MASK) + ((size_t)(b * 64 + (tpos >> 6)) * 32 * 64 + (tpos & 63)) * 4;
    if (N <= 256) {
        for (int j = lane; j < N; j += 64) sel[j] = j;
        if (lane < N / 64) { u32x2_t o = {0xffffffffu, 0xffffffffu}; *(u32x2_t*)(MASKW + (size_t)(lane >> 1) * 256 + (lane & 1) * 2) = o; }
        if (lane == 0) { THR[m] = -INFINITY; KCUT[m] = 0x7fffffff; SELCNT[m] = N; }
        return;
    }
    { const u32x2_t q = *(const u32x2_t*)(P + PL_IQ * PLANE + (size_t)m * 256 + lane * 4);
      sq[lane * 4 + 0] = bflo(q.x); sq[lane * 4 + 1] = bfhi(q.x); sq[lane * 4 + 2] = bflo(q.y); sq[lane * 4 + 3] = bfhi(q.y); }
    const f32x4_t iw = *(const f32x4_t*)(IW + (size_t)m * 4);
    const float wg0 = iw.x * IDX_SCALE, wg1 = iw.y * IDX_SCALE, wg2 = iw.z * IDX_SCALE, wg3 = iw.w * IDX_SCALE;
    WAVE_SYNC();
    for (int i = 0; i < N / 64; ++i) {
        asm volatile("" ::: "memory");
        const int s = i * 64 + lane; const bf16_t* kr = P + PL_IK * PLANE + (size_t)(b * SEQ + s) * 256;
        float l0 = 0.f, l1 = 0.f, l2 = 0.f, l3 = 0.f;
#pragma unroll
        for (int c = 0; c < 8; ++c) { const u32x4_t kv = *(const u32x4_t*)(kr + c * 8);
            const float k[8] = {bflo(kv.x), bfhi(kv.x), bflo(kv.y), bfhi(kv.y), bflo(kv.z), bfhi(kv.z), bflo(kv.w), bfhi(kv.w)};
#pragma unroll
            for (int e = 0; e < 8; ++e) { const int d = c * 8 + e; l0 += sq[d] * k[e]; l1 += sq[64 + d] * k[e]; l2 += sq[128 + d] * k[e]; l3 += sq[192 + d] * k[e]; } }
        float sc = wg0 * fmaxf(l0, 0.f) + wg1 * fmaxf(l1, 0.f) + wg2 * fmaxf(l2, 0.f) + wg3 * fmaxf(l3, 0.f);
        sc += 0.0f;
        skey[s] = f2key(sc);
    }
    WAVE_SYNC();
    unsigned prefix = 0u;
    for (int bit = 31; bit >= 0; --bit) { const unsigned cand = prefix | (1u << bit); int c = 0;
        for (int i = 0; i < N / 64; ++i) c += (skey[i * 64 + lane] >= cand) ? 1 : 0;
        c = wave_sum_i(c); if (c >= 256) prefix = cand; }
    int cgt = 0; for (int i = 0; i < N / 64; ++i) cgt += (skey[i * 64 + lane] > prefix) ? 1 : 0;
    cgt = wave_sum_i(cgt);
    const int r = 256 - cgt;
    int run = 0, kcut = 0x7fffffff;
    for (int i = 0; i < N / 64; ++i) { const unsigned long long bm = __ballot(skey[i * 64 + lane] == prefix); const int c = __popcll(bm);
        if (run + c >= r) { unsigned long long t = bm; for (int q = 0; q < r - run - 1; ++q) t &= t - 1; kcut = i * 64 + (int)__builtin_ctzll(t); break; }
        run += c; }
    int base = 0;
    for (int i = 0; i < N / 64; ++i) { const unsigned k = skey[i * 64 + lane]; const int idx = i * 64 + lane; const bool f = (k > prefix) || (k == prefix && idx <= kcut);
        const unsigned long long bm = __ballot(f); const int pos = base + __popcll(bm & ((1ull << lane) - 1ull)); if (f && pos < 256) sel[pos] = idx; base += __popcll(bm);
        if (lane == 0) { u32x2_t o = {(unsigned)bm, (unsigned)(bm >> 32)}; *(u32x2_t*)(MASKW + (size_t)(i >> 1) * 256 + (i & 1) * 2) = o; } }
    if (lane == 0) { THR[m] = key2f(prefix); KCUT[m] = kcut; SELCNT[m] = 256; }
    WAVE_SYNC();
}
__device__ __forceinline__ void dsa_naive_one(int m, int lane, float* sq, float* sc, int* ssel, unsigned char* ws, const float* __restrict__ rel_bias) {
    const bf16_t* P = (const bf16_t*)(ws + WS_P); const int* SELCNT = (const int*)(ws + WS_SELCNT); const int* SEL = (const int*)(ws + WS_SEL);
    bf16_t* AOBO = (bf16_t*)(ws + WS_AOBO);
    const int b = m / SEQ, tpos = m % SEQ; const int cnt = SELCNT[m];
    { const int hc = lane * 8; const u32x4_t q = *(const u32x4_t*)(P + (PL_BQ + (hc >> 8)) * PLANE + (size_t)m * 256 + (hc & 255));
      sq[hc + 0] = bflo(q.x); sq[hc + 1] = bfhi(q.x); sq[hc + 2] = bflo(q.y); sq[hc + 3] = bfhi(q.y); sq[hc + 4] = bflo(q.z); sq[hc + 5] = bfhi(q.z); sq[hc + 6] = bflo(q.w); sq[hc + 7] = bfhi(q.w); }
    for (int j = lane; j < 256; j += 64) ssel[j] = (j < cnt) ? SEL[(size_t)m * 256 + j] : 0;
    WAVE_SYNC();
    for (int jj = 0; jj < 4; ++jj) { const int j = jj * 64 + lane;
        if (j < cnt) { const int s = ssel[j]; const size_t ms = (size_t)(b * SEQ + s); const int bk = t5_bucket(s - tpos);
            for (int h = 0; h < 8; ++h) { const bf16_t* kr = P + (PL_BK + (h >> 2)) * PLANE + ms * 256 + (h & 3) * 64; float a = 0.f;
#pragma unroll
                for (int c = 0; c < 8; ++c) { const u32x4_t kv = *(const u32x4_t*)(kr + c * 8); const float* q = &sq[h * 64 + c * 8];
                    a += q[0] * bflo(kv.x) + q[1] * bfhi(kv.x) + q[2] * bflo(kv.y) + q[3] * bfhi(kv.y) + q[4] * bflo(kv.z) + q[5] * bfhi(kv.z) + q[6] * bflo(kv.w) + q[7] * bfhi(kv.w); }
                sc[h * 256 + j] = a + rel_bias[bk * 12 + 4 + h] * LOG2E; }
        } else { for (int h = 0; h < 8; ++h) sc[h * 256 + j] = -INFINITY; }
    }
    WAVE_SYNC();
    for (int h = 0; h < 8; ++h) { float v0 = sc[h * 256 + lane], v1 = sc[h * 256 + 64 + lane], v2 = sc[h * 256 + 128 + lane], v3 = sc[h * 256 + 192 + lane];
        const float mx = wave_max(fmaxf(fmaxf(v0, v1), fmaxf(v2, v3)));
        v0 = __builtin_amdgcn_exp2f(v0 - mx); v1 = __builtin_amdgcn_exp2f(v1 - mx); v2 = __builtin_amdgcn_exp2f(v2 - mx); v3 = __builtin_amdgcn_exp2f(v3 - mx);
        const float inv = 1.0f / wave_sum((v0 + v1) + (v2 + v3));
        sc[h * 256 + lane] = v0 * inv; sc[h * 256 + 64 + lane] = v1 * inv; sc[h * 256 + 128 + lane] = v2 * inv; sc[h * 256 + 192 + lane] = v3 * inv; }
    WAVE_SYNC();
    { const int hc = lane * 8, h = lane >> 3; float acc[8];
#pragma unroll
      for (int e = 0; e < 8; ++e) acc[e] = 0.f;
      for (int j = 0; j < cnt; ++j) { const float p = sc[h * 256 + j]; const int s = ssel[j];
          const u32x4_t vv = *(const u32x4_t*)(P + (PL_BV + (hc >> 8)) * PLANE + (size_t)(b * SEQ + s) * 256 + (hc & 255));
          acc[0] += p * bflo(vv.x); acc[1] += p * bfhi(vv.x); acc[2] += p * bflo(vv.y); acc[3] += p * bfhi(vv.y); acc[4] += p * bflo(vv.z); acc[5] += p * bfhi(vv.z); acc[6] += p * bflo(vv.w); acc[7] += p * bfhi(vv.w); }
      const u32x4_t g = *(const u32x4_t*)(P + (PL_BG + (hc >> 8)) * PLANE + (size_t)m * 256 + (hc & 255));
      u32x4_t o; o.x = pk2(acc[0] * bflo(g.x), acc[1] * bfhi(g.x)); o.y = pk2(acc[2] * bflo(g.y), acc[3] * bfhi(g.y)); o.z = pk2(acc[4] * bflo(g.z), acc[5] * bfhi(g.z)); o.w = pk2(acc[6] * bflo(g.w), acc[7] * bfhi(g.w));
      *(u32x4_t*)(AOBO + (size_t)m * DM + 512 + hc) = o; }
    WAVE_SYNC();
}
__device__ __forceinline__ float diff_lambda(int lane, const float* lq1, const float* lk1, const float* lq2, const float* lk2) {
    return expf(wave_sum(lq1[lane] * lk1[lane])) - expf(wave_sum(lq2[lane] * lk2[lane])) + LAMBDA_INIT; }
__device__ __forceinline__ void diff_naive_one(int m, int h, int lane, float* s1, float* s2, float* sq, float lam, unsigned char* ws, const float* __restrict__ rel_bias, const float* __restrict__ subln_w) {
    const bf16_t* P = (const bf16_t*)(ws + WS_P); bf16_t* AOBO = (bf16_t*)(ws + WS_AOBO);
    const int b = m / SEQ, tpos = m % SEQ, N = ((tpos >> 6) + 1) << 6;
    const int pq = h >> 1, co = (h & 1) * 128;
    { const unsigned q = *(const unsigned*)(P + (PL_AQ + pq) * PLANE + (size_t)m * 256 + co + lane * 2); sq[lane * 2] = bflo(q); sq[lane * 2 + 1] = bfhi(q); }
    WAVE_SYNC();
    float mx1 = -INFINITY, mx2 = -INFINITY;
    for (int i = 0; i < N / 64; ++i) { asm volatile("" ::: "memory"); const int s = i * 64 + lane; const bf16_t* kr = P + (PL_AK + pq) * PLANE + (size_t)(b * SEQ + s) * 256 + co;
        float d1 = 0.f, d2 = 0.f;
#pragma unroll
        for (int c = 0; c < 8; ++c) { const u32x4_t kv = *(const u32x4_t*)(kr + c * 8); const float* q = &sq[c * 8];
            d1 += q[0] * bflo(kv.x) + q[1] * bfhi(kv.x) + q[2] * bflo(kv.y) + q[3] * bfhi(kv.y) + q[4] * bflo(kv.z) + q[5] * bfhi(kv.z) + q[6] * bflo(kv.w) + q[7] * bfhi(kv.w); }
#pragma unroll
        for (int c = 0; c < 8; ++c) { const u32x4_t kv = *(const u32x4_t*)(kr + 64 + c * 8); const float* q = &sq[64 + c * 8];
            d2 += q[0] * bflo(kv.x) + q[1] * bfhi(kv.x) + q[2] * bflo(kv.y) + q[3] * bfhi(kv.y) + q[4] * bflo(kv.z) + q[5] * bfhi(kv.z) + q[6] * bflo(kv.w) + q[7] * bfhi(kv.w); }
        const float bias = rel_bias[t5_bucket(s - tpos) * 12 + h] * LOG2E;
        d1 += bias; d2 += bias; s1[s] = d1; s2[s] = d2; mx1 = fmaxf(mx1, d1); mx2 = fmaxf(mx2, d2); }
    mx1 = wave_max(mx1); mx2 = wave_max(mx2);
    float l1 = 0.f, l2 = 0.f;
    for (int i = 0; i < N / 64; ++i) { const int s = i * 64 + lane; const float p1 = __builtin_amdgcn_exp2f(s1[s] - mx1), p2 = __builtin_amdgcn_exp2f(s2[s] - mx2); s1[s] = p1; s2[s] = p2; l1 += p1; l2 += p2; }
    l1 = wave_sum(l1); l2 = wave_sum(l2);
    const float i1 = 1.0f / l1, i2 = lam / l2;
    for (int i = 0; i < N / 64; ++i) { const int s = i * 64 + lane; s1[s] = s1[s] * i1 - s2[s] * i2; }
    WAVE_SYNC();
    float a0 = 0.f, a1 = 0.f;
    const bf16_t* vb = P + (PL_AV + pq) * PLANE + (size_t)(b * SEQ) * 256 + co + lane * 2;
    for (int s = 0; s < N; ++s) { const float wv = s1[s]; const unsigned vv = *(const unsigned*)(vb + (size_t)s * 256); a0 += wv * bflo(vv); a1 += wv * bfhi(vv); }
    const float rstd = 1.0f / sqrtf(wave_sum(a0 * a0 + a1 * a1) * (1.0f / 128.0f) + EPS);
    const unsigned g = *(const unsigned*)(P + (PL_AG + pq) * PLANE + (size_t)m * 256 + co + lane * 2);
    const float o0 = a0 * rstd * subln_w[lane * 2] * ONE_M_LAMBDA * bflo(g), o1 = a1 * rstd * subln_w[lane * 2 + 1] * ONE_M_LAMBDA * bfhi(g);
    *(unsigned*)(AOBO + (size_t)m * DM + h * 128 + lane * 2) = pk2(o0, o1);
    WAVE_SYNC();
}
namespace dfa {
typedef short bf16x8 __attribute__((ext_vector_type(8)));
typedef short s16x4 __attribute__((ext_vector_type(4)));
typedef float f32x16 __attribute__((ext_vector_type(16)));
typedef LAS const char* lds_cptr;
constexpr int KBUF = 16384, VBUF = 16384;
constexpr int OFF_K = 0, OFF_V = 2 * KBUF, OFF_LUT = OFF_V + 2 * VBUF, OFF_X = OFF_LUT + 1024, LDS_NEED = OFF_X + 65536;
constexpr float THR = 8.0f;
__device__ __forceinline__ int crow(int r, int hi) { return (r & 3) + 8 * (r >> 2) + 4 * hi; }
__device__ __forceinline__ s16x4 vtr(lds_cptr p) { return __builtin_bit_cast(s16x4, __builtin_amdgcn_ds_read_tr16_b64_v4i16((LAS s16x4*)p)); }
__device__ __forceinline__ float swap_other_half(float v) { auto rr = __builtin_amdgcn_permlane32_swap(__float_as_uint(v), __float_as_uint(v), false, false); return __uint_as_float((threadIdx.x & 32) ? rr[0] : rr[1]); }

__device__ __forceinline__ void unit(unsigned char* lds, int b, int h, int cc, const bf16_t* P, bf16_t* AOBO, const float* __restrict__ rel_bias, const float* __restrict__ subln_w, float lam) {
    const int tid = threadIdx.x, lane = tid & 63, r32 = lane & 31, hi = lane >> 5;
    const int w = __builtin_amdgcn_readfirstlane(tid >> 6), j = w & 1, qs = w >> 1;
    const int cw = 2 * cc + (qs >> 1);
    const int NT = 2 * cc + 2, NTw = cw + 1;
    const size_t rowb = (size_t)b * SEQ;
    const bf16_t* Kg = P + (size_t)(PL_AK + (h >> 1)) * PLANE + rowb * 256 + (h & 1) * 128;
    const bf16_t* Vg = P + (size_t)(PL_AV + (h >> 1)) * PLANE + rowb * 256 + (h & 1) * 128;
    const bf16_t* Qg = P + (size_t)(PL_AQ + (h >> 1)) * PLANE + rowb * 256 + (h & 1) * 128;
    const bf16_t* Gg = P + (size_t)(PL_AG + (h >> 1)) * PLANE + rowb * 256 + (h & 1) * 128;
    LAS unsigned char* L = (LAS unsigned char*)lds;
    LAS float* lut = (LAS float*)(L + OFF_LUT);
    if (tid < 256) { const int rel = tid - 192; const float far = rel_bias[15 * 12 + h]; lut[tid] = (rel_bias[t5_bucket(rel) * 12 + h] - far) * LOG2E; }
#define DFA_DMA(t, buf) do { \
        _Pragma("unroll") for (int i_ = 0; i_ < 2; ++i_) { const int ch_ = 2 * w + i_; \
            __builtin_amdgcn_global_load_lds((const unsigned*)(Kg + (size_t)((t) * 64 + lane) * 256 + ch_ * 8), (LAS unsigned*)(L + OFF_K + (buf) * KBUF + ch_ * 1024), 16, 0, 0); } \
        _Pragma("unroll") for (int i_ = 0; i_ < 2; ++i_) { const int ii_ = 2 * w + i_, dq_ = ii_ >> 2, g_ = ii_ & 3; \
            __builtin_amdgcn_global_load_lds((const unsigned*)(Vg + (size_t)((t) * 64 + 16 * g_ + (lane >> 2)) * 256 + dq_ * 32 + (lane & 3) * 8), (LAS unsigned*)(L + OFF_V + (buf) * VBUF + dq_ * 4096 + g_ * 1024), 16, 0, 0); } \
    } while (0)
    DFA_DMA(0, 0);
    bf16x8 qf[4];
    { const bf16_t* qp = Qg + (size_t)(128 * cc + 32 * qs + r32) * 256 + 64 * j + 8 * hi;
#pragma unroll
      for (int d0 = 0; d0 < 4; ++d0) qf[d0] = *(const bf16x8*)(qp + 16 * d0); }
    f32x16 o[4];
#pragma unroll
    for (int dq = 0; dq < 4; ++dq)
#pragma unroll
        for (int r = 0; r < 16; ++r) o[dq][r] = 0.f;
    f32x16 negm;
#pragma unroll
    for (int r = 0; r < 16; ++r) negm[r] = 0.f;
    float mrun = 0.f, lsum = 0.f;
    const int koff = (8 * j + hi) * 1024 + r32 * 16;
    const int voff = ((lane >> 4) & 1) * 32 + (lane & 3) * 8 + (4 * hi + ((lane & 15) >> 2)) * 64;
    asm volatile("s_waitcnt vmcnt(0)" ::: "memory");
    __syncthreads();
    for (int t = 0; t < NT; ++t) {
        const int buf = t & 1;
        if (t + 1 < NT) DFA_DMA(t + 1, buf ^ 1);
        if (t < NTw) {
            const lds_cptr kb = (lds_cptr)(L + OFF_K + buf * KBUF + koff);
            f32x16 s0 = negm, s1 = negm;
#pragma unroll
            for (int d0 = 0; d0 < 4; ++d0) {
                const bf16x8 a0 = *(const LAS bf16x8*)(kb + d0 * 2048), a1 = *(const LAS bf16x8*)(kb + d0 * 2048 + 512);
                s0 = __builtin_amdgcn_mfma_f32_32x32x16_bf16(a0, qf[d0], s0, 0, 0, 0);
                s1 = __builtin_amdgcn_mfma_f32_32x32x16_bf16(a1, qf[d0], s1, 0, 0, 0);
            }
            if (t >= cw - 2) {
                const int base = 192 + 64 * (t - cw) - 32 * (qs & 1) - r32 + 4 * hi;
#pragma unroll
                for (int r = 0; r < 16; ++r) { const int kk = (r & 3) + 8 * (r >> 2); s0[r] += lut[base + kk]; s1[r] += lut[base + 32 + kk]; }
            }
            float tm = fmaxf(s0[0], s1[0]);
#pragma unroll
            for (int r = 1; r < 16; ++r) tm = fmaxf(tm, fmaxf(s0[r], s1[r]));
            tm = fmaxf(tm, swap_other_half(tm));
            const bool first = (t == 0);
            if (first || __any(tm > THR)) {
                const float dl = first ? tm : fmaxf(tm, 0.f);
                mrun += dl;
#pragma unroll
                for (int r = 0; r < 16; ++r) { s0[r] -= dl; s1[r] -= dl; negm[r] = -mrun; }
                const float al = __builtin_amdgcn_exp2f(-dl);
                lsum *= al;
                if (!first) {
#pragma unroll
                    for (int dq = 0; dq < 4; ++dq)
#pragma unroll
                        for (int r = 0; r < 16; ++r) o[dq][r] *= al;
                }
            }
            float ps = 0.f;
#pragma unroll
            for (int r = 0; r < 16; ++r) { s0[r] = __builtin_amdgcn_exp2f(s0[r]); s1[r] = __builtin_amdgcn_exp2f(s1[r]); ps += s0[r] + s1[r]; }
            lsum += ps;
            bf16x8 pf[4];
#pragma unroll
            for (int ks = 0; ks < 2; ++ks) {
                u32x4_t a, c;
                a.x = pk2(s0[8 * ks + 0], s0[8 * ks + 1]); a.y = pk2(s0[8 * ks + 2], s0[8 * ks + 3]); a.z = pk2(s0[8 * ks + 4], s0[8 * ks + 5]); a.w = pk2(s0[8 * ks + 6], s0[8 * ks + 7]);
                c.x = pk2(s1[8 * ks + 0], s1[8 * ks + 1]); c.y = pk2(s1[8 * ks + 2], s1[8 * ks + 3]); c.z = pk2(s1[8 * ks + 4], s1[8 * ks + 5]); c.w = pk2(s1[8 * ks + 6], s1[8 * ks + 7]);
                pf[ks] = __builtin_bit_cast(bf16x8, a); pf[2 + ks] = __builtin_bit_cast(bf16x8, c);
            }
            const lds_cptr vp = (lds_cptr)(L + OFF_V + buf * VBUF + voff);
#pragma unroll
            for (int dq = 0; dq < 4; ++dq)
#pragma unroll
                for (int ks = 0; ks < 4; ++ks) {
                    const s16x4 lo = vtr(vp + dq * 4096 + ks * 1024), hh = vtr(vp + dq * 4096 + ks * 1024 + 512);
                    const bf16x8 vf = {lo[0], lo[1], lo[2], lo[3], hh[0], hh[1], hh[2], hh[3]};
                    o[dq] = __builtin_amdgcn_mfma_f32_32x32x16_bf16(vf, pf[ks], o[dq], 0, 0, 0);
                }
        }
        asm volatile("s_waitcnt vmcnt(0)" ::: "memory");
        __syncthreads();
    }
#undef DFA_DMA
    const float ltot = lsum + swap_other_half(lsum);
    LAS float* X = (LAS float*)(L + OFF_X) + qs * 4096;
    if (j == 1) {
        const float sc = lam / ltot;
#pragma unroll
        for (int dq = 0; dq < 4; ++dq)
#pragma unroll
            for (int r = 0; r < 16; ++r) X[(dq * 16 + r) * 64 + lane] = o[dq][r] * sc;
    }
    __syncthreads();
    if (j == 0) {
        const float inv = 1.0f / ltot; float ss = 0.f;
#pragma unroll
        for (int dq = 0; dq < 4; ++dq)
#pragma unroll
            for (int r = 0; r < 16; ++r) { const float v = o[dq][r] * inv - X[(dq * 16 + r) * 64 + lane]; o[dq][r] = v; ss += v * v; }
        ss += swap_other_half(ss);
        const float rstd = ONE_M_LAMBDA / sqrtf(ss * (1.0f / 128.0f) + EPS);
        const size_t m = rowb + (size_t)(128 * cc + 32 * qs + r32);
        const bf16_t* gp = Gg + (m - rowb) * 256;
        bf16_t* op = AOBO + m * DM + h * 128;
#pragma unroll
        for (int dq = 0; dq < 4; ++dq)
#pragma unroll
            for (int g = 0; g < 4; ++g) { const int dv = 32 * dq + 8 * g + 4 * hi;
                const u32x2_t gv = *(const u32x2_t*)(gp + dv); const f32x4_t sw = *(const f32x4_t*)(subln_w + dv);
                u32x2_t ov; ov.x = pk2(o[dq][4 * g + 0] * rstd * sw.x * bflo(gv.x), o[dq][4 * g + 1] * rstd * sw.y * bfhi(gv.x));
                ov.y = pk2(o[dq][4 * g + 2] * rstd * sw.z * bflo(gv.y), o[dq][4 * g + 3] * rstd * sw.w * bfhi(gv.y));
                *(u32x2_t*)(op + dv) = ov; }
    }
    __syncthreads();
}
__device__ __forceinline__ void phase(unsigned char* lds, int blk, int G, const bf16_t* P, bf16_t* AOBO, const float* rel_bias, const float* subln_w, float lam) {
    if (G == 256) {
        const int x = blk & 7, i = blk >> 3;
        for (int k = 0; k < 4; ++k) { const int id = 4 * x + k; unit(lds, id >> 2, id & 3, (k & 1) ? 31 - i : i, P, AOBO, rel_bias, subln_w, lam); }
    } else {
        for (int u = blk; u < 32 * 32; u += G) unit(lds, (u >> 5) >> 2, (u >> 5) & 3, u & 31, P, AOBO, rel_bias, subln_w, lam);
    }
}
}
namespace dsa {
typedef short bf16x8 __attribute__((ext_vector_type(8)));
typedef short s16x4 __attribute__((ext_vector_type(4)));
typedef float f32x16 __attribute__((ext_vector_type(16)));
typedef LAS const char* lds_cptr;
constexpr int KBUF = 16384, VBUF = 16384;
constexpr int OFF_K = 0, OFF_V = 2 * KBUF, OFF_LUT = OFF_V + 2 * VBUF, LDS_NEED = OFF_LUT + 2048;
constexpr float THR = 8.0f;
__device__ __forceinline__ s16x4 vtr(lds_cptr p) { return __builtin_bit_cast(s16x4, __builtin_amdgcn_ds_read_tr16_b64_v4i16((LAS s16x4*)p)); }
__device__ __forceinline__ float swap_other_half(float v) { auto rr = __builtin_amdgcn_permlane32_swap(__float_as_uint(v), __float_as_uint(v), false, false); return __uint_as_float((threadIdx.x & 32) ? rr[0] : rr[1]); }

__device__ __forceinline__ void unit(unsigned char* lds, int b, int hg, int cc, const bf16_t* P, const unsigned* MASK, bf16_t* AOBO, const float* __restrict__ rel_bias) {
    const int tid = threadIdx.x, lane = tid & 63, r32 = lane & 31, hi = lane >> 5;
    const int w = __builtin_amdgcn_readfirstlane(tid >> 6), hl = w & 1, qs = w >> 1;
    const int cw = 2 * cc + (qs >> 1);
    const int NT = 2 * cc + 2, NTw = cw + 1;
    const int h = 2 * hg + hl;
    const size_t rowb = (size_t)b * SEQ;
    const int pl = hg >> 1, co = (hg & 1) * 128;
    const bf16_t* Kg = P + (size_t)(PL_BK + pl) * PLANE + rowb * 256 + co;
    const bf16_t* Vg = P + (size_t)(PL_BV + pl) * PLANE + rowb * 256 + co;
    const bf16_t* Qg = P + (size_t)(PL_BQ + pl) * PLANE + rowb * 256 + co;
    const bf16_t* Gg = P + (size_t)(PL_BG + pl) * PLANE + rowb * 256 + co;
    LAS unsigned char* L = (LAS unsigned char*)lds;
    LAS float* lut = (LAS float*)(L + OFF_LUT) + hl * 256;
    { const int hh = tid >> 8, rel = (tid & 255) - 192, hd = 4 + 2 * hg + hh; const float far = rel_bias[15 * 12 + hd];
      ((LAS float*)(L + OFF_LUT))[tid] = (rel_bias[t5_bucket(rel) * 12 + hd] - far) * LOG2E; }
#define DSA_DMA(t, buf) do { \
        _Pragma("unroll") for (int i_ = 0; i_ < 2; ++i_) { const int ch_ = 2 * w + i_; \
            __builtin_amdgcn_global_load_lds((const unsigned*)(Kg + (size_t)((t) * 64 + lane) * 256 + ch_ * 8), (LAS unsigned*)(L + OFF_K + (buf) * KBUF + ch_ * 1024), 16, 0, 0); } \
        _Pragma("unroll") for (int i_ = 0; i_ < 2; ++i_) { const int ii_ = 2 * w + i_, dq_ = ii_ >> 2, g_ = ii_ & 3; \
            __builtin_amdgcn_global_load_lds((const unsigned*)(Vg + (size_t)((t) * 64 + 16 * g_ + (lane >> 2)) * 256 + dq_ * 32 + (lane & 3) * 8), (LAS unsigned*)(L + OFF_V + (buf) * VBUF + dq_ * 4096 + g_ * 1024), 16, 0, 0); } \
    } while (0)
    DSA_DMA(0, 0);
    bf16x8 qf[4];
    { const bf16_t* qp = Qg + (size_t)(128 * cc + 32 * qs + r32) * 256 + 64 * hl + 8 * hi;
#pragma unroll
      for (int d0 = 0; d0 < 4; ++d0) qf[d0] = *(const bf16x8*)(qp + 16 * d0); }
    f32x16 o[2];
#pragma unroll
    for (int dq = 0; dq < 2; ++dq)
#pragma unroll
        for (int r = 0; r < 16; ++r) o[dq][r] = 0.f;
    f32x16 negm;
#pragma unroll
    for (int r = 0; r < 16; ++r) negm[r] = 0.f;
    float mrun = 0.f, lsum = 0.f;
    const int koff = (8 * hl + hi) * 1024 + r32 * 16;
    const int voff = ((lane >> 4) & 1) * 32 + (lane & 3) * 8 + (4 * hi + ((lane & 15) >> 2)) * 64 + 2 * hl * 4096;
    const u32x4_t* mrow = (const u32x4_t*)MASK + ((size_t)(b * 64 + cw) * 32) * 64 + (32 * (qs & 1) + r32);
    asm volatile("s_waitcnt vmcnt(0)" ::: "memory");
    __syncthreads();
    u32x4_t mw = {0u, 0u, 0u, 0u};
    for (int t = 0; t < NT; ++t) {
        const int buf = t & 1;
        if (t + 1 < NT) DSA_DMA(t + 1, buf ^ 1);
        if (t < NTw) {
            if ((t & 1) == 0) mw = mrow[(size_t)(t >> 1) * 64];
            const unsigned w0 = ((t & 1) ? mw.z : mw.x) >> (4 * hi), w1 = ((t & 1) ? mw.w : mw.y) >> (4 * hi);
            const lds_cptr kb = (lds_cptr)(L + OFF_K + buf * KBUF + koff);
            f32x16 s0 = negm, s1 = negm;
#pragma unroll
            for (int d0 = 0; d0 < 4; ++d0) {
                const bf16x8 a0 = *(const LAS bf16x8*)(kb + d0 * 2048), a1 = *(const LAS bf16x8*)(kb + d0 * 2048 + 512);
                s0 = __builtin_amdgcn_mfma_f32_32x32x16_bf16(a0, qf[d0], s0, 0, 0, 0);
                s1 = __builtin_amdgcn_mfma_f32_32x32x16_bf16(a1, qf[d0], s1, 0, 0, 0);
            }
            if (t >= cw - 2) {
                const int base = 192 + 64 * (t - cw) - 32 * (qs & 1) - r32 + 4 * hi;
#pragma unroll
                for (int r = 0; r < 16; ++r) { const int kk = (r & 3) + 8 * (r >> 2); s0[r] += lut[base + kk]; s1[r] += lut[base + 32 + kk]; }
            }
            float tm = fmaxf(s0[0], s1[0]);
#pragma unroll
            for (int r = 1; r < 16; ++r) tm = fmaxf(tm, fmaxf(s0[r], s1[r]));
            tm = fmaxf(tm, swap_other_half(tm));
            const bool first = (t == 0);
            if (first || __any(tm > THR)) {
                const float dl = first ? tm : fmaxf(tm, 0.f);
                mrun += dl;
#pragma unroll
                for (int r = 0; r < 16; ++r) { s0[r] -= dl; s1[r] -= dl; negm[r] = -mrun; }
                const float al = __builtin_amdgcn_exp2f(-dl);
                lsum *= al;
                if (!first) {
#pragma unroll
                    for (int dq = 0; dq < 2; ++dq)
#pragma unroll
                        for (int r = 0; r < 16; ++r) o[dq][r] *= al;
                }
            }
            float ps = 0.f;
#pragma unroll
            for (int r = 0; r < 16; ++r) { const int kk = (r & 3) + 8 * (r >> 2);
                const float e0 = __builtin_amdgcn_exp2f(s0[r]), e1 = __builtin_amdgcn_exp2f(s1[r]);
                s0[r] = ((w0 >> kk) & 1u) ? e0 : 0.f; s1[r] = ((w1 >> kk) & 1u) ? e1 : 0.f; ps += s0[r] + s1[r]; }
            lsum += ps;
            bf16x8 pf[4];
#pragma unroll
            for (int ks = 0; ks < 2; ++ks) {
                u32x4_t a, c;
                a.x = pk2(s0[8 * ks + 0], s0[8 * ks + 1]); a.y = pk2(s0[8 * ks + 2], s0[8 * ks + 3]); a.z = pk2(s0[8 * ks + 4], s0[8 * ks + 5]); a.w = pk2(s0[8 * ks + 6], s0[8 * ks + 7]);
                c.x = pk2(s1[8 * ks + 0], s1[8 * ks + 1]); c.y = pk2(s1[8 * ks + 2], s1[8 * ks + 3]); c.z = pk2(s1[8 * ks + 4], s1[8 * ks + 5]); c.w = pk2(s1[8 * ks + 6], s1[8 * ks + 7]);
                pf[ks] = __builtin_bit_cast(bf16x8, a); pf[2 + ks] = __builtin_bit_cast(bf16x8, c);
            }
            const lds_cptr vp = (lds_cptr)(L + OFF_V + buf * VBUF + voff);
#pragma unroll
            for (int dq = 0; dq < 2; ++dq)
#pragma unroll
                for (int ks = 0; ks < 4; ++ks) {
                    const s16x4 lo = vtr(vp + dq * 4096 + ks * 1024), hh = vtr(vp + dq * 4096 + ks * 1024 + 512);
                    const bf16x8 vf = {lo[0], lo[1], lo[2], lo[3], hh[0], hh[1], hh[2], hh[3]};
                    o[dq] = __builtin_amdgcn_mfma_f32_32x32x16_bf16(vf, pf[ks], o[dq], 0, 0, 0);
                }
        }
        asm volatile("s_waitcnt vmcnt(0)" ::: "memory");
        __syncthreads();
    }
#undef DSA_DMA
    {
        const float inv = 1.0f / (lsum + swap_other_half(lsum));
        const size_t m = rowb + (size_t)(128 * cc + 32 * qs + r32);
        const bf16_t* gp = Gg + (m - rowb) * 256 + 64 * hl;
        bf16_t* op = AOBO + m * DM + 512 + h * 64;
#pragma unroll
        for (int dq = 0; dq < 2; ++dq)
#pragma unroll
            for (int g = 0; g < 4; ++g) { const int dv = 32 * dq + 8 * g + 4 * hi;
                const u32x2_t gv = *(const u32x2_t*)(gp + dv);
                u32x2_t ov; ov.x = pk2(o[dq][4 * g + 0] * inv * bflo(gv.x), o[dq][4 * g + 1] * inv * bfhi(gv.x));
                ov.y = pk2(o[dq][4 * g + 2] * inv * bflo(gv.y), o[dq][4 * g + 3] * inv * bfhi(gv.y));
                *(u32x2_t*)(op + dv) = ov; }
    }
    __syncthreads();
}
__device__ __forceinline__ void phase(unsigned char* lds, int blk, int G, const bf16_t* P, const unsigned* MASK, bf16_t* AOBO, const float* rel_bias) {
    if (G == 256) {
        const int x = blk & 7, i = blk >> 3;
        for (int k = 0; k < 4; ++k) { const int id = 4 * x + k; unit(lds, id >> 2, id & 3, (k & 1) ? 31 - i : i, P, MASK, AOBO, rel_bias); }
    } else {
        for (int u = blk; u < 32 * 32; u += G) unit(lds, (u >> 5) >> 2, (u >> 5) & 3, u & 31, P, MASK, AOBO, rel_bias);
    }
}
}
#ifndef DBG_COUNT
#define DBG_COUNT(i) do {} while (0)
#endif
namespace sel {
typedef short bf16x8 __attribute__((ext_vector_type(8)));
typedef float f32x16 __attribute__((ext_vector_type(16)));
constexpr int B1 = 512, KNEG = 256, CAP = 128;
constexpr int OFF_HIST = 0, OFF_TW = 0, OFF_CLS = 16384, OFF_CLI = 32768, OFF_PAR = 66048, OFF_IQ = 70656, OFF_SLOW = 0, LDS_NEED = OFF_IQ + 16384;
constexpr int P_KMAX = 0, P_S0 = 32, P_EST = 64, P_R = 96, P_CC = 128, P_MODE = 160, P_SEG = 192;

__device__ __forceinline__ float other_half(float v) { auto rr = __builtin_amdgcn_permlane32_swap(__float_as_uint(v), __float_as_uint(v), false, false); return __uint_as_float((threadIdx.x & 32) ? rr[0] : rr[1]); }
__device__ __forceinline__ unsigned other_half_u(unsigned v) { auto rr = __builtin_amdgcn_permlane32_swap(v, v, false, false); return (threadIdx.x & 32) ? rr[0] : rr[1]; }

struct Tile { bf16x8 a[4]; };
__device__ __forceinline__ void load_tile(Tile& t, const bf16_t* ikrow) {
#pragma unroll
    for (int d0 = 0; d0 < 4; ++d0) t.a[d0] = *(const bf16x8*)(ikrow + 16 * d0);
}
__device__ __forceinline__ void score_tile(f32x16& sc, const Tile& t, LAS const char* iqb, const float (&wg)[4]) {
    asm volatile("" ::: "memory");
#pragma unroll
    for (int h = 0; h < 4; ++h) {
        __builtin_amdgcn_sched_barrier(0);
        f32x16 l;
#pragma unroll
        for (int r = 0; r < 16; ++r) l[r] = 0.f;
#pragma unroll
        for (int d0 = 0; d0 < 4; ++d0) { const bf16x8 bqf = *(const LAS bf16x8*)(iqb + (8 * h + 2 * d0) * 512); l = __builtin_amdgcn_mfma_f32_32x32x16_bf16(t.a[d0], bqf, l, 0, 0, 0); }
#pragma unroll
        for (int r = 0; r < 16; ++r) sc[r] = (h == 0) ? wg[0] * fmaxf(l[r], 0.f) : fmaf(wg[h], fmaxf(l[r], 0.f), sc[r]);
    }
#pragma unroll
    for (int r = 0; r < 16; ++r) sc[r] = sc[r] + 0.0f;
}
__device__ __forceinline__ int bin_of(float s, float s0, int s0b) {
    int fl = (__float_as_int(fabsf(s) + s0) - s0b) >> 19; fl = fl > 255 ? 255 : fl;
    return KNEG + (fl ^ (__float_as_int(s) >> 31));
}
__device__ __forceinline__ void sel_slow_one(int b, int c, int q, int lane, unsigned* skey, float* sq, const bf16_t* P, const float* IW, unsigned* MW) {
    const int m = b * SEQ + 64 * c + q, N = 64 * (c + 1);
    { const u32x2_t qv = *(const u32x2_t*)(P + PL_IQ * PLANE + (size_t)m * 256 + lane * 4);
      sq[lane * 4 + 0] = bflo(qv.x); sq[lane * 4 + 1] = bfhi(qv.x); sq[lane * 4 + 2] = bflo(qv.y); sq[lane * 4 + 3] = bfhi(qv.y); }
    const f32x4_t iw = *(const f32x4_t*)(IW + (size_t)m * 4);
    const float wg0 = iw.x * IDX_SCALE, wg1 = iw.y * IDX_SCALE, wg2 = iw.z * IDX_SCALE, wg3 = iw.w * IDX_SCALE;
    WAVE_SYNC();
    for (int i = 0; i < N / 64; ++i) {
        asm volatile("" ::: "memory");
        const int s = i * 64 + lane; const bf16_t* kr = P + PL_IK * PLANE + (size_t)(b * SEQ + s) * 256;
        float l0 = 0.f, l1 = 0.f, l2 = 0.f, l3 = 0.f;
#pragma unroll
        for (int cc = 0; cc < 8; ++cc) { const u32x4_t kv = *(const u32x4_t*)(kr + cc * 8);
            const float k[8] = {bflo(kv.x), bfhi(kv.x), bflo(kv.y), bfhi(kv.y), bflo(kv.z), bfhi(kv.z), bflo(kv.w), bfhi(kv.w)};
#pragma unroll
            for (int e = 0; e < 8; ++e) { const int d = cc * 8 + e; l0 += sq[d] * k[e]; l1 += sq[64 + d] * k[e]; l2 += sq[128 + d] * k[e]; l3 += sq[192 + d] * k[e]; } }
        float sc = wg0 * fmaxf(l0, 0.f); sc = fmaf(wg1, fmaxf(l1, 0.f), sc); sc = fmaf(wg2, fmaxf(l2, 0.f), sc); sc = fmaf(wg3, fmaxf(l3, 0.f), sc);
        sc += 0.0f;
        skey[s] = f2key(sc);
    }
    WAVE_SYNC();
    unsigned prefix = 0u;
    for (int bit = 31; bit >= 0; --bit) { const unsigned cand = prefix | (1u << bit); int cn = 0;
        for (int i = 0; i < N / 64; ++i) cn += (skey[i * 64 + lane] >= cand) ? 1 : 0;
        cn = wave_sum_i(cn); if (cn >= 256) prefix = cand; }
    int cgt = 0; for (int i = 0; i < N / 64; ++i) cgt += (skey[i * 64 + lane] > prefix) ? 1 : 0;
    cgt = wave_sum_i(cgt);
    const int r = 256 - cgt;
    int run = 0, kcut = 0x7fffffff;
    for (int i = 0; i < N / 64; ++i) { const unsigned long long bm = __ballot(skey[i * 64 + lane] == prefix); const int cn = __popcll(bm);
        if (run + cn >= r) { unsigned long long t = bm; for (int z = 0; z < r - run - 1; ++z) t &= t - 1; kcut = i * 64 + (int)__builtin_ctzll(t); break; }
        run += cn; }
    for (int i = 0; i < N / 64; ++i) { const unsigned k = skey[i * 64 + lane]; const int idx = i * 64 + lane; const bool f = (k > prefix) || (k == prefix && idx <= kcut);
        const unsigned long long bm = __ballot(f);
        if (lane == 0) { u32x2_t o = {(unsigned)bm, (unsigned)(bm >> 32)}; *(u32x2_t*)(MW + ((size_t)(i >> 1) * 64 + q) * 4 + (i & 1) * 2) = o; } }
    WAVE_SYNC();
}

__device__ __forceinline__ void unit(unsigned char* lds, int b, int c, int hq, const bf16_t* P, const float* IW, unsigned* MASK) {
    const int tid = threadIdx.x, lane = tid & 63, r32 = lane & 31, hi = lane >> 5;
    const int w = __builtin_amdgcn_readfirstlane(tid >> 6);
    const int N = 64 * (c + 1), NT32 = N / 32;
    unsigned* MW = MASK + ((size_t)(b * 64 + c) * 32 * 64) * 4;
    if (c < 4) {
        for (int idx = tid; idx < 32 * NT32; idx += 512) { const int q = 32 * hq + (idx & 31), kt = idx >> 5; MW[((size_t)(kt >> 2) * 64 + q) * 4 + (kt & 3)] = 0xffffffffu; }
        return;
    }
    LAS unsigned* hist = (LAS unsigned*)((LAS unsigned char*)lds + OFF_HIST);
    LAS unsigned* TW = (LAS unsigned*)((LAS unsigned char*)lds + OFF_TW);
    LAS float* CLS = (LAS float*)((LAS unsigned char*)lds + OFF_CLS);
    LAS unsigned* CLI = (LAS unsigned*)((LAS unsigned char*)lds + OFF_CLI);
    LAS unsigned* PAR = (LAS unsigned*)((LAS unsigned char*)lds + OFF_PAR);
    const int q = r32, qc = 32 * hq + r32;
    const size_t m = (size_t)b * SEQ + 64 * c + qc;
    {
        const bf16_t* qrow = P + (size_t)PL_IQ * PLANE + ((size_t)b * SEQ + 64 * c + 32 * hq) * 256;
#pragma unroll
        for (int i = 0; i < 2; ++i) { const int p = tid + 512 * i, qq = p >> 5, ch = p & 31;
            *(LAS u32x4_t*)((LAS unsigned char*)lds + OFF_IQ + ch * 512 + qq * 16) = *(const u32x4_t*)(qrow + (size_t)qq * 256 + ch * 8); }
    }
    LAS const char* iqb = (LAS const char*)((LAS unsigned char*)lds + OFF_IQ + hi * 512 + q * 16);
    float wg[4];
    { const f32x4_t iw = *(const f32x4_t*)(IW + m * 4); wg[0] = iw.x * IDX_SCALE; wg[1] = iw.y * IDX_SCALE; wg[2] = iw.z * IDX_SCALE; wg[3] = iw.w * IDX_SCALE; }
    const bf16_t* ikl = P + (size_t)PL_IK * PLANE + ((size_t)b * SEQ + r32) * 256 + 8 * hi;
    for (int i = tid; i < 513 * 32; i += 512) hist[i] = 0u;
    if (tid < 32) { PAR[P_KMAX + tid] = 0u; PAR[P_CC + tid] = 0u; }
    __syncthreads();
    {   float mx = 0.f;
        for (int kt = w; kt < NT32; kt += 64) { Tile t; load_tile(t, ikl + (size_t)kt * 32 * 256); f32x16 sc; score_tile(sc, t, iqb, wg);
#pragma unroll
            for (int r = 0; r < 16; ++r) mx = fmaxf(mx, fabsf(sc[r])); }
        mx = fmaxf(mx, other_half(mx));
        if (hi == 0) atomicMax((unsigned*)&PAR[P_KMAX + q], __float_as_uint(mx));
    }
    __syncthreads();
    if (tid < 32) { const float R = __uint_as_float(PAR[P_KMAX + tid]) * 1.125f + 1e-30f; PAR[P_S0 + tid] = __float_as_uint(R * (1.0f / 65536.0f)); }
    __syncthreads();
    const float s0 = __uint_as_float(PAR[P_S0 + q]); const int s0b = (int)PAR[P_S0 + q];
    {   Tile t0, t1;
        if (w < NT32) load_tile(t0, ikl + (size_t)w * 32 * 256);
        for (int kt = w; kt < NT32; kt += 16) {
            if (kt + 8 < NT32) load_tile(t1, ikl + (size_t)(kt + 8) * 32 * 256);
            { f32x16 sc; score_tile(sc, t0, iqb, wg);
#pragma unroll
              for (int r = 0; r < 16; ++r) { int bn = bin_of(sc[r], s0, s0b); bn = (sc[r] != 0.f) ? bn : B1; atomicAdd((unsigned*)&hist[bn * 32 + q], 1u); } }
            if (kt + 8 < NT32) {
                if (kt + 16 < NT32) load_tile(t0, ikl + (size_t)(kt + 16) * 32 * 256);
                f32x16 sc; score_tile(sc, t1, iqb, wg);
#pragma unroll
                for (int r = 0; r < 16; ++r) { int bn = bin_of(sc[r], s0, s0b); bn = (sc[r] != 0.f) ? bn : B1; atomicAdd((unsigned*)&hist[bn * 32 + q], 1u); }
            }
        }
    }
    __syncthreads();
    {   const int sq_ = tid & 31, seg = tid >> 5; unsigned ssum = 0u;
#pragma unroll 8
        for (int i = 0; i < 32; ++i) ssum += hist[(seg * 32 + i) * 32 + sq_];
        PAR[P_SEG + sq_ * 16 + seg] = ssum;
    }
    __syncthreads();
    if (tid < 32) {
        const int cntZ = (int)hist[B1 * 32 + tid];
        int cum = 0, est = -1, mode = 0, R = 0, cnt = 0;
#pragma nounroll
        for (int step = 0; step < 17 && est < 0; ++step) {
            if (step == 8) { if (cum + cntZ >= 256) { est = 2 * KNEG; R = 256 - cum; mode = 1; cnt = cntZ; } else cum += cntZ; }
            else { const int seg = step < 8 ? 15 - step : 16 - step; const int ssum = (int)PAR[P_SEG + tid * 16 + seg];
                if (cum + ssum >= 256) {
#pragma nounroll
                    for (int bn = seg * 32 + 31; bn >= seg * 32; --bn) { const int hcount = (int)hist[bn * 32 + tid]; if (cum + hcount >= 256) { est = 2 * bn + 1; R = 256 - cum; cnt = hcount; break; } cum += hcount; }
                } else cum += ssum; }
        }
        if (est < 0) { est = 1; R = 1; mode = 2; }
        if (mode == 0 && cnt > CAP) mode = 2;
        PAR[P_EST + tid] = (unsigned)est; PAR[P_R + tid] = (unsigned)R; PAR[P_MODE + tid] = (unsigned)mode;
    }
    __syncthreads();
    const int est = (int)PAR[P_EST + q]; const bool normal = (PAR[P_MODE + q] == 0u);
    {   Tile t0, t1;
        if (w < NT32) load_tile(t0, ikl + (size_t)w * 32 * 256);
#define SEL_FINAL_TILE(T, KT) do { f32x16 sc; score_tile(sc, T, iqb, wg); unsigned gp = 0u, ep = 0u; \
            _Pragma("unroll") for (int r = 0; r < 16; ++r) { const int bn = bin_of(sc[r], s0, s0b); const int e = 2 * bn + (sc[r] != 0.f ? 1 : 0); const int pos = (r & 3) + 8 * (r >> 2); \
                gp |= (e > est ? 1u : 0u) << pos; ep |= (e == est ? 1u : 0u) << pos; } \
            unsigned cb = normal ? ep : 0u; \
            while (__any(cb != 0u)) { \
                if (cb != 0u) { const int pos = __builtin_ctz(cb); cb &= cb - 1u; const int rr = (pos & 3) + 4 * (pos >> 3); float val = sc[0]; \
                    _Pragma("unroll") for (int r = 1; r < 16; ++r) val = (rr == r) ? sc[r] : val; \
                    const unsigned slot = atomicAdd((unsigned*)&PAR[P_CC + q], 1u); \
                    if (slot < (unsigned)CAP) { CLS[q * CAP + slot] = val; CLI[q * CAP + slot] = (unsigned)((KT) * 32 + pos + 4 * hi); } } } \
            gp <<= 4 * hi; ep <<= 4 * hi; gp |= other_half_u(gp); ep |= other_half_u(ep); \
            if (hi == 0) { MW[((size_t)((KT) >> 2) * 64 + qc) * 4 + ((KT) & 3)] = gp; TW[q * 128 + (KT)] = ep; } } while (0)
        for (int kt = w; kt < NT32; kt += 16) {
            if (kt + 8 < NT32) load_tile(t1, ikl + (size_t)(kt + 8) * 32 * 256);
            SEL_FINAL_TILE(t0, kt);
            if (kt + 8 < NT32) {
                if (kt + 16 < NT32) load_tile(t0, ikl + (size_t)(kt + 16) * 32 * 256);
                SEL_FINAL_TILE(t1, kt + 8);
            }
        }
#undef SEL_FINAL_TILE
    }
    asm volatile("s_waitcnt vmcnt(0) lgkmcnt(0)" ::: "memory");
    __syncthreads();
    for (int qq = w; qq < 32; qq += 8) {
        const unsigned mode = PAR[P_MODE + qq]; const int R = (int)PAR[P_R + qq]; const int qqc = 32 * hq + qq;
        if (mode == 0u) {
            const int n = (int)PAR[P_CC + qq];
            if (n > CAP) { if (lane == 0) PAR[P_MODE + qq] = 2u; }
            else {
                const float s_lo = lane < n ? CLS[qq * CAP + lane] : -INFINITY, s_hi = (lane + 64) < n ? CLS[qq * CAP + 64 + lane] : -INFINITY;
                const unsigned i_lo = lane < n ? CLI[qq * CAP + lane] : 0xffffffffu, i_hi = (lane + 64) < n ? CLI[qq * CAP + 64 + lane] : 0xffffffffu;
                int rk_lo = 0, rk_hi = 0;
                const int n1 = n < 64 ? n : 64;
                for (int i = 0; i < n1; ++i) { const float si = __uint_as_float(__builtin_amdgcn_readlane(__float_as_uint(s_lo), i)); const unsigned ii = __builtin_amdgcn_readlane(i_lo, i);
                    rk_lo += ((si > s_lo) || (si == s_lo && ii < i_lo)) ? 1 : 0; rk_hi += ((si > s_hi) || (si == s_hi && ii < i_hi)) ? 1 : 0; }
                for (int i = 64; i < n; ++i) { const float si = __uint_as_float(__builtin_amdgcn_readlane(__float_as_uint(s_hi), i - 64)); const unsigned ii = __builtin_amdgcn_readlane(i_hi, i - 64);
                    rk_lo += ((si > s_lo) || (si == s_lo && ii < i_lo)) ? 1 : 0; rk_hi += ((si > s_hi) || (si == s_hi && ii < i_hi)) ? 1 : 0; }
                if (lane < n && rk_lo < R) atomicOr(&MW[((size_t)(i_lo >> 7) * 64 + qqc) * 4 + ((i_lo >> 5) & 3)], 1u << (i_lo & 31));
                if ((lane + 64) < n && rk_hi < R) atomicOr(&MW[((size_t)(i_hi >> 7) * 64 + qqc) * 4 + ((i_hi >> 5) & 3)], 1u << (i_hi & 31));
            }
        } else if (mode == 1u) {
            const unsigned w0 = lane < NT32 ? TW[qq * 128 + lane] : 0u, w1 = (lane + 64) < NT32 ? TW[qq * 128 + 64 + lane] : 0u;
            const int c0 = __popc(w0), c1 = __popc(w1);
            int p0 = c0, p1 = c1;
#pragma unroll
            for (int o = 1; o < 64; o <<= 1) { const int t0 = __shfl_up(p0, o), t1 = __shfl_up(p1, o); if (lane >= o) { p0 += t0; p1 += t1; } }
            const int tot0 = __shfl(p0, 63);
            const int before0 = p0 - c0, before1 = tot0 + p1 - c1;
#pragma unroll
            for (int half = 0; half < 2; ++half) {
                unsigned wv = half ? w1 : w0; const int cnt = half ? c1 : c0; const int before = half ? before1 : before0; const int kt = lane + 64 * half;
                int take = R - before; take = take < 0 ? 0 : (take > cnt ? cnt : take);
                if (take > 0) { unsigned res = 0u; for (int z = 0; z < take; ++z) { const unsigned low = wv & (0u - wv); res |= low; wv ^= low; }
                    atomicOr(&MW[((size_t)(kt >> 2) * 64 + qqc) * 4 + (kt & 3)], res); }
            }
        }
    }
    asm volatile("s_waitcnt vmcnt(0) lgkmcnt(0)" ::: "memory");
    __syncthreads();
    if (w < 3) {
        unsigned* skey = (unsigned*)(lds + OFF_SLOW + w * 17408); float* sq = (float*)(lds + OFF_SLOW + w * 17408 + 16384);
        int seen = 0;
        for (int qq = 0; qq < 32; ++qq) if (PAR[P_MODE + qq] == 2u) { if ((seen % 3) == w) { sel_slow_one(b, c, 32 * hq + qq, lane, skey, sq, P, IW, MW); DBG_COUNT(0); } ++seen; }
    }
    asm volatile("s_waitcnt vmcnt(0) lgkmcnt(0)" ::: "memory");
    __syncthreads();
}
__device__ __forceinline__ void phase(unsigned char* lds, int blk, int G, const bf16_t* P, const float* IW, unsigned* MASK) {
    if (G == 256) { const int b = blk & 7, i = blk >> 3;
        for (int k = 0; k < 4; ++k) unit(lds, b, (k & 2) ? 63 - i : i, k & 1, P, IW, MASK); }
    else { for (int u = blk; u < NBATCH * 128; u += G) unit(lds, u >> 7, (u >> 1) & 63, u & 1, P, IW, MASK); }
}
}
constexpr int LDS_MAIN = 139264;
constexpr int MISC_OFF = LDS_MAIN, LDS_BYTES = LDS_MAIN + 64;
constexpr size_t BAR_BYTES = (size_t)XCD_BAR_WORDS * 4;
#ifndef REP_GEMM1
#define REP_GEMM1 1
#endif
#ifndef REP_SEL
#define REP_SEL 1
#endif
#ifndef REP_DSA
#define REP_DSA 1
#endif
#ifndef REP_DFA
#define REP_DFA 1
#endif
#ifndef REP_OUT
#define REP_OUT 1
#endif
struct Args { const float* in[11]; float* out; unsigned char* ws; };

__global__ void __launch_bounds__(512, 2) fwd(Args a) {
    extern __shared__ __attribute__((aligned(16))) unsigned char lds[];
    const int tid = threadIdx.x, lane = tid & 63, wave = __builtin_amdgcn_readfirstlane(tid >> 6);
    volatile LAS unsigned* misc = (volatile LAS unsigned*)((LAS unsigned char*)lds + MISC_OFF);
    if (tid < 16) misc[tid] = 0u;
    __syncthreads();
    XcdBarrier bar = xcd_barrier_post((unsigned*)a.ws, misc);
    const int G = gridDim.x, gw = blockIdx.x * 8 + wave, ngw = G * 8;
    unsigned char* ws = a.ws;
    const float* x = a.in[0]; const float* rel_bias = a.in[9];
    prologue_body(gw, ngw, lane, x, a.in[1], a.in[2], a.in[3], (bf16_t*)(ws + WS_H), (float*)(ws + WS_IW), (bf16_t*)(ws + WS_WINT), (bf16_t*)(ws + WS_WOUTT));
    xcd_barrier(bar);
    for (int rep = 0; rep < REP_GEMM1; ++rep)
    { pg8::Gemm g{(const bf16_t*)(ws + WS_H), (const bf16_t*)(ws + WS_WINT), MT, NPAD, DM}; pg8::StaticOrder S; S.init(MT, NPAD, G, (int)blockIdx.x);
      pg8::EpiProj E{(bf16_t*)(ws + WS_P)};
      pg8::gemm_phase<pg8::EpiProj, pg8::StaticOrder, true, true>((PG8_LAS unsigned char*)lds, g, S, E); }
    xcd_barrier(bar);
    for (int rep = 0; rep < REP_SEL; ++rep)
    sel::phase(lds, (int)blockIdx.x, G, (const bf16_t*)(ws + WS_P), (const float*)(ws + WS_IW), (unsigned*)(ws + WS_MASK));
    xcd_barrier(bar);
    for (int rep = 0; rep < REP_DSA; ++rep)
    dsa::phase(lds, (int)blockIdx.x, G, (const bf16_t*)(ws + WS_P), (const unsigned*)(ws + WS_MASK), (bf16_t*)(ws + WS_AOBO), rel_bias);
    __syncthreads();
    { const float lam = diff_lambda(lane, a.in[4], a.in[5], a.in[6], a.in[7]);
      for (int rep = 0; rep < REP_DFA; ++rep)
      dfa::phase(lds, (int)blockIdx.x, G, (const bf16_t*)(ws + WS_P), (bf16_t*)(ws + WS_AOBO), rel_bias, a.in[8], lam); }
    xcd_barrier(bar);
    for (int rep = 0; rep < REP_OUT; ++rep)
    { pg8::Gemm g{(const bf16_t*)(ws + WS_AOBO), (const bf16_t*)(ws + WS_WOUTT), MT, DM, DM}; pg8::StaticOrder S; S.init(MT, DM, G, (int)blockIdx.x);
      pg8::EpiOut E{x, a.out};
      pg8::gemm_phase<pg8::EpiOut, pg8::StaticOrder, true, true>((PG8_LAS unsigned char*)lds, g, S, E); }
    xcd_barrier(bar);
    final_norm_body(gw, ngw, lane, a.out, a.in[10]);
#ifdef DBG_ENCODE
    DBG_ENCODE
#endif
}

extern "C" void kernel_launch(void* const* d_in, const int* in_sizes, int n_in, void* d_out, int out_size, void* d_ws, size_t ws_size, hipStream_t stream) {
    static int grid = 0;
    if (grid == 0) {
        if (n_in != 11 || out_size != MT * DM || ws_size < WS_END) { fprintf(stderr, "kernel_launch: unexpected shapes (n_in %d out %d ws %zu need %zu)\n", n_in, out_size, ws_size, (size_t)WS_END); grid = -1; return; }
        int dev = 0, cus = 0, per_cu = 0;
        if (hipGetDevice(&dev) != hipSuccess || hipDeviceGetAttribute(&cus, hipDeviceAttributeMultiprocessorCount, dev) != hipSuccess) { grid = -1; return; }
        if (hipFuncSetAttribute((const void*)fwd, hipFuncAttributeMaxDynamicSharedMemorySize, LDS_BYTES) != hipSuccess) { fprintf(stderr, "kernel_launch: hipFuncSetAttribute failed\n"); grid = -1; return; }
        if (hipOccupancyMaxActiveBlocksPerMultiprocessor(&per_cu, (const void*)fwd, 512, LDS_BYTES) != hipSuccess || per_cu < 1) { fprintf(stderr, "kernel_launch: occupancy query says %d blocks per CU\n", per_cu); (void)hipGetLastError(); }
        grid = cus;
    }
    if (grid < 0) return;
    if (hipMemsetAsync(d_ws, 0, 16384, stream) != hipSuccess) { fprintf(stderr, "kernel_launch: memset failed\n"); return; }
    Args a; memset(&a, 0, sizeof(a));
    for (int i = 0; i < 11; ++i) a.in[i] = (const float*)d_in[i];
    a.out = (float*)d_out; a.ws = (unsigned char*)d_ws;
    hipLaunchKernelGGL(fwd, dim3(grid), dim3(512), LDS_BYTES, stream, a);
}
```

```cpp
#include <hip/hip_runtime.h>
#include <cstdio>
#include <cstdint>
#include <cstring>
#include <cmath>
#define LAS __attribute__((address_space(3)))
typedef unsigned short bf16_t;
typedef unsigned u32x4_t __attribute__((ext_vector_type(4)));
typedef unsigned u32x2_t __attribute__((ext_vector_type(2)));
typedef float f32x4_t __attribute__((ext_vector_type(4)));

constexpr int DM = 1024, NBATCH = 8, SEQ = 4096, MT = NBATCH * SEQ;
constexpr int D_IN = 4420, NPAD = 4608, NPLANES = 18;
constexpr float EPS = 1e-6f, LOG2E = 1.4426950408889634f;
constexpr float C2 = 0.125f * LOG2E;
constexpr float IDX_SCALE = 0.0625f;
constexpr float LAMBDA_INIT = 0.2f, ONE_M_LAMBDA = 0.8f;
constexpr size_t PLANE = (size_t)MT * 256;
constexpr int PL_AQ = 0, PL_AK = 2, PL_AV = 4, PL_AG = 6, PL_BQ = 8, PL_BK = 10, PL_BV = 12, PL_BG = 14, PL_IQ = 16, PL_IK = 17;

constexpr size_t WS_CTL = 0;
constexpr size_t WS_WINT = 65536;
constexpr size_t WS_WOUTT = WS_WINT + (size_t)NPAD * DM * 2;
constexpr size_t WS_H = WS_WOUTT + (size_t)DM * DM * 2;
constexpr size_t WS_P = WS_H + (size_t)MT * DM * 2;
constexpr size_t WS_IW = WS_P + (size_t)NPLANES * PLANE * 2;
constexpr size_t WS_THR = WS_IW + (size_t)MT * 16;
constexpr size_t WS_KCUT = WS_THR + (size_t)MT * 4;
constexpr size_t WS_SELCNT = WS_KCUT + (size_t)MT * 4;
constexpr size_t WS_AOBO = WS_SELCNT + (size_t)MT * 4;
constexpr size_t WS_SEL = WS_AOBO + (size_t)MT * DM * 2;
constexpr size_t WS_MASK = WS_SEL + (size_t)MT * 256 * 4;
constexpr size_t WS_END = WS_MASK + (size_t)NBATCH * 64 * 32 * 64 * 16;

__device__ __forceinline__ float bf2f(bf16_t v) { return __uint_as_float(((unsigned)v) << 16); }
__device__ __forceinline__ float bflo(unsigned w) { return __uint_as_float(w << 16); }
__device__ __forceinline__ float bfhi(unsigned w) { return __uint_as_float(w & 0xffff0000u); }
__device__ __forceinline__ unsigned pk2(float lo, float hi) {
    typedef float f2 __attribute__((ext_vector_type(2))); typedef __bf16 b2 __attribute__((ext_vector_type(2)));
    f2 v = {lo, hi}; b2 b = __builtin_convertvector(v, b2); return __builtin_bit_cast(unsigned, b); }
__device__ __forceinline__ float wave_sum(float v) {
#pragma unroll
    for (int o = 1; o < 64; o <<= 1) v += __shfl_xor(v, o);
    return v; }
__device__ __forceinline__ int wave_sum_i(int v) {
#pragma unroll
    for (int o = 1; o < 64; o <<= 1) v += __shfl_xor(v, o);
    return v; }
__device__ __forceinline__ float wave_max(float v) {
#pragma unroll
    for (int o = 1; o < 64; o <<= 1) v = fmaxf(v, __shfl_xor(v, o));
    return v; }
__device__ __forceinline__ int t5_bucket(int rel) {
    const int ret = rel > 0 ? 16 : 0; const int n = rel < 0 ? -rel : rel;
    if (n < 8) return ret + n;
    int large = 2 + (31 - __builtin_clz((unsigned)(n * n))); large = large > 15 ? 15 : large;
    return ret + large; }
__device__ __forceinline__ unsigned f2key(float f) { const unsigned u = __float_as_uint(f); return (u & 0x80000000u) ? ~u : (u | 0x80000000u); }
__device__ __forceinline__ float key2f(unsigned k) { return __uint_as_float((k & 0x80000000u) ? (k ^ 0x80000000u) : ~k); }
__device__ __forceinline__ float silu_f(float v) { return v * __builtin_amdgcn_rcpf(1.0f + __builtin_amdgcn_exp2f(-v * LOG2E)); }
namespace pg8 {
#define PG8_LAS __attribute__((address_space(3)))
typedef unsigned short bf16_t;
typedef short bf16x8 __attribute__((ext_vector_type(8)));
typedef float f32x4 __attribute__((ext_vector_type(4)));
typedef unsigned u32x4 __attribute__((ext_vector_type(4)));
constexpr int BM = 256, BK = 64, HALF = 128, HTB = HALF * BK * 2  , STAGE_BYTES = 8 * HTB, NXCD = 8, WGM = 8;

__host__ __device__ __forceinline__ int lds_byte(int r, int c) { const int st = (r >> 4) * 2 + (c >> 5), rr = r & 15, cc = c & 31, ob = rr * 64 + cc * 2; return st * 1024 + (ob ^ (((ob >> 9) & 1) << 5)); }
__host__ __device__ __forceinline__ void stage_rc(int b, int& R, int& C) { const int st = b / 1024, sb = b % 1024, swz = sb ^ (((sb >> 9) & 1) << 5); R = (st >> 1) * 16 + swz / 64; C = (st & 1) * 32 + (swz % 64) / 2; }
__host__ __device__ __forceinline__ int perm32(int rho) { const int n = rho >> 4, i = rho & 15; return 8 * (i >> 2) + 4 * n + (i & 3); }

struct Unit { int pm, pn; };
struct Gemm { const bf16_t* A; const bf16_t* Bt; int M, N, K; };

struct StaticOrder {
    int nM, nN, nwg, G, c;
    __host__ __device__ void init(int M, int N, int G_, int c_) { nM = M / BM; nN = N / BM; nwg = nM * nN; G = G_; c = c_; }
    __host__ __device__ bool next(int i, Unit& u) const {
        const long L = (long)i * G + c; if (L >= nwg) return false;
        int wgid = (int)L; { const int q = nwg / NXCD, r = nwg % NXCD, xcd = wgid % NXCD, off = wgid / NXCD; wgid = (xcd < r ? xcd * (q + 1) : r * (q + 1) + (xcd - r) * q) + off; }
        const int nig = WGM * nN, gid = wgid / nig, fm = gid * WGM, gsz = (nM - fm) < WGM ? (nM - fm) : WGM;
        u.pm = fm + ((wgid % nig) % gsz); u.pn = (wgid % nig) / gsz; return true;
    }
    __device__ __forceinline__ void a_ready(const Unit&) const {}
    __device__ __forceinline__ void done(const Unit&) const {}
};

__device__ __forceinline__ unsigned cvt_pk_bf16(float lo, float hi) { unsigned r; asm volatile("v_cvt_pk_bf16_f32 %0, %1, %2" : "=v"(r) : "v"(lo), "v"(hi)); return r; }
template <class Epi, class Sched, bool ALIGN_EPI = false, bool SP2 = false>
__device__ __forceinline__ void gemm_phase(PG8_LAS unsigned char* lds, const Gemm g, const Sched& S, const Epi& E) {
    const int tid = threadIdx.x, wid = __builtin_amdgcn_readfirstlane(tid >> 6), lane = tid & 63, wr = wid >> 2, wc = wid & 3, fr = lane & 15, fq = lane >> 4;
    const int K = g.K, nt = K / BK;
    unsigned voffA[2], voffB[2];
#pragma unroll
    for (int i = 0; i < 2; ++i) { int R, C; stage_rc(tid * 16 + i * 8192, R, C); const int Rb = Epi::PERM ? ((R & ~31) + perm32(R & 31)) : R;
        voffA[i] = (unsigned)(R * K + C) * 2u; voffB[i] = (unsigned)(Rb * K + C) * 2u; }
    const size_t kstep = (size_t)(BK * 2);
    const size_t hstep = (size_t)HALF * K * 2;
    const size_t tstep = 2 * hstep;
    const unsigned ldsw = (unsigned)wid * 1024u;
    const int aoff = lds_byte(wr * 64 + fr, fq * 8), boff = lds_byte(wc * 32 + fr, fq * 8);
#define PG8_SA(b, h) (((b) * 2 + (h)) * HTB)
#define PG8_SB(b, h) ((4 + (b) * 2 + (h)) * HTB)
#define PG8_STAGE(bufoff, gbase, voff) do { _Pragma("unroll") for (int _i = 0; _i < 2; ++_i) \
        __builtin_amdgcn_global_load_lds((const unsigned*)((const char*)(gbase) + (voff)[_i]), (PG8_LAS unsigned*)(lds + (bufoff) + ldsw + _i * 8192), 16, 0, 0); } while (0)
#define PG8_LDA(dst, b, h) do { _Pragma("unroll") for (int m = 0; m < 4; ++m) _Pragma("unroll") for (int k = 0; k < 2; ++k) dst[m][k] = *(const PG8_LAS bf16x8*)(lds + PG8_SA(b, h) + aoff + m * 2048 + k * 1024); } while (0)
#define PG8_LDB(dst, b, h) do { _Pragma("unroll") for (int n = 0; n < 2; ++n) _Pragma("unroll") for (int k = 0; k < 2; ++k) dst[n][k] = *(const PG8_LAS bf16x8*)(lds + PG8_SB(b, h) + boff + n * 2048 + k * 1024); } while (0)
#define PG8_MMA(ai, bj, At, Bt) do { __builtin_amdgcn_s_setprio(1); _Pragma("unroll") for (int m = 0; m < 4; ++m) _Pragma("unroll") for (int n = 0; n < 2; ++n) _Pragma("unroll") for (int k = 0; k < 2; ++k) \
        acc[ai][bj][m][n] = __builtin_amdgcn_mfma_f32_16x16x32_bf16(Bt[n][k], At[m][k], acc[ai][bj][m][n], 0, 0, 0); __builtin_amdgcn_s_setprio(0); } while (0)
#define PG8_WAIT_V(n) asm volatile("s_waitcnt vmcnt(" #n ")" ::: "memory")
#define PG8_WAIT_L(n) asm volatile("s_waitcnt lgkmcnt(" #n ")" ::: "memory")
#define PG8_BAR __builtin_amdgcn_s_barrier()
#define PG8_SCHED __builtin_amdgcn_sched_barrier(0)
    Unit cur, nxt; int ui = 0;
    if (!S.next(0, cur)) return;
    f32x4 acc[2][2][4][2];
#pragma unroll
    for (int a = 0; a < 2; ++a)
#pragma unroll
        for (int b = 0; b < 2; ++b)
#pragma unroll
            for (int m = 0; m < 4; ++m)
#pragma unroll
                for (int n = 0; n < 2; ++n) acc[a][b][m][n] = (f32x4){0.f, 0.f, 0.f, 0.f};
    bf16x8 At[4][2], B0[2][2], B1[2][2];
    const char* cA = (const char*)g.A + (size_t)cur.pm * tstep; const char* cB = (const char*)g.Bt + (size_t)cur.pn * tstep;
    S.a_ready(cur);
    if constexpr (SP2) {
        PG8_STAGE(PG8_SB(0, 0), cB, voffB); PG8_STAGE(PG8_SB(0, 1), cB + hstep, voffB); PG8_STAGE(PG8_SA(0, 0), cA, voffA); PG8_STAGE(PG8_SA(0, 1), cA + hstep, voffA);
        if (wr == 1) PG8_BAR;
        PG8_WAIT_V(2); PG8_BAR;
        PG8_STAGE(PG8_SB(1, 0), cB + kstep, voffB); PG8_STAGE(PG8_SA(1, 0), cA + kstep, voffA); PG8_STAGE(PG8_SB(1, 1), cB + hstep + kstep, voffB);
        PG8_WAIT_V(6); PG8_BAR;
    } else {
        PG8_STAGE(PG8_SB(0, 0), cB, voffB); PG8_STAGE(PG8_SA(0, 0), cA, voffA); PG8_STAGE(PG8_SB(0, 1), cB + hstep, voffB); PG8_STAGE(PG8_SA(0, 1), cA + hstep, voffA);
        if (wr == 1) PG8_BAR;
        PG8_WAIT_V(4); PG8_BAR;
        PG8_STAGE(PG8_SB(1, 0), cB + kstep, voffB); PG8_STAGE(PG8_SA(1, 0), cA + kstep, voffA); PG8_STAGE(PG8_SB(1, 1), cB + hstep + kstep, voffB);
        PG8_WAIT_V(6); PG8_BAR;
    }
    for (;;) {
        const bool has_next = S.next(ui + 1, nxt);
        const char* nA = has_next ? (const char*)g.A + (size_t)nxt.pm * tstep : cA; const char* nB = has_next ? (const char*)g.Bt + (size_t)nxt.pn * tstep : cB;
        for (int t = 0; t < nt; t += 2) {
            const bool last = (t == nt - 2);
            const char* a1 = cA + (size_t)(t + 1) * kstep;
            const char* a2 = last ? nA : cA + (size_t)(t + 2) * kstep; const char* b2 = last ? nB : cB + (size_t)(t + 2) * kstep;
            const char* a3 = a2 + kstep; const char* b3 = b2 + kstep;
            if (last && has_next) S.a_ready(nxt);
            if constexpr (SP2) {
            PG8_LDB(B0, 0, 0); PG8_LDB(B1, 0, 1); PG8_SCHED; PG8_LDA(At, 0, 0); PG8_STAGE(PG8_SA(1, 1), a1 + hstep, voffA);
            PG8_WAIT_V(8); PG8_WAIT_L(0); PG8_BAR; PG8_MMA(0, 0, At, B0); PG8_MMA(0, 1, At, B1); PG8_BAR; PG8_SCHED;
            PG8_LDA(At, 0, 1); PG8_STAGE(PG8_SB(0, 0), b2, voffB); PG8_STAGE(PG8_SB(0, 1), b2 + hstep, voffB); PG8_STAGE(PG8_SA(0, 0), a2, voffA);
            PG8_WAIT_V(8); PG8_WAIT_L(0); PG8_BAR; PG8_MMA(1, 0, At, B0); PG8_MMA(1, 1, At, B1); PG8_BAR; PG8_SCHED;
            PG8_LDB(B0, 1, 0); PG8_LDB(B1, 1, 1); PG8_SCHED; PG8_LDA(At, 1, 0); PG8_STAGE(PG8_SA(0, 1), a2 + hstep, voffA);
            PG8_WAIT_V(8); PG8_WAIT_L(0); PG8_BAR; PG8_MMA(0, 0, At, B0); PG8_MMA(0, 1, At, B1); PG8_BAR; PG8_SCHED;
            PG8_LDA(At, 1, 1); PG8_STAGE(PG8_SB(1, 0), b3, voffB); PG8_STAGE(PG8_SB(1, 1), b3 + hstep, voffB); PG8_STAGE(PG8_SA(1, 0), a3, voffA);
            PG8_WAIT_V(8); PG8_WAIT_L(0); PG8_BAR; PG8_MMA(1, 0, At, B0); PG8_MMA(1, 1, At, B1); PG8_BAR; PG8_SCHED;
            } else {
            PG8_LDB(B0, 0, 0); PG8_SCHED; PG8_LDA(At, 0, 0); PG8_STAGE(PG8_SA(1, 1), a1 + hstep, voffA);
            PG8_WAIT_L(8); PG8_BAR; PG8_WAIT_L(0); PG8_MMA(0, 0, At, B0); PG8_BAR; PG8_SCHED;
            PG8_LDB(B1, 0, 1); PG8_STAGE(PG8_SB(0, 0), b2, voffB);
            PG8_BAR; PG8_WAIT_L(0); PG8_MMA(0, 1, At, B1); PG8_BAR;
            PG8_LDA(At, 0, 1); PG8_STAGE(PG8_SA(0, 0), a2, voffA);
            PG8_BAR; PG8_WAIT_L(0); PG8_MMA(1, 0, At, B0); PG8_BAR; PG8_SCHED;
            PG8_STAGE(PG8_SB(0, 1), b2 + hstep, voffB);
            PG8_WAIT_V(6); PG8_BAR; PG8_MMA(1, 1, At, B1); PG8_BAR;
            PG8_LDB(B0, 1, 0); PG8_SCHED; PG8_LDA(At, 1, 0); PG8_STAGE(PG8_SA(0, 1), a2 + hstep, voffA);
            PG8_WAIT_L(8); PG8_BAR; PG8_WAIT_L(0); PG8_MMA(0, 0, At, B0); PG8_BAR; PG8_SCHED;
            PG8_LDB(B1, 1, 1); PG8_STAGE(PG8_SB(1, 0), b3, voffB);
            PG8_BAR; PG8_WAIT_L(0); PG8_MMA(0, 1, At, B1); PG8_BAR;
            PG8_LDA(At, 1, 1); PG8_STAGE(PG8_SA(1, 0), a3, voffA);
            PG8_BAR; PG8_WAIT_L(0); PG8_MMA(1, 0, At, B0); PG8_BAR; PG8_SCHED;
            PG8_STAGE(PG8_SB(1, 1), b3 + hstep, voffB);
            PG8_WAIT_V(6); PG8_BAR; PG8_MMA(1, 1, At, B1); PG8_BAR;
            }
        }
        if constexpr (ALIGN_EPI) { if (wr == 0) PG8_BAR; }
        if constexpr (!Epi::AFTER_DRAIN) { E(acc, cur, wr, wc, fr, fq); S.done(cur); }
        if (!has_next) break;
#pragma unroll
        for (int a = 0; a < 2; ++a)
#pragma unroll
            for (int b = 0; b < 2; ++b)
#pragma unroll
                for (int m = 0; m < 4; ++m)
#pragma unroll
                    for (int n = 0; n < 2; ++n) acc[a][b][m][n] = (f32x4){0.f, 0.f, 0.f, 0.f};
        cur = nxt; cA = nA; cB = nB; ++ui;
        if constexpr (ALIGN_EPI) { if (wr == 1) PG8_BAR; }
    }
    PG8_WAIT_V(0);
    if constexpr (!ALIGN_EPI) { if (wr == 0) PG8_BAR; }
    PG8_BAR;
    if constexpr (Epi::AFTER_DRAIN) { E.fused(acc, cur, wr, wc, fr, fq, lds, wid, lane); S.done(cur); }
#undef PG8_SA
#undef PG8_SB
#undef PG8_STAGE
#undef PG8_LDA
#undef PG8_LDB
#undef PG8_MMA
#undef PG8_WAIT_V
#undef PG8_WAIT_L
#undef PG8_BAR
#undef PG8_SCHED
}
}
namespace pg8 {
struct EpiProj {
    static constexpr bool PERM = true, AFTER_DRAIN = false;
    bf16_t* P;
    __device__ __forceinline__ void operator()(const f32x4 (&acc)[2][2][4][2], const Unit& u, int wr, int wc, int fr, int fq) const {
        const int row0 = u.pm * BM + wr * 64 + fr, col0 = wc * 32 + 8 * fq, pl = u.pn;
        bf16_t* base = P + (size_t)pl * ((size_t)MT * 256);
        const int mode = (pl < 2 || pl == 8 || pl == 9) ? 1 : ((pl == 6 || pl == 7 || pl == 14 || pl == 15) ? 2 : 0);
#pragma unroll
        for (int ai = 0; ai < 2; ++ai)
#pragma unroll
            for (int m = 0; m < 4; ++m) { bf16_t* rowp = base + (size_t)(row0 + ai * HALF + m * 16) * 256 + col0;
#pragma unroll
                for (int bj = 0; bj < 2; ++bj) { f32x4 v0 = acc[ai][bj][m][0], v1 = acc[ai][bj][m][1];
                    if (mode == 1) { v0 = v0 * C2; v1 = v1 * C2; }
                    if (mode == 2) {
#pragma unroll
                        for (int j = 0; j < 4; ++j) { v0[j] = silu_f(v0[j]); v1[j] = silu_f(v1[j]); } }
                    u32x4 w; w.x = cvt_pk_bf16(v0[0], v0[1]); w.y = cvt_pk_bf16(v0[2], v0[3]); w.z = cvt_pk_bf16(v1[0], v1[1]); w.w = cvt_pk_bf16(v1[2], v1[3]);
                    *(u32x4*)(rowp + bj * HALF) = w; } }
    }
};
struct EpiOut {
    static constexpr bool PERM = true, AFTER_DRAIN = false;
    const float* X; bf16_t* Z;
    __device__ __forceinline__ void operator()(const f32x4 (&acc)[2][2][4][2], const Unit& u, int wr, int wc, int fr, int fq) const {
        const int row0 = u.pm * BM + wr * 64 + fr, col0 = u.pn * BM + wc * 32 + 8 * fq;
#pragma unroll
        for (int ai = 0; ai < 2; ++ai)
#pragma unroll
            for (int m = 0; m < 4; ++m) { const size_t off = (size_t)(row0 + ai * HALF + m * 16) * DM + col0;
#pragma unroll
                for (int bj = 0; bj < 2; ++bj) { const f32x4 x0 = *(const f32x4*)(X + off + bj * HALF), x1 = *(const f32x4*)(X + off + bj * HALF + 4);
                    const f32x4 v0 = x0 + acc[ai][bj][m][0], v1 = x1 + acc[ai][bj][m][1];
                    u32x4 w; w.x = cvt_pk_bf16(v0[0], v0[1]); w.y = cvt_pk_bf16(v0[2], v0[3]); w.z = cvt_pk_bf16(v1[0], v1[1]); w.w = cvt_pk_bf16(v1[2], v1[3]);
                    *(u32x4*)(Z + off + bj * HALF) = w; } }
    }
};
}
#include <cstdlib>
#include <vector>

#define XB_TMO      128
#define XB_XCNT(j)  (256  + 64 * (j))
#define XB_XSUB(j)  (1280 + 64 * (j))
#define XB_XGEN(j)  (2304 + 64 * (j))
#define XB_TOP      3328
#define XB_TOPGEN   3392
#define XCD_BAR_WORDS 3456
#define XB_SPIN_CAP (1u << 18)
#define LAS __attribute__((address_space(3)))

__device__ __forceinline__ unsigned xb_ld(unsigned* p)              { return __hip_atomic_load(p, __ATOMIC_RELAXED, __HIP_MEMORY_SCOPE_AGENT); }
__device__ __forceinline__ unsigned xb_add(unsigned* p, unsigned v) { return __hip_atomic_fetch_add(p, v, __ATOMIC_RELAXED, __HIP_MEMORY_SCOPE_AGENT); }
__device__ __forceinline__ unsigned xb_xcc_id() { return (unsigned)__builtin_amdgcn_s_getreg((3 << 11) | 20) & 0xFu; }
#define XB_SPIN(cond, bar) do { unsigned _sp = 0; while (cond) { __builtin_amdgcn_s_sleep(1); \
    if ((++_sp & 255u) == 0u) { if (xb_ld(&(bar)[XB_TMO])) break; if (_sp > XB_SPIN_CAP) { atomicAdd(&(bar)[XB_TMO], 1u); break; } } } } while (0)

struct XcdBarrier {
    unsigned* bar; unsigned x;
    volatile LAS unsigned* st;
};

__device__ __forceinline__ XcdBarrier xcd_barrier_post(unsigned* bar, volatile LAS unsigned* st) {
    XcdBarrier b; b.bar = bar; b.x = xb_xcc_id(); b.st = st;
    if (threadIdx.x == 0) (void)xb_add(&bar[XB_XCNT(b.x)], 1u);
    return b;
}
__device__ __forceinline__ void xcd_barrier_complete(unsigned* bar, unsigned x, unsigned& nloc, unsigned& nx) {
    const unsigned G = gridDim.x * gridDim.y * gridDim.z;
    unsigned sum, cnt, mine, sp = 0u;
    for (;;) {
        sum = 0u; cnt = 0u; mine = 0u;
#pragma unroll
        for (unsigned j = 0; j < 16; ++j) { const unsigned c = xb_ld(&bar[XB_XCNT(j)]); sum += c; cnt += (c > 0u) ? 1u : 0u; mine = (j == x) ? c : mine; }
        if (sum == G) break;
        __builtin_amdgcn_s_sleep(1);
        if ((++sp & 255u) == 0u) { if (xb_ld(&bar[XB_TMO])) break; if (sp > XB_SPIN_CAP) { atomicAdd(&bar[XB_TMO], 1u); break; } }
    }
    nloc = mine > 0u ? mine : 1u; nx = cnt > 0u ? cnt : 1u;
}

__device__ __forceinline__ void xcd_barrier(const XcdBarrier& b) {
    asm volatile("s_waitcnt vmcnt(0)" ::: "memory");
    __syncthreads();
    if (threadIdx.x == 0) {
        unsigned* bar = b.bar;
        __builtin_amdgcn_s_waitcnt(0);
        unsigned nloc = b.st[0], nx = b.st[1];
        if (nloc == 0u) { xcd_barrier_complete(bar, b.x, nloc, nx); b.st[0] = nloc; b.st[1] = nx; }
        const unsigned old = xb_add(&bar[XB_XSUB(b.x)], 1u);
        const unsigned gen = old / nloc;
        if (old + 1u == (gen + 1u) * nloc) {
            __builtin_amdgcn_fence(__ATOMIC_RELEASE, "agent");
            asm volatile("s_waitcnt vmcnt(0)" ::: "memory");
            const unsigned og = xb_add(&bar[XB_TOP], 1u);
            const unsigned tg = og / nx;
            if (og + 1u == (tg + 1u) * nx) xb_add(&bar[XB_TOPGEN], 1u);
            else XB_SPIN(xb_ld(&bar[XB_TOPGEN]) == tg, bar);
            __builtin_amdgcn_fence(__ATOMIC_ACQUIRE, "agent");
            xb_add(&bar[XB_XGEN(b.x)], 1u);
            asm volatile("s_waitcnt vmcnt(0)" ::: "memory");
        } else {
            XB_SPIN(xb_ld(&bar[XB_XGEN(b.x)]) == gen, bar);
            __builtin_amdgcn_fence(__ATOMIC_ACQUIRE, "agent");
            asm volatile("s_waitcnt vmcnt(0)" ::: "memory");
        }
    }
    __syncthreads();
}
__device__ __forceinline__ void prologue_body(int gw, int ngw, int lane, const float* __restrict__ x, const float* __restrict__ norm_w, const float* __restrict__ w_in,
                                              const float* __restrict__ w_out, bf16_t* H, float* IW, bf16_t* WinT, bf16_t* WoutT) {
    for (int m = gw; m < MT; m += ngw) {
        const f32x4_t* xr = (const f32x4_t*)(x + (size_t)m * DM) + lane;
        f32x4_t v[4]; float s = 0.f;
#pragma unroll
        for (int j = 0; j < 4; ++j) { v[j] = xr[64 * j]; s += (v[j].x * v[j].x + v[j].y * v[j].y) + (v[j].z * v[j].z + v[j].w * v[j].w); }
        const float rstd = 1.0f / sqrtf(wave_sum(s) * (1.0f / DM) + EPS);
        float a0 = 0.f, a1 = 0.f, a2 = 0.f, a3 = 0.f;
        u32x2_t* o8 = (u32x2_t*)(H + (size_t)m * DM) + lane;
#pragma unroll
        for (int j = 0; j < 4; ++j) {
            const f32x4_t w = ((const f32x4_t*)norm_w)[64 * j + lane];
            f32x4_t hv; hv.x = v[j].x * rstd * w.x; hv.y = v[j].y * rstd * w.y; hv.z = v[j].z * rstd * w.z; hv.w = v[j].w * rstd * w.w;
            const int d = 256 * j + 4 * lane;
            const f32x4_t w0 = *(const f32x4_t*)(w_in + (size_t)(d + 0) * D_IN + 4416), w1 = *(const f32x4_t*)(w_in + (size_t)(d + 1) * D_IN + 4416);
            const f32x4_t w2 = *(const f32x4_t*)(w_in + (size_t)(d + 2) * D_IN + 4416), w3 = *(const f32x4_t*)(w_in + (size_t)(d + 3) * D_IN + 4416);
            a0 += hv.x * w0.x + hv.y * w1.x + hv.z * w2.x + hv.w * w3.x;
            a1 += hv.x * w0.y + hv.y * w1.y + hv.z * w2.y + hv.w * w3.y;
            a2 += hv.x * w0.z + hv.y * w1.z + hv.z * w2.z + hv.w * w3.z;
            a3 += hv.x * w0.w + hv.y * w1.w + hv.z * w2.w + hv.w * w3.w;
            u32x2_t o; o.x = pk2(hv.x, hv.y); o.y = pk2(hv.z, hv.w); o8[64 * j] = o;
        }
        a0 = wave_sum(a0); a1 = wave_sum(a1); a2 = wave_sum(a2); a3 = wave_sum(a3);
        if (lane == 0) { f32x4_t o = {a0, a1, a2, a3}; *(f32x4_t*)(IW + (size_t)m * 4) = o; }
    }
    const long tid = (long)gw * 64 + lane, nth = (long)ngw * 64;
    for (long i = tid; i < (long)NPAD * (DM / 8); i += nth) {
        const int n = (int)(i % NPAD), k8 = (int)(i / NPAD);
        float e[8];
#pragma unroll
        for (int q = 0; q < 8; ++q) e[q] = (n < D_IN) ? w_in[(size_t)(k8 * 8 + q) * D_IN + n] : 0.f;
        u32x4_t o; o.x = pk2(e[0], e[1]); o.y = pk2(e[2], e[3]); o.z = pk2(e[4], e[5]); o.w = pk2(e[6], e[7]);
        *(u32x4_t*)(WinT + (size_t)n * DM + k8 * 8) = o;
    }
    for (long i = tid; i < (long)DM * (DM / 8); i += nth) {
        const int n = (int)(i % DM), k8 = (int)(i / DM);
        float e[8];
#pragma unroll
        for (int q = 0; q < 8; ++q) e[q] = w_out[(size_t)(k8 * 8 + q) * DM + n];
        u32x4_t o; o.x = pk2(e[0], e[1]); o.y = pk2(e[2], e[3]); o.z = pk2(e[4], e[5]); o.w = pk2(e[6], e[7]);
        *(u32x4_t*)(WoutT + (size_t)n * DM + k8 * 8) = o;
    }
}
__device__ __forceinline__ void final_norm_body(int gw, int ngw, int lane, const bf16_t* Z, float* out, const float* __restrict__ fw) {
    for (int m = gw; m < MT; m += ngw) {
        const u32x2_t* zr = (const u32x2_t*)(Z + (size_t)m * DM) + lane;
        f32x4_t v[4]; float s = 0.f;
#pragma unroll
        for (int j = 0; j < 4; ++j) { const u32x2_t z = zr[64 * j]; v[j].x = bflo(z.x); v[j].y = bfhi(z.x); v[j].z = bflo(z.y); v[j].w = bfhi(z.y);
            s += (v[j].x * v[j].x + v[j].y * v[j].y) + (v[j].z * v[j].z + v[j].w * v[j].w); }
        const float rstd = 1.0f / sqrtf(wave_sum(s) * (1.0f / DM) + EPS);
        f32x4_t* xr = (f32x4_t*)(out + (size_t)m * DM) + lane;
#pragma unroll
        for (int j = 0; j < 4; ++j) { const f32x4_t w = ((const f32x4_t*)fw)[64 * j + lane]; f32x4_t o;
            o.x = v[j].x * rstd * w.x; o.y = v[j].y * rstd * w.y; o.z = v[j].z * rstd * w.z; o.w = v[j].w * rstd * w.w; xr[64 * j] = o; }
    }
}
#define WAVE_SYNC() asm volatile("s_waitcnt vmcnt(0) lgkmcnt(0)" ::: "memory")
__device__ __forceinline__ void sel_naive_one(int m, int lane, unsigned* skey, float* sq, unsigned char* ws) {
    const bf16_t* P = (const bf16_t*)(ws + WS_P); const float* IW = (const float*)(ws + WS_IW);
    float* THR = (float*)(ws + WS_THR); int* KCUT = (int*)(ws + WS_KCUT); int* SELCNT = (int*)(ws + WS_SELCNT); int* SEL = (int*)(ws + WS_SEL);
    const int b = m / SEQ, tpos = m % SEQ, N = ((tpos >> 6) + 1) << 6;
    int* sel = SEL + (size_t)m * 256;
    unsigned* MASKW = (unsigned*)(ws + WS_MASK) + ((size_t)(b * 64 + (tpos >> 6)) * 32 * 64 + (tpos & 63)) * 4;
    if (N <= 256) {
        for (int j = lane; j < N; j += 64) sel[j] = j;
        if (lane < N / 64) { u32x2_t o = {0xffffffffu, 0xffffffffu}; *(u32x2_t*)(MASKW + (size_t)(lane >> 1) * 256 + (lane & 1) * 2) = o; }
        if (lane == 0) { THR[m] = -INFINITY; KCUT[m] = 0x7fffffff; SELCNT[m] = N; }
        return;
    }
    { const u32x2_t q = *(const u32x2_t*)(P + PL_IQ * PLANE + (size_t)m * 256 + lane * 4);
      sq[lane * 4 + 0] = bflo(q.x); sq[lane * 4 + 1] = bfhi(q.x); sq[lane * 4 + 2] = bflo(q.y); sq[lane * 4 + 3] = bfhi(q.y); }
    const f32x4_t iw = *(const f32x4_t*)(IW + (size_t)m * 4);
    const float wg0 = iw.x * IDX_SCALE, wg1 = iw.y * IDX_SCALE, wg2 = iw.z * IDX_SCALE, wg3 = iw.w * IDX_SCALE;
    WAVE_SYNC();
    for (int i = 0; i < N / 64; ++i) {
        asm volatile("" ::: "memory");
        const int s = i * 64 + lane; const bf16_t* kr = P + PL_IK * PLANE + (size_t)(b * SEQ + s) * 256;
        float l0 = 0.f, l1 = 0.f, l2 = 0.f, l3 = 0.f;
#pragma unroll
        for (int c = 0; c < 8; ++c) { const u32x4_t kv = *(const u32x4_t*)(kr + c * 8);
            const float k[8] = {bflo(kv.x), bfhi(kv.x), bflo(kv.y), bfhi(kv.y), bflo(kv.z), bfhi(kv.z), bflo(kv.w), bfhi(kv.w)};
#pragma unroll
            for (int e = 0; e < 8; ++e) { const int d = c * 8 + e; l0 += sq[d] * k[e]; l1 += sq[64 + d] * k[e]; l2 += sq[128 + d] * k[e]; l3 += sq[192 + d] * k[e]; } }
        float sc = wg0 * fmaxf(l0, 0.f) + wg1 * fmaxf(l1, 0.f) + wg2 * fmaxf(l2, 0.f) + wg3 * fmaxf(l3, 0.f);
        sc += 0.0f;
        skey[s] = f2key(sc);
    }
    WAVE_SYNC();
    unsigned prefix = 0u;
    for (int bit = 31; bit >= 0; --bit) { const unsigned cand = prefix | (1u << bit); int c = 0;
        for (int i = 0; i < N / 64; ++i) c += (skey[i * 64 + lane] >= cand) ? 1 : 0;
        c = wave_sum_i(c); if (c >= 256) prefix = cand; }
    int cgt = 0; for (int i = 0; i < N / 64; ++i) cgt += (skey[i * 64 + lane] > prefix) ? 1 : 0;
    cgt = wave_sum_i(cgt);
    const int r = 256 - cgt;
    int run = 0, kcut = 0x7fffffff;
    for (int i = 0; i < N / 64; ++i) { const unsigned long long bm = __ballot(skey[i * 64 + lane] == prefix); const int c = __popcll(bm);
        if (run + c >= r) { unsigned long long t = bm; for (int q = 0; q < r - run - 1; ++q) t &= t - 1; kcut = i * 64 + (int)__builtin_ctzll(t); break; }
        run += c; }
    int base = 0;
    for (int i = 0; i < N / 64; ++i) { const unsigned k = skey[i * 64 + lane]; const int idx = i * 64 + lane; const bool f = (k > prefix) || (k == prefix && idx <= kcut);
        const unsigned long long bm = __ballot(f); const int pos = base + __popcll(bm & ((1ull << lane) - 1ull)); if (f && pos < 256) sel[pos] = idx; base += __popcll(bm);
        if (lane == 0) { u32x2_t o = {(unsigned)bm, (unsigned)(bm >> 32)}; *(u32x2_t*)(MASKW + (size_t)(i >> 1) * 256 + (i & 1) * 2) = o; } }
    if (lane == 0) { THR[m] = key2f(prefix); KCUT[m] = kcut; SELCNT[m] = 256; }
    WAVE_SYNC();
}
__device__ __forceinline__ void dsa_naive_one(int m, int lane, float* sq, float* sc, int* ssel, unsigned char* ws, const float* __restrict__ rel_bias) {
    const bf16_t* P = (const bf16_t*)(ws + WS_P); const int* SELCNT = (const int*)(ws + WS_SELCNT); const int* SEL = (const int*)(ws + WS_SEL);
    bf16_t* AOBO = (bf16_t*)(ws + WS_AOBO);
    const int b = m / SEQ, tpos = m % SEQ; const int cnt = SELCNT[m];
    { const int hc = lane * 8; const u32x4_t q = *(const u32x4_t*)(P + (PL_BQ + (hc >> 8)) * PLANE + (size_t)m * 256 + (hc & 255));
      sq[hc + 0] = bflo(q.x); sq[hc + 1] = bfhi(q.x); sq[hc + 2] = bflo(q.y); sq[hc + 3] = bfhi(q.y); sq[hc + 4] = bflo(q.z); sq[hc + 5] = bfhi(q.z); sq[hc + 6] = bflo(q.w); sq[hc + 7] = bfhi(q.w); }
    for (int j = lane; j < 256; j += 64) ssel[j] = (j < cnt) ? SEL[(size_t)m * 256 + j] : 0;
    WAVE_SYNC();
    for (int jj = 0; jj < 4; ++jj) { const int j = jj * 64 + lane;
        if (j < cnt) { const int s = ssel[j]; const size_t ms = (size_t)(b * SEQ + s); const int bk = t5_bucket(s - tpos);
            for (int h = 0; h < 8; ++h) { const bf16_t* kr = P + (PL_BK + (h >> 2)) * PLANE + ms * 256 + (h & 3) * 64; float a = 0.f;
#pragma unroll
                for (int c = 0; c < 8; ++c) { const u32x4_t kv = *(const u32x4_t*)(kr + c * 8); const float* q = &sq[h * 64 + c * 8];
                    a += q[0] * bflo(kv.x) + q[1] * bfhi(kv.x) + q[2] * bflo(kv.y) + q[3] * bfhi(kv.y) + q[4] * bflo(kv.z) + q[5] * bfhi(kv.z) + q[6] * bflo(kv.w) + q[7] * bfhi(kv.w); }
                sc[h * 256 + j] = a + rel_bias[bk * 12 + 4 + h] * LOG2E; }
        } else { for (int h = 0; h < 8; ++h) sc[h * 256 + j] = -INFINITY; }
    }
    WAVE_SYNC();
    for (int h = 0; h < 8; ++h) { float v0 = sc[h * 256 + lane], v1 = sc[h * 256 + 64 + lane], v2 = sc[h * 256 + 128 + lane], v3 = sc[h * 256 + 192 + lane];
        const float mx = wave_max(fmaxf(fmaxf(v0, v1), fmaxf(v2, v3)));
        v0 = __builtin_amdgcn_exp2f(v0 - mx); v1 = __builtin_amdgcn_exp2f(v1 - mx); v2 = __builtin_amdgcn_exp2f(v2 - mx); v3 = __builtin_amdgcn_exp2f(v3 - mx);
        const float inv = 1.0f / wave_sum((v0 + v1) + (v2 + v3));
        sc[h * 256 + lane] = v0 * inv; sc[h * 256 + 64 + lane] = v1 * inv; sc[h * 256 + 128 + lane] = v2 * inv; sc[h * 256 + 192 + lane] = v3 * inv; }
    WAVE_SYNC();
    { const int hc = lane * 8, h = lane >> 3; float acc[8];
#pragma unroll
      for (int e = 0; e < 8; ++e) acc[e] = 0.f;
      for (int j = 0; j < cnt; ++j) { const float p = sc[h * 256 + j]; const int s = ssel[j];
          const u32x4_t vv = *(const u32x4_t*)(P + (PL_BV + (hc >> 8)) * PLANE + (size_t)(b * SEQ + s) * 256 + (hc & 255));
          acc[0] += p * bflo(vv.x); acc[1] += p * bfhi(vv.x); acc[2] += p * bflo(vv.y); acc[3] += p * bfhi(vv.y); acc[4] += p * bflo(vv.z); acc[5] += p * bfhi(vv.z); acc[6] += p * bflo(vv.w); acc[7] += p * bfhi(vv.w); }
      const u32x4_t g = *(const u32x4_t*)(P + (PL_BG + (hc >> 8)) * PLANE + (size_t)m * 256 + (hc & 255));
      u32x4_t o; o.x = pk2(acc[0] * bflo(g.x), acc[1] * bfhi(g.x)); o.y = pk2(acc[2] * bflo(g.y), acc[3] * bfhi(g.y)); o.z = pk2(acc[4] * bflo(g.z), acc[5] * bfhi(g.z)); o.w = pk2(acc[6] * bflo(g.w), acc[7] * bfhi(g.w));
      *(u32x4_t*)(AOBO + (size_t)m * DM + 512 + hc) = o; }
    WAVE_SYNC();
}
__device__ __forceinline__ float diff_lambda(int lane, const float* lq1, const float* lk1, const float* lq2, const float* lk2) {
    return expf(wave_sum(lq1[lane] * lk1[lane])) - expf(wave_sum(lq2[lane] * lk2[lane])) + LAMBDA_INIT; }
__device__ __forceinline__ void diff_naive_one(int m, int h, int lane, float* s1, float* s2, float* sq, float lam, unsigned char* ws, const float* __restrict__ rel_bias, const float* __restrict__ subln_w) {
    const bf16_t* P = (const bf16_t*)(ws + WS_P); bf16_t* AOBO = (bf16_t*)(ws + WS_AOBO);
    const int b = m / SEQ, tpos = m % SEQ, N = ((tpos >> 6) + 1) << 6;
    const int pq = h >> 1, co = (h & 1) * 128;
    { const unsigned q = *(const unsigned*)(P + (PL_AQ + pq) * PLANE + (size_t)m * 256 + co + lane * 2); sq[lane * 2] = bflo(q); sq[lane * 2 + 1] = bfhi(q); }
    WAVE_SYNC();
    float mx1 = -INFINITY, mx2 = -INFINITY;
    for (int i = 0; i < N / 64; ++i) { asm volatile("" ::: "memory"); const int s = i * 64 + lane; const bf16_t* kr = P + (PL_AK + pq) * PLANE + (size_t)(b * SEQ + s) * 256 + co;
        float d1 = 0.f, d2 = 0.f;
#pragma unroll
        for (int c = 0; c < 8; ++c) { const u32x4_t kv = *(const u32x4_t*)(kr + c * 8); const float* q = &sq[c * 8];
            d1 += q[0] * bflo(kv.x) + q[1] * bfhi(kv.x) + q[2] * bflo(kv.y) + q[3] * bfhi(kv.y) + q[4] * bflo(kv.z) + q[5] * bfhi(kv.z) + q[6] * bflo(kv.w) + q[7] * bfhi(kv.w); }
#pragma unroll
        for (int c = 0; c < 8; ++c) { const u32x4_t kv = *(const u32x4_t*)(kr + 64 + c * 8); const float* q = &sq[64 + c * 8];
            d2 += q[0] * bflo(kv.x) + q[1] * bfhi(kv.x) + q[2] * bflo(kv.y) + q[3] * bfhi(kv.y) + q[4] * bflo(kv.z) + q[5] * bfhi(kv.z) + q[6] * bflo(kv.w) + q[7] * bfhi(kv.w); }
        const float bias = rel_bias[t5_bucket(s - tpos) * 12 + h] * LOG2E;
        d1 += bias; d2 += bias; s1[s] = d1; s2[s] = d2; mx1 = fmaxf(mx1, d1); mx2 = fmaxf(mx2, d2); }
    mx1 = wave_max(mx1); mx2 = wave_max(mx2);
    float l1 = 0.f, l2 = 0.f;
    for (int i = 0; i < N / 64; ++i) { const int s = i * 64 + lane; const float p1 = __builtin_amdgcn_exp2f(s1[s] - mx1), p2 = __builtin_amdgcn_exp2f(s2[s] - mx2); s1[s] = p1; s2[s] = p2; l1 += p1; l2 += p2; }
    l1 = wave_sum(l1); l2 = wave_sum(l2);
    const float i1 = 1.0f / l1, i2 = lam / l2;
    for (int i = 0; i < N / 64; ++i) { const int s = i * 64 + lane; s1[s] = s1[s] * i1 - s2[s] * i2; }
    WAVE_SYNC();
    float a0 = 0.f, a1 = 0.f;
    const bf16_t* vb = P + (PL_AV + pq) * PLANE + (size_t)(b * SEQ) * 256 + co + lane * 2;
    for (int s = 0; s < N; ++s) { const float wv = s1[s]; const unsigned vv = *(const unsigned*)(vb + (size_t)s * 256); a0 += wv * bflo(vv); a1 += wv * bfhi(vv); }
    const float rstd = 1.0f / sqrtf(wave_sum(a0 * a0 + a1 * a1) * (1.0f / 128.0f) + EPS);
    const unsigned g = *(const unsigned*)(P + (PL_AG + pq) * PLANE + (size_t)m * 256 + co + lane * 2);
    const float o0 = a0 * rstd * subln_w[lane * 2] * ONE_M_LAMBDA * bflo(g), o1 = a1 * rstd * subln_w[lane * 2 + 1] * ONE_M_LAMBDA * bfhi(g);
    *(unsigned*)(AOBO + (size_t)m * DM + h * 128 + lane * 2) = pk2(o0, o1);
    WAVE_SYNC();
}
namespace dfa {
typedef short bf16x8 __attribute__((ext_vector_type(8)));
typedef short s16x4 __attribute__((ext_vector_type(4)));
typedef float f32x16 __attribute__((ext_vector_type(16)));
typedef LAS const char* lds_cptr;
constexpr int KBUF = 16384, VBUF = 16384;
constexpr int OFF_K = 0, OFF_V = 3 * KBUF, OFF_LUT = OFF_V + 4 * VBUF, OFF_Q = OFF_LUT + 1024, OFF_X = 0, LDS_NEED = OFF_Q + 32768;
constexpr float THR = 8.0f;
__device__ __forceinline__ int crow(int r, int hi) { return (r & 3) + 8 * (r >> 2) + 4 * hi; }
__device__ __forceinline__ s16x4 vtr(lds_cptr p) { return __builtin_bit_cast(s16x4, __builtin_amdgcn_ds_read_tr16_b64_v4i16((LAS s16x4*)p)); }
__device__ __forceinline__ float swap_other_half(float v) { auto rr = __builtin_amdgcn_permlane32_swap(__float_as_uint(v), __float_as_uint(v), false, false); return __uint_as_float((threadIdx.x & 32) ? rr[0] : rr[1]); }

__device__ __forceinline__ float max3_asm(float a, float b, float c) { float r; asm("v_max3_f32 %0, %1, %2, %3" : "=v"(r) : "v"(a), "v"(b), "v"(c)); return r; }
__device__ __forceinline__ void unit(unsigned char* lds, int b, int h, int cc, const bf16_t* P, bf16_t* AOBO, const float* __restrict__ rel_bias, const float* __restrict__ subln_w, float lam) {
    const int tid = threadIdx.x, lane = tid & 63, r32 = lane & 31, hi = lane >> 5;
    const int w = __builtin_amdgcn_readfirstlane(tid >> 6), j = w & 1, qs = w >> 1;
    const int cw = 2 * cc + (qs >> 1);
    const int NT = 2 * cc + 2, NTw = cw + 1;
    const size_t rowb = (size_t)b * SEQ;
    const bf16_t* Kg = P + (size_t)(PL_AK + (h >> 1)) * PLANE + rowb * 256 + (h & 1) * 128;
    const bf16_t* Vg = P + (size_t)(PL_AV + (h >> 1)) * PLANE + rowb * 256 + (h & 1) * 128;
    const bf16_t* Qg = P + (size_t)(PL_AQ + (h >> 1)) * PLANE + rowb * 256 + (h & 1) * 128;
    const bf16_t* Gg = P + (size_t)(PL_AG + (h >> 1)) * PLANE + rowb * 256 + (h & 1) * 128;
    LAS unsigned char* L = (LAS unsigned char*)lds;
    LAS float* lut = (LAS float*)(L + OFF_LUT);
    if (tid < 256) { const int rel = tid - 192; const float far = rel_bias[15 * 12 + h]; lut[tid] = (rel_bias[t5_bucket(rel) * 12 + h] - far) * LOG2E; }
#define DFA_DMA_K(t, kbuf) do { \
        _Pragma("unroll") for (int i_ = 0; i_ < 2; ++i_) { const int p_ = 2 * w + i_, sub_ = p_ >> 3, row_ = 8 * (p_ & 7) + (lane >> 3); \
            __builtin_amdgcn_global_load_lds((const unsigned*)(Kg + (size_t)((t) * 64 + row_) * 256 + sub_ * 64 + (((lane & 7) ^ ((row_ >> 1) & 7)) * 8)), (LAS unsigned*)(L + OFF_K + (kbuf) * KBUF + p_ * 1024), 16, 0, 0); } \
    } while (0)
#define DFA_DMA_V(t, vbuf) do { \
        _Pragma("unroll") for (int i_ = 0; i_ < 2; ++i_) { const int ii_ = 2 * w + i_, dq_ = ii_ >> 2, g_ = ii_ & 3; \
            __builtin_amdgcn_global_load_lds((const unsigned*)(Vg + (size_t)((t) * 64 + 16 * g_ + (lane >> 2)) * 256 + dq_ * 32 + (lane & 3) * 8), (LAS unsigned*)(L + OFF_V + (vbuf) * VBUF + dq_ * 4096 + g_ * 1024), 16, 0, 0); } \
    } while (0)
    DFA_DMA_K(0, 0); DFA_DMA_V(0, 0); DFA_DMA_K(1, 1); DFA_DMA_V(1, 1);
    { const bf16_t* qp = Qg + (size_t)(128 * cc + 32 * qs + r32) * 256 + 64 * j + 8 * hi;
#pragma unroll
      for (int d0 = 0; d0 < 4; ++d0) *(LAS u32x4_t*)(L + OFF_Q + w * 4096 + d0 * 1024 + lane * 16) = *(const u32x4_t*)(qp + 16 * d0); }
    const lds_cptr qb = (lds_cptr)(L + OFF_Q + w * 4096 + lane * 16);
    f32x16 o[4];
#pragma unroll
    for (int dq = 0; dq < 4; ++dq)
#pragma unroll
        for (int r = 0; r < 16; ++r) o[dq][r] = 0.f;
    f32x16 negm;
#pragma unroll
    for (int r = 0; r < 16; ++r) negm[r] = 0.f;
    float mrun = 0.f, lsum = 0.f;
    bf16x8 pf[4];
#pragma unroll
    for (int ks = 0; ks < 4; ++ks) pf[ks] = (bf16x8){0, 0, 0, 0, 0, 0, 0, 0};
    f32x16 s0 = negm, s1 = negm;
    int koff[4];
#pragma unroll
    for (int d0 = 0; d0 < 4; ++d0) koff[d0] = j * 8192 + r32 * 128 + ((((hi << 4) ^ (((r32 >> 1) & 7) << 4))) ^ (d0 << 5));
    const int voff = ((lane >> 4) & 1) * 32 + (lane & 3) * 8 + (4 * hi + ((lane & 15) >> 2)) * 64;
#define DFA_QK(t, kbuf) do { \
        asm volatile("" ::: "memory"); \
        const lds_cptr kb = (lds_cptr)(L + OFF_K + (kbuf) * KBUF); \
        s0 = negm; s1 = negm; \
        _Pragma("unroll") for (int d0 = 0; d0 < 4; ++d0) { \
            const bf16x8 a0 = *(const LAS bf16x8*)(kb + koff[d0]), a1 = *(const LAS bf16x8*)(kb + koff[d0] + 4096), qfd = *(const LAS bf16x8*)(qb + d0 * 1024); \
            s0 = __builtin_amdgcn_mfma_f32_32x32x16_bf16(a0, qfd, s0, 0, 0, 0); \
            s1 = __builtin_amdgcn_mfma_f32_32x32x16_bf16(a1, qfd, s1, 0, 0, 0); } \
        if ((t) >= cw - 2) { \
            const int base = 192 + 64 * ((t) - cw) - 32 * (qs & 1) - r32 + 4 * hi; \
            _Pragma("unroll") for (int r = 0; r < 16; ++r) { const int kk = (r & 3) + 8 * (r >> 2); s0[r] += lut[base + kk]; s1[r] += lut[base + 32 + kk]; } } \
    } while (0)
#define DFA_SM(t) do { \
        asm volatile("s_nop 11" : "+v"(s0), "+v"(s1));        \
        float tm = max3_asm(s0[0], s1[0], s0[1]), tn = max3_asm(s1[1], s0[2], s1[2]); \
        _Pragma("unroll") for (int r = 3; r < 15; r += 3) { tm = max3_asm(tm, s0[r], s1[r]); tn = max3_asm(tn, s0[r + 1], s1[r + 1]); tm = max3_asm(tm, s0[r + 2], s1[r + 2]); } \
        tm = max3_asm(tm, tn, s0[15]); tm = max3_asm(tm, s1[15], swap_other_half(max3_asm(tm, s1[15], s1[15]))); \
        const bool first = ((t) == 0); \
        if (first || __any(tm > THR)) { \
            const float dl = first ? tm : fmaxf(tm, 0.f); \
            mrun += dl; \
            _Pragma("unroll") for (int r = 0; r < 16; ++r) { s0[r] -= dl; s1[r] -= dl; negm[r] = -mrun; } \
            const float al = __builtin_amdgcn_exp2f(-dl); \
            lsum *= al; \
            if (!first) { _Pragma("unroll") for (int dq = 0; dq < 4; ++dq) _Pragma("unroll") for (int r = 0; r < 16; ++r) o[dq][r] *= al; } } \
        float ps = 0.f; \
        _Pragma("unroll") for (int r = 0; r < 16; ++r) { s0[r] = __builtin_amdgcn_exp2f(s0[r]); s1[r] = __builtin_amdgcn_exp2f(s1[r]); ps += s0[r] + s1[r]; } \
        lsum += ps; \
        _Pragma("unroll") for (int ks = 0; ks < 2; ++ks) { u32x4_t a, c; \
            a.x = pk2(s0[8 * ks + 0], s0[8 * ks + 1]); a.y = pk2(s0[8 * ks + 2], s0[8 * ks + 3]); a.z = pk2(s0[8 * ks + 4], s0[8 * ks + 5]); a.w = pk2(s0[8 * ks + 6], s0[8 * ks + 7]); \
            c.x = pk2(s1[8 * ks + 0], s1[8 * ks + 1]); c.y = pk2(s1[8 * ks + 2], s1[8 * ks + 3]); c.z = pk2(s1[8 * ks + 4], s1[8 * ks + 5]); c.w = pk2(s1[8 * ks + 6], s1[8 * ks + 7]); \
            pf[ks] = __builtin_bit_cast(bf16x8, a); pf[2 + ks] = __builtin_bit_cast(bf16x8, c); } \
    } while (0)
#define DFA_PV(vbuf) do { \
        const lds_cptr vp = (lds_cptr)(L + OFF_V + (vbuf) * VBUF + voff); \
        _Pragma("unroll") for (int dq = 0; dq < 4; ++dq) _Pragma("unroll") for (int ks = 0; ks < 4; ++ks) { \
            const s16x4 lo = vtr(vp + dq * 4096 + ks * 1024), hh = vtr(vp + dq * 4096 + ks * 1024 + 512); \
            const bf16x8 vf = {lo[0], lo[1], lo[2], lo[3], hh[0], hh[1], hh[2], hh[3]}; \
            o[dq] = __builtin_amdgcn_mfma_f32_32x32x16_bf16(vf, pf[ks], o[dq], 0, 0, 0); } \
    } while (0)
    asm volatile("s_waitcnt vmcnt(0)" ::: "memory");
    __syncthreads();
#define DFA_STEP_END(t) do { if ((t) + 2 < NT) asm volatile("s_waitcnt vmcnt(2) lgkmcnt(0)" ::: "memory"); else asm volatile("s_waitcnt vmcnt(0) lgkmcnt(0)" ::: "memory"); \
        __builtin_amdgcn_s_barrier(); asm volatile("" ::: "memory"); } while (0)
    int k0 = 0, k1 = 1, k2 = 2;
    if (w < 4) {
        DFA_QK(0, 0);
        for (int t = 0; t < NT; ++t) {
            if (t + 2 < NT) { DFA_DMA_K(t + 2, k2); DFA_DMA_V(t + 2, (t + 2) & 3); }
            if (t < NTw) { DFA_SM(t); DFA_PV(t & 3); if (t + 1 < NTw) DFA_QK(t + 1, k1); }
            DFA_STEP_END(t);
            { const int kt_ = k0; k0 = k1; k1 = k2; k2 = kt_; }
        }
    } else {
        for (int t = 0; t < NT; ++t) {
            if (t + 2 < NT) { DFA_DMA_K(t + 2, k2); DFA_DMA_V(t + 2, (t + 2) & 3); }
            if (t >= 1 && t - 1 < NTw) DFA_PV((t - 1) & 3);
            if (t < NTw) { DFA_QK(t, k0); DFA_SM(t); }
            DFA_STEP_END(t);
            { const int kt_ = k0; k0 = k1; k1 = k2; k2 = kt_; }
        }
        if (NT - 1 < NTw) DFA_PV((NT - 1) & 3);
    }
#undef DFA_STEP_END
    __syncthreads();
#undef DFA_DMA_K
#undef DFA_DMA_V
#undef DFA_QK
#undef DFA_SM
#undef DFA_PV
    const float ltot = lsum + swap_other_half(lsum);
    LAS float* X = (LAS float*)(L + OFF_X) + qs * 4096;
    if (j == 1) {
        const float sc = lam / ltot;
#pragma unroll
        for (int dq = 0; dq < 4; ++dq)
#pragma unroll
            for (int r = 0; r < 16; ++r) X[(dq * 16 + r) * 64 + lane] = o[dq][r] * sc;
    }
    __syncthreads();
    if (j == 0) {
        const float inv = 1.0f / ltot; float ss = 0.f;
#pragma unroll
        for (int dq = 0; dq < 4; ++dq)
#pragma unroll
            for (int r = 0; r < 16; ++r) { const float v = o[dq][r] * inv - X[(dq * 16 + r) * 64 + lane]; o[dq][r] = v; ss += v * v; }
        ss += swap_other_half(ss);
        const float rstd = ONE_M_LAMBDA / sqrtf(ss * (1.0f / 128.0f) + EPS);
        const size_t m = rowb + (size_t)(128 * cc + 32 * qs + r32);
        const bf16_t* gp = Gg + (m - rowb) * 256;
        bf16_t* op = AOBO + m * DM + h * 128;
#pragma unroll
        for (int dq = 0; dq < 4; ++dq)
#pragma unroll
            for (int g = 0; g < 4; ++g) { const int dv = 32 * dq + 8 * g + 4 * hi;
                const u32x2_t gv = *(const u32x2_t*)(gp + dv); const f32x4_t sw = *(const f32x4_t*)(subln_w + dv);
                u32x2_t ov; ov.x = pk2(o[dq][4 * g + 0] * rstd * sw.x * bflo(gv.x), o[dq][4 * g + 1] * rstd * sw.y * bfhi(gv.x));
                ov.y = pk2(o[dq][4 * g + 2] * rstd * sw.z * bflo(gv.y), o[dq][4 * g + 3] * rstd * sw.w * bfhi(gv.y));
                *(u32x2_t*)(op + dv) = ov; }
    }
    __syncthreads();
}
__device__ __forceinline__ void phase(unsigned char* lds, int blk, int G, const bf16_t* P, bf16_t* AOBO, const float* rel_bias, const float* subln_w, float lam) {
    if (G == 256) {
        const int x = blk & 7, i = blk >> 3;
        for (int k = 0; k < 4; ++k) { const int id = 4 * x + k; unit(lds, id >> 2, id & 3, (k & 1) ? 31 - i : i, P, AOBO, rel_bias, subln_w, lam); }
    } else {
        for (int u = blk; u < 32 * 32; u += G) unit(lds, (u >> 5) >> 2, (u >> 5) & 3, u & 31, P, AOBO, rel_bias, subln_w, lam);
    }
}
}
namespace dsa {
typedef short bf16x8 __attribute__((ext_vector_type(8)));
typedef short s16x4 __attribute__((ext_vector_type(4)));
typedef float f32x16 __attribute__((ext_vector_type(16)));
typedef LAS const char* lds_cptr;
constexpr int KBUF = 16384, VBUF = 16384;
constexpr int OFF_K = 0, OFF_V = 2 * KBUF, OFF_LUT = OFF_V + 2 * VBUF, LDS_NEED = OFF_LUT + 2048;
constexpr float THR = 8.0f;
__device__ __forceinline__ s16x4 vtr(lds_cptr p) { return __builtin_bit_cast(s16x4, __builtin_amdgcn_ds_read_tr16_b64_v4i16((LAS s16x4*)p)); }
__device__ __forceinline__ float swap_other_half(float v) { auto rr = __builtin_amdgcn_permlane32_swap(__float_as_uint(v), __float_as_uint(v), false, false); return __uint_as_float((threadIdx.x & 32) ? rr[0] : rr[1]); }

typedef __bf16 bf2_t __attribute__((ext_vector_type(2)));
__device__ __forceinline__ float max3_asm(float a, float b, float c) { float r; asm("v_max3_f32 %0, %1, %2, %3" : "=v"(r) : "v"(a), "v"(b), "v"(c)); return r; }
__device__ __forceinline__ unsigned pair_mask(unsigned w, int p) { const unsigned t0 = (unsigned)__builtin_amdgcn_sbfe((int)w, p, 1), t1 = (unsigned)__builtin_amdgcn_sbfe((int)w, p + 1, 1); return (t0 & 0xffffu) | (t1 & 0xffff0000u); }
__device__ __forceinline__ void unit(unsigned char* lds, int b, int hg, int cc, const bf16_t* P, const unsigned* MASK, bf16_t* AOBO, const float* __restrict__ rel_bias) {
    const int tid = threadIdx.x, lane = tid & 63, r32 = lane & 31, hi = lane >> 5;
    const int w = __builtin_amdgcn_readfirstlane(tid >> 6), hl = w & 1, qs = w >> 1;
    const int cw = 2 * cc + (qs >> 1);
    const int NT = 2 * cc + 2, NTw = cw + 1;
    const int h = 2 * hg + hl;
    const size_t rowb = (size_t)b * SEQ;
    const int pl = hg >> 1, co = (hg & 1) * 128;
    const bf16_t* Kg = P + (size_t)(PL_BK + pl) * PLANE + rowb * 256 + co;
    const bf16_t* Vg = P + (size_t)(PL_BV + pl) * PLANE + rowb * 256 + co;
    const bf16_t* Qg = P + (size_t)(PL_BQ + pl) * PLANE + rowb * 256 + co;
    const bf16_t* Gg = P + (size_t)(PL_BG + pl) * PLANE + rowb * 256 + co;
    LAS unsigned char* L = (LAS unsigned char*)lds;
    LAS float* lut = (LAS float*)(L + OFF_LUT) + hl * 256;
    { const int hh = tid >> 8, rel = (tid & 255) - 192, hd = 4 + 2 * hg + hh; const float far = rel_bias[15 * 12 + hd];
      ((LAS float*)(L + OFF_LUT))[tid] = (rel_bias[t5_bucket(rel) * 12 + hd] - far) * LOG2E; }
#define DSA_DMA(t, buf) do { \
        _Pragma("unroll") for (int i_ = 0; i_ < 2; ++i_) { const int p_ = 2 * w + i_, sub_ = p_ >> 3, row_ = 8 * (p_ & 7) + (lane >> 3); \
            __builtin_amdgcn_global_load_lds((const unsigned*)(Kg + (size_t)((t) * 64 + row_) * 256 + sub_ * 64 + (((lane & 7) ^ ((row_ >> 1) & 7)) * 8)), (LAS unsigned*)(L + OFF_K + (buf) * KBUF + p_ * 1024), 16, 0, 0); } \
        _Pragma("unroll") for (int i_ = 0; i_ < 2; ++i_) { const int ii_ = 2 * w + i_, dq_ = ii_ >> 2, g_ = ii_ & 3; \
            __builtin_amdgcn_global_load_lds((const unsigned*)(Vg + (size_t)((t) * 64 + 16 * g_ + (lane >> 2)) * 256 + dq_ * 32 + (lane & 3) * 8), (LAS unsigned*)(L + OFF_V + (buf) * VBUF + dq_ * 4096 + g_ * 1024), 16, 0, 0); } \
    } while (0)
    DSA_DMA(0, 0);
    bf16x8 qf[4];
    { const bf16_t* qp = Qg + (size_t)(128 * cc + 32 * qs + r32) * 256 + 64 * hl + 8 * hi;
#pragma unroll
      for (int d0 = 0; d0 < 4; ++d0) qf[d0] = *(const bf16x8*)(qp + 16 * d0); }
    f32x16 o[2];
#pragma unroll
    for (int dq = 0; dq < 2; ++dq)
#pragma unroll
        for (int r = 0; r < 16; ++r) o[dq][r] = 0.f;
    f32x16 negm;
#pragma unroll
    for (int r = 0; r < 16; ++r) negm[r] = 0.f;
    float mrun = 0.f, lsum = 0.f;
    int koff[4];
#pragma unroll
    for (int d0 = 0; d0 < 4; ++d0) koff[d0] = hl * 8192 + r32 * 128 + ((((hi << 4) ^ (((r32 >> 1) & 7) << 4))) ^ (d0 << 5));
    const int voff = ((lane >> 4) & 1) * 32 + (lane & 3) * 8 + (4 * hi + ((lane & 15) >> 2)) * 64 + 2 * hl * 4096;
    const u32x4_t* mrow = (const u32x4_t*)MASK + ((size_t)(b * 64 + cw) * 32) * 64 + (32 * (qs & 1) + r32);
    asm volatile("s_waitcnt vmcnt(0)" ::: "memory");
    __syncthreads();
    u32x4_t mw = mrow[0], mwn = mw;
    for (int t = 0; t < NT; ++t) {
        const int buf = t & 1;
        if (t + 1 < NT) DSA_DMA(t + 1, buf ^ 1);
        if ((t & 1) == 0 && t + 2 < NTw) mwn = mrow[(size_t)((t >> 1) + 1) * 64];
        if (t < NTw) {
            const unsigned w0 = ((t & 1) ? mw.z : mw.x) >> (4 * hi), w1 = ((t & 1) ? mw.w : mw.y) >> (4 * hi);
            const lds_cptr kb = (lds_cptr)(L + OFF_K + buf * KBUF);
            f32x16 s0 = negm, s1 = negm;
#pragma unroll
            for (int d0 = 0; d0 < 4; ++d0) {
                const bf16x8 a0 = *(const LAS bf16x8*)(kb + koff[d0]), a1 = *(const LAS bf16x8*)(kb + koff[d0] + 4096);
                s0 = __builtin_amdgcn_mfma_f32_32x32x16_bf16(a0, qf[d0], s0, 0, 0, 0);
                s1 = __builtin_amdgcn_mfma_f32_32x32x16_bf16(a1, qf[d0], s1, 0, 0, 0);
            }
            if (t >= cw - 2) {
                const int base = 192 + 64 * (t - cw) - 32 * (qs & 1) - r32 + 4 * hi;
#pragma unroll
                for (int r = 0; r < 16; ++r) { const int kk = (r & 3) + 8 * (r >> 2); s0[r] += lut[base + kk]; s1[r] += lut[base + 32 + kk]; }
            }
            asm volatile("s_nop 11" : "+v"(s0), "+v"(s1));
            float tm = max3_asm(s0[0], s1[0], s0[1]), tn = max3_asm(s1[1], s0[2], s1[2]);
#pragma unroll
            for (int r = 3; r < 15; r += 3) { tm = max3_asm(tm, s0[r], s1[r]); tn = max3_asm(tn, s0[r + 1], s1[r + 1]); tm = max3_asm(tm, s0[r + 2], s1[r + 2]); }
            tm = max3_asm(tm, tn, s0[15]); tm = max3_asm(tm, s1[15], swap_other_half(max3_asm(tm, s1[15], s1[15])));
            const bool first = (t == 0);
            if (first || __any(tm > THR)) {
                const float dl = first ? tm : fmaxf(tm, 0.f);
                mrun += dl;
#pragma unroll
                for (int r = 0; r < 16; ++r) { s0[r] -= dl; s1[r] -= dl; negm[r] = -mrun; }
                const float al = __builtin_amdgcn_exp2f(-dl);
                lsum *= al;
                if (!first) {
#pragma unroll
                    for (int dq = 0; dq < 2; ++dq)
#pragma unroll
                        for (int r = 0; r < 16; ++r) o[dq][r] *= al;
                }
            }
#pragma unroll
            for (int r = 0; r < 16; ++r) { s0[r] = __builtin_amdgcn_exp2f(s0[r]); s1[r] = __builtin_amdgcn_exp2f(s1[r]); }
            bf16x8 pf[4]; float ps = 0.f; const unsigned ones = 0x3f803f80u;
#pragma unroll
            for (int ks = 0; ks < 2; ++ks) {
                u32x4_t a, c;
#pragma unroll
                for (int e = 0; e < 4; ++e) { const int r = 8 * ks + 2 * e, pos = (r & 3) + 8 * (r >> 2);
                    const unsigned pa = pk2(s0[r], s0[r + 1]) & pair_mask(w0, pos), pc = pk2(s1[r], s1[r + 1]) & pair_mask(w1, pos);
                    a[e] = pa; c[e] = pc;
                    ps = __builtin_amdgcn_fdot2_f32_bf16(__builtin_bit_cast(bf2_t, pa), __builtin_bit_cast(bf2_t, ones), ps, false);
                    ps = __builtin_amdgcn_fdot2_f32_bf16(__builtin_bit_cast(bf2_t, pc), __builtin_bit_cast(bf2_t, ones), ps, false); }
                pf[ks] = __builtin_bit_cast(bf16x8, a); pf[2 + ks] = __builtin_bit_cast(bf16x8, c);
            }
            lsum += ps;
            const lds_cptr vp = (lds_cptr)(L + OFF_V + buf * VBUF + voff);
#pragma unroll
            for (int dq = 0; dq < 2; ++dq)
#pragma unroll
                for (int ks = 0; ks < 4; ++ks) {
                    const s16x4 lo = vtr(vp + dq * 4096 + ks * 1024), hh = vtr(vp + dq * 4096 + ks * 1024 + 512);
                    const bf16x8 vf = {lo[0], lo[1], lo[2], lo[3], hh[0], hh[1], hh[2], hh[3]};
                    o[dq] = __builtin_amdgcn_mfma_f32_32x32x16_bf16(vf, pf[ks], o[dq], 0, 0, 0);
                }
        }
        asm volatile("s_waitcnt vmcnt(0)" ::: "memory");
        __syncthreads();
        if (t & 1) mw = mwn;
    }
#undef DSA_DMA
    {
        const float inv = 1.0f / (lsum + swap_other_half(lsum));
        const size_t m = rowb + (size_t)(128 * cc + 32 * qs + r32);
        const bf16_t* gp = Gg + (m - rowb) * 256 + 64 * hl;
        bf16_t* op = AOBO + m * DM + 512 + h * 64;
#pragma unroll
        for (int dq = 0; dq < 2; ++dq)
#pragma unroll
            for (int g = 0; g < 4; ++g) { const int dv = 32 * dq + 8 * g + 4 * hi;
                const u32x2_t gv = *(const u32x2_t*)(gp + dv);
                u32x2_t ov; ov.x = pk2(o[dq][4 * g + 0] * inv * bflo(gv.x), o[dq][4 * g + 1] * inv * bfhi(gv.x));
                ov.y = pk2(o[dq][4 * g + 2] * inv * bflo(gv.y), o[dq][4 * g + 3] * inv * bfhi(gv.y));
                *(u32x2_t*)(op + dv) = ov; }
    }
    __syncthreads();
}
__device__ __forceinline__ void phase(unsigned char* lds, int blk, int G, const bf16_t* P, const unsigned* MASK, bf16_t* AOBO, const float* rel_bias) {
    if (G == 256) {
        const int x = blk & 7, i = blk >> 3;
        for (int k = 0; k < 4; ++k) { const int id = 4 * x + k; unit(lds, id >> 2, id & 3, (k & 1) ? 31 - i : i, P, MASK, AOBO, rel_bias); }
    } else {
        for (int u = blk; u < 32 * 32; u += G) unit(lds, (u >> 5) >> 2, (u >> 5) & 3, u & 31, P, MASK, AOBO, rel_bias);
    }
}
}
#ifndef DBG_T
#define DBG_T(i) do {} while (0)
#endif
#ifndef DBG_COUNT
#define DBG_COUNT(i) do {} while (0)
#endif
#ifndef REP_SEL_HIST
#define REP_SEL_HIST 1
#endif
#ifndef REP_SEL_FINAL
#define REP_SEL_FINAL 1
#endif
#ifndef REP_SEL_RESOLVE
#define REP_SEL_RESOLVE 1
#endif
namespace sel {
typedef short bf16x8 __attribute__((ext_vector_type(8)));
typedef float f32x16 __attribute__((ext_vector_type(16)));
constexpr int B1 = 512, KNEG = 256, CAP = 128;
constexpr int OFF_HIST = 0, OFF_TW = 0, OFF_CLS = 16384, OFF_CLI = 32768, OFF_PAR = 66048, OFF_IQ = 70656, OFF_SLOW = 0, LDS_NEED = OFF_IQ + 16384;
constexpr int P_KMAX = 0, P_S0 = 32, P_EST = 64, P_R = 96, P_CC = 128, P_MODE = 160, P_SEG = 192;

__device__ __forceinline__ float other_half(float v) { auto rr = __builtin_amdgcn_permlane32_swap(__float_as_uint(v), __float_as_uint(v), false, false); return __uint_as_float((threadIdx.x & 32) ? rr[0] : rr[1]); }
__device__ __forceinline__ unsigned other_half_u(unsigned v) { auto rr = __builtin_amdgcn_permlane32_swap(v, v, false, false); return (threadIdx.x & 32) ? rr[0] : rr[1]; }

struct Tile { bf16x8 a[4]; };
__device__ __forceinline__ void load_tile(Tile& t, const bf16_t* ikrow) {
#pragma unroll
    for (int d0 = 0; d0 < 4; ++d0) t.a[d0] = *(const bf16x8*)(ikrow + 16 * d0);
}
__device__ __forceinline__ float relu_f(float x) { float r; asm("v_max_f32_e32 %0, 0, %1" : "=v"(r) : "v"(x)); return r; }
__device__ __forceinline__ f32x16 head_logits(const Tile& t, LAS const char* iqb, int h) {
    f32x16 l;
#pragma unroll
    for (int r = 0; r < 16; ++r) l[r] = 0.f;
#pragma unroll
    for (int d0 = 0; d0 < 4; ++d0) { const bf16x8 bqf = *(const LAS bf16x8*)(iqb + (8 * h + 2 * d0) * 512); l = __builtin_amdgcn_mfma_f32_32x32x16_bf16(t.a[d0], bqf, l, 0, 0, 0); }
    return l;
}
#define SEL_PIN(x) asm volatile("" : "+v"(x))
__device__ __forceinline__ void score_tile(f32x16& sc, Tile& t, LAS const char* iqb, const float (&wg)[4], const bf16_t* nxt) {
    asm volatile("" ::: "memory");
    f32x16 la = head_logits(t, iqb, 0);
    f32x16 lb = head_logits(t, iqb, 1);
    SEL_PIN(la); SEL_PIN(lb);
    __builtin_amdgcn_sched_barrier(0);
#pragma unroll
    for (int r = 0; r < 16; ++r) sc[r] = wg[0] * relu_f(la[r]);
    SEL_PIN(sc);
    __builtin_amdgcn_sched_barrier(0);
    la = head_logits(t, iqb, 2);
    SEL_PIN(la);
    __builtin_amdgcn_sched_barrier(0);
#pragma unroll
    for (int r = 0; r < 16; ++r) sc[r] = fmaf(wg[1], relu_f(lb[r]), sc[r]);
    SEL_PIN(sc);
    __builtin_amdgcn_sched_barrier(0);
    lb = head_logits(t, iqb, 3);
    SEL_PIN(lb);
    if (nxt) load_tile(t, nxt);
    __builtin_amdgcn_sched_barrier(0);
#pragma unroll
    for (int r = 0; r < 16; ++r) sc[r] = fmaf(wg[2], relu_f(la[r]), sc[r]);
    SEL_PIN(sc);
    __builtin_amdgcn_sched_barrier(0);
#pragma unroll
    for (int r = 0; r < 16; ++r) sc[r] = fmaf(wg[3], relu_f(lb[r]), sc[r]) + 0.0f;
    SEL_PIN(sc);
    __builtin_amdgcn_sched_barrier(0);
}
__device__ __forceinline__ int bin_of(float s, float s0, int s0b) {
    int fl = (__float_as_int(fabsf(s) + s0) - s0b) >> 19; fl = fl > 255 ? 255 : fl;
    return KNEG + (fl ^ (__float_as_int(s) >> 31));
}
__device__ __forceinline__ void sel_slow_one(int b, int c, int q, int lane, unsigned* skey, float* sq, const bf16_t* P, const float* IW, unsigned* MW) {
    const int m = b * SEQ + 64 * c + q, N = 64 * (c + 1);
    { const u32x2_t qv = *(const u32x2_t*)(P + PL_IQ * PLANE + (size_t)m * 256 + lane * 4);
      sq[lane * 4 + 0] = bflo(qv.x); sq[lane * 4 + 1] = bfhi(qv.x); sq[lane * 4 + 2] = bflo(qv.y); sq[lane * 4 + 3] = bfhi(qv.y); }
    const f32x4_t iw = *(const f32x4_t*)(IW + (size_t)m * 4);
    const float wg0 = iw.x * IDX_SCALE, wg1 = iw.y * IDX_SCALE, wg2 = iw.z * IDX_SCALE, wg3 = iw.w * IDX_SCALE;
    WAVE_SYNC();
    for (int i = 0; i < N / 64; ++i) {
        asm volatile("" ::: "memory");
        const int s = i * 64 + lane; const bf16_t* kr = P + PL_IK * PLANE + (size_t)(b * SEQ + s) * 256;
        float l0 = 0.f, l1 = 0.f, l2 = 0.f, l3 = 0.f;
#pragma unroll
        for (int cc = 0; cc < 8; ++cc) { const u32x4_t kv = *(const u32x4_t*)(kr + cc * 8);
            const float k[8] = {bflo(kv.x), bfhi(kv.x), bflo(kv.y), bfhi(kv.y), bflo(kv.z), bfhi(kv.z), bflo(kv.w), bfhi(kv.w)};
#pragma unroll
            for (int e = 0; e < 8; ++e) { const int d = cc * 8 + e; l0 += sq[d] * k[e]; l1 += sq[64 + d] * k[e]; l2 += sq[128 + d] * k[e]; l3 += sq[192 + d] * k[e]; } }
        float sc = wg0 * fmaxf(l0, 0.f); sc = fmaf(wg1, fmaxf(l1, 0.f), sc); sc = fmaf(wg2, fmaxf(l2, 0.f), sc); sc = fmaf(wg3, fmaxf(l3, 0.f), sc);
        sc += 0.0f;
        skey[s] = f2key(sc);
    }
    WAVE_SYNC();
    unsigned prefix = 0u;
    for (int bit = 31; bit >= 0; --bit) { const unsigned cand = prefix | (1u << bit); int cn = 0;
        for (int i = 0; i < N / 64; ++i) cn += (skey[i * 64 + lane] >= cand) ? 1 : 0;
        cn = wave_sum_i(cn); if (cn >= 256) prefix = cand; }
    int cgt = 0; for (int i = 0; i < N / 64; ++i) cgt += (skey[i * 64 + lane] > prefix) ? 1 : 0;
    cgt = wave_sum_i(cgt);
    const int r = 256 - cgt;
    int run = 0, kcut = 0x7fffffff;
    for (int i = 0; i < N / 64; ++i) { const unsigned long long bm = __ballot(skey[i * 64 + lane] == prefix); const int cn = __popcll(bm);
        if (run + cn >= r) { unsigned long long t = bm; for (int z = 0; z < r - run - 1; ++z) t &= t - 1; kcut = i * 64 + (int)__builtin_ctzll(t); break; }
        run += cn; }
    for (int i = 0; i < N / 64; ++i) { const unsigned k = skey[i * 64 + lane]; const int idx = i * 64 + lane; const bool f = (k > prefix) || (k == prefix && idx <= kcut);
        const unsigned long long bm = __ballot(f);
        if (lane == 0) { u32x2_t o = {(unsigned)bm, (unsigned)(bm >> 32)}; *(u32x2_t*)(MW + ((size_t)(i >> 1) * 64 + q) * 4 + (i & 1) * 2) = o; } }
    WAVE_SYNC();
}

__device__ __forceinline__ void unit(unsigned char* lds, int b, int c, int hq, const bf16_t* P, const float* IW, unsigned* MASK) {
    const int tid = threadIdx.x, lane = tid & 63, r32 = lane & 31, hi = lane >> 5;
    const int w = __builtin_amdgcn_readfirstlane(tid >> 6);
    const int N = 64 * (c + 1), NT32 = N / 32;
    unsigned* MW = MASK + ((size_t)(b * 64 + c) * 32 * 64) * 4;
    if (c < 4) {
        for (int idx = tid; idx < 32 * NT32; idx += 512) { const int q = 32 * hq + (idx & 31), kt = idx >> 5; MW[((size_t)(kt >> 2) * 64 + q) * 4 + (kt & 3)] = 0xffffffffu; }
        return;
    }
    DBG_T(0);
    LAS unsigned* hist = (LAS unsigned*)((LAS unsigned char*)lds + OFF_HIST);
    LAS unsigned* TW = (LAS unsigned*)((LAS unsigned char*)lds + OFF_TW);
    LAS float* CLS = (LAS float*)((LAS unsigned char*)lds + OFF_CLS);
    LAS unsigned* CLI = (LAS unsigned*)((LAS unsigned char*)lds + OFF_CLI);
    LAS unsigned* PAR = (LAS unsigned*)((LAS unsigned char*)lds + OFF_PAR);
    const int q = r32, qc = 32 * hq + r32;
    const size_t m = (size_t)b * SEQ + 64 * c + qc;
    {
        const bf16_t* qrow = P + (size_t)PL_IQ * PLANE + ((size_t)b * SEQ + 64 * c + 32 * hq) * 256;
#pragma unroll
        for (int i = 0; i < 2; ++i) { const int p = tid + 512 * i, qq = p >> 5, ch = p & 31;
            *(LAS u32x4_t*)((LAS unsigned char*)lds + OFF_IQ + ch * 512 + qq * 16) = *(const u32x4_t*)(qrow + (size_t)qq * 256 + ch * 8); }
    }
    LAS const char* iqb = (LAS const char*)((LAS unsigned char*)lds + OFF_IQ + hi * 512 + q * 16);
    float wg[4];
    { const f32x4_t iw = *(const f32x4_t*)(IW + m * 4); wg[0] = iw.x * IDX_SCALE; wg[1] = iw.y * IDX_SCALE; wg[2] = iw.z * IDX_SCALE; wg[3] = iw.w * IDX_SCALE; }
    const bf16_t* ikl = P + (size_t)PL_IK * PLANE + ((size_t)b * SEQ + r32) * 256 + 8 * hi;
    for (int i = tid; i < 513 * 32; i += 512) hist[i] = 0u;
    if (tid < 32) { PAR[P_KMAX + tid] = 0u; PAR[P_CC + tid] = 0u; }
    __syncthreads();
    {   float mx = 0.f;
        for (int kt = w; kt < NT32; kt += 64) { Tile t; load_tile(t, ikl + (size_t)kt * 32 * 256); f32x16 sc; score_tile(sc, t, iqb, wg, nullptr);
#pragma unroll
            for (int r = 0; r < 16; ++r) mx = fmaxf(mx, fabsf(sc[r])); }
        mx = fmaxf(mx, other_half(mx));
        if (hi == 0) atomicMax((unsigned*)&PAR[P_KMAX + q], __float_as_uint(mx));
    }
    __syncthreads();
    if (tid < 32) { const float R = __uint_as_float(PAR[P_KMAX + tid]) * 1.125f + 1e-30f; PAR[P_S0 + tid] = __float_as_uint(R * (1.0f / 65536.0f)); }
    __syncthreads();
    const float s0 = __uint_as_float(PAR[P_S0 + q]); const int s0b = (int)PAR[P_S0 + q];
    DBG_T(1);
    for (int rep_ = 0; rep_ < REP_SEL_HIST; ++rep_)
    {   Tile t; const unsigned one_ = rep_ == 0 ? 1u : 0u;
        if (w < NT32) load_tile(t, ikl + (size_t)w * 32 * 256);
        for (int kt = w; kt < NT32; kt += 8) {
            f32x16 sc; score_tile(sc, t, iqb, wg, (kt + 8 < NT32) ? ikl + (size_t)(kt + 8) * 32 * 256 : nullptr);
#pragma unroll
            for (int r = 0; r < 16; ++r) { int bn = bin_of(sc[r], s0, s0b); bn = (sc[r] != 0.f) ? bn : B1; atomicAdd((unsigned*)&hist[bn * 32 + q], one_); }
        }
    }
    __syncthreads();
    DBG_T(2);
    {   const int sq_ = tid & 31, seg = tid >> 5; unsigned ssum = 0u;
#pragma unroll 8
        for (int i = 0; i < 32; ++i) ssum += hist[(seg * 32 + i) * 32 + sq_];
        PAR[P_SEG + sq_ * 16 + seg] = ssum;
    }
    __syncthreads();
    if (tid < 32) {
        const int cntZ = (int)hist[B1 * 32 + tid];
        int cum = 0, est = -1, mode = 0, R = 0, cnt = 0;
#pragma nounroll
        for (int step = 0; step < 17 && est < 0; ++step) {
            if (step == 8) { if (cum + cntZ >= 256) { est = 2 * KNEG; R = 256 - cum; mode = 1; cnt = cntZ; } else cum += cntZ; }
            else { const int seg = step < 8 ? 15 - step : 16 - step; const int ssum = (int)PAR[P_SEG + tid * 16 + seg];
                if (cum + ssum >= 256) {
#pragma nounroll
                    for (int bn = seg * 32 + 31; bn >= seg * 32; --bn) { const int hcount = (int)hist[bn * 32 + tid]; if (cum + hcount >= 256) { est = 2 * bn + 1; R = 256 - cum; cnt = hcount; break; } cum += hcount; }
                } else cum += ssum; }
        }
        if (est < 0) { est = 1; R = 1; mode = 2; }
        if (mode == 0 && cnt > CAP) mode = 2;
        PAR[P_EST + tid] = (unsigned)est; PAR[P_R + tid] = (unsigned)R; PAR[P_MODE + tid] = (unsigned)mode;
    }
    __syncthreads();
    const int est = (int)PAR[P_EST + q]; const bool normal = (PAR[P_MODE + q] == 0u);
    DBG_T(3);
    for (int rep_ = 0; rep_ < REP_SEL_FINAL; ++rep_)
    {   Tile t;
        if (rep_ > 0) { __syncthreads(); if (tid < 32) PAR[P_CC + tid] = 0u; __syncthreads(); }
        if (w < NT32) load_tile(t, ikl + (size_t)w * 32 * 256);
#define SEL_FINAL_TILE(T, KT) do { f32x16 sc; score_tile(sc, T, iqb, wg, ((KT) + 8 < NT32) ? ikl + (size_t)((KT) + 8) * 32 * 256 : nullptr); unsigned gp = 0u, ep = 0u; \
            _Pragma("unroll") for (int r = 0; r < 16; ++r) { const int bn = bin_of(sc[r], s0, s0b); const int e = 2 * bn + (sc[r] != 0.f ? 1 : 0); const int pos = (r & 3) + 8 * (r >> 2); \
                gp |= (e > est ? 1u : 0u) << pos; ep |= (e == est ? 1u : 0u) << pos; } \
            unsigned cb = normal ? ep : 0u; \
            while (__any(cb != 0u)) { \
                if (cb != 0u) { const int pos = __builtin_ctz(cb); cb &= cb - 1u; const int rr = (pos & 3) + 4 * (pos >> 3); float val = sc[0]; \
                    _Pragma("unroll") for (int r = 1; r < 16; ++r) val = (rr == r) ? sc[r] : val; \
                    const unsigned slot = atomicAdd((unsigned*)&PAR[P_CC + q], 1u); \
                    if (slot < (unsigned)CAP) { CLS[q * CAP + slot] = val; CLI[q * CAP + slot] = (unsigned)((KT) * 32 + pos + 4 * hi); } } } \
            gp <<= 4 * hi; ep <<= 4 * hi; gp |= other_half_u(gp); ep |= other_half_u(ep); \
            if (hi == 0) { MW[((size_t)((KT) >> 2) * 64 + qc) * 4 + ((KT) & 3)] = gp; TW[q * 128 + (KT)] = ep; } } while (0)
        for (int kt = w; kt < NT32; kt += 8) SEL_FINAL_TILE(t, kt);
#undef SEL_FINAL_TILE
    }
    asm volatile("s_waitcnt vmcnt(0) lgkmcnt(0)" ::: "memory");
    __syncthreads();
    DBG_T(4);
    for (int rep_ = 0; rep_ < REP_SEL_RESOLVE; ++rep_)
    for (int qq = w; qq < 32; qq += 8) {
        const unsigned mode = PAR[P_MODE + qq]; const int R = (int)PAR[P_R + qq]; const int qqc = 32 * hq + qq;
        if (mode == 0u) {
            const int n = (int)PAR[P_CC + qq];
            if (n > CAP) { if (lane == 0) PAR[P_MODE + qq] = 2u; }
            else {
                const float s_lo = lane < n ? CLS[qq * CAP + lane] : -INFINITY, s_hi = (lane + 64) < n ? CLS[qq * CAP + 64 + lane] : -INFINITY;
                const unsigned i_lo = lane < n ? CLI[qq * CAP + lane] : 0xffffffffu, i_hi = (lane + 64) < n ? CLI[qq * CAP + 64 + lane] : 0xffffffffu;
                int rk_lo = 0, rk_hi = 0;
                const int n1 = n < 64 ? n : 64;
                for (int i = 0; i < n1; ++i) { const float si = __uint_as_float(__builtin_amdgcn_readlane(__float_as_uint(s_lo), i)); const unsigned ii = __builtin_amdgcn_readlane(i_lo, i);
                    rk_lo += ((si > s_lo) || (si == s_lo && ii < i_lo)) ? 1 : 0; rk_hi += ((si > s_hi) || (si == s_hi && ii < i_hi)) ? 1 : 0; }
                for (int i = 64; i < n; ++i) { const float si = __uint_as_float(__builtin_amdgcn_readlane(__float_as_uint(s_hi), i - 64)); const unsigned ii = __builtin_amdgcn_readlane(i_hi, i - 64);
                    rk_lo += ((si > s_lo) || (si == s_lo && ii < i_lo)) ? 1 : 0; rk_hi += ((si > s_hi) || (si == s_hi && ii < i_hi)) ? 1 : 0; }
                if (lane < n && rk_lo < R) atomicOr(&MW[((size_t)(i_lo >> 7) * 64 + qqc) * 4 + ((i_lo >> 5) & 3)], 1u << (i_lo & 31));
                if ((lane + 64) < n && rk_hi < R) atomicOr(&MW[((size_t)(i_hi >> 7) * 64 + qqc) * 4 + ((i_hi >> 5) & 3)], 1u << (i_hi & 31));
            }
        } else if (mode == 1u) {
            const unsigned w0 = lane < NT32 ? TW[qq * 128 + lane] : 0u, w1 = (lane + 64) < NT32 ? TW[qq * 128 + 64 + lane] : 0u;
            const int c0 = __popc(w0), c1 = __popc(w1);
            int p0 = c0, p1 = c1;
#pragma unroll
            for (int o = 1; o < 64; o <<= 1) { const int t0 = __shfl_up(p0, o), t1 = __shfl_up(p1, o); if (lane >= o) { p0 += t0; p1 += t1; } }
            const int tot0 = __shfl(p0, 63);
            const int before0 = p0 - c0, before1 = tot0 + p1 - c1;
#pragma unroll
            for (int half = 0; half < 2; ++half) {
                unsigned wv = half ? w1 : w0; const int cnt = half ? c1 : c0; const int before = half ? before1 : before0; const int kt = lane + 64 * half;
                int take = R - before; take = take < 0 ? 0 : (take > cnt ? cnt : take);
                if (take > 0) { unsigned res = 0u; for (int z = 0; z < take; ++z) { const unsigned low = wv & (0u - wv); res |= low; wv ^= low; }
                    atomicOr(&MW[((size_t)(kt >> 2) * 64 + qqc) * 4 + (kt & 3)], res); }
            }
        }
    }
    asm volatile("s_waitcnt vmcnt(0) lgkmcnt(0)" ::: "memory");
    __syncthreads();
    DBG_T(5);
    if (w < 3) {
        unsigned* skey = (unsigned*)(lds + OFF_SLOW + w * 17408); float* sq = (float*)(lds + OFF_SLOW + w * 17408 + 16384);
        int seen = 0;
        for (int qq = 0; qq < 32; ++qq) if (PAR[P_MODE + qq] == 2u) { if ((seen % 3) == w) { sel_slow_one(b, c, 32 * hq + qq, lane, skey, sq, P, IW, MW); DBG_COUNT(0); } ++seen; }
    }
    asm volatile("s_waitcnt vmcnt(0) lgkmcnt(0)" ::: "memory");
    __syncthreads();
    DBG_T(6);
}
__device__ __forceinline__ void phase(unsigned char* lds, int blk, int G, const bf16_t* P, const float* IW, unsigned* MASK) {
    DBG_T(7);
    if (G == 256) { const int b = blk & 7, i = blk >> 3;
        for (int k = 0; k < 4; ++k) unit(lds, b, (k & 2) ? 63 - i : i, k & 1, P, IW, MASK); }
    else { for (int u = blk; u < NBATCH * 128; u += G) unit(lds, u >> 7, (u >> 1) & 63, u & 1, P, IW, MASK); }
}
}
constexpr int LDS_MAIN = 150528;
constexpr int MISC_OFF = LDS_MAIN, LDS_BYTES = LDS_MAIN + 64;
constexpr size_t BAR_BYTES = (size_t)XCD_BAR_WORDS * 4;
#ifndef REP_PRO
#define REP_PRO 1
#endif
#ifndef REP_GEMM1
#define REP_GEMM1 1
#endif
#ifndef REP_SEL
#define REP_SEL 1
#endif
#ifndef REP_DSA
#define REP_DSA 1
#endif
#ifndef REP_DFA
#define REP_DFA 1
#endif
#ifndef REP_OUT
#define REP_OUT 1
#endif
struct Args { const float* in[11]; float* out; unsigned char* ws; };

__global__ void __launch_bounds__(512, 2) fwd(Args a) {
    extern __shared__ __attribute__((aligned(16))) unsigned char lds[];
    const int tid = threadIdx.x, lane = tid & 63, wave = __builtin_amdgcn_readfirstlane(tid >> 6);
    volatile LAS unsigned* misc = (volatile LAS unsigned*)((LAS unsigned char*)lds + MISC_OFF);
    if (tid < 16) misc[tid] = 0u;
    __syncthreads();
    XcdBarrier bar = xcd_barrier_post((unsigned*)a.ws, misc);
    const int G = gridDim.x, gw = blockIdx.x * 8 + wave, ngw = G * 8;
    unsigned char* ws = a.ws;
    const float* x = a.in[0]; const float* rel_bias = a.in[9];
    prologue_body(gw, ngw, lane, x, a.in[1], a.in[2], a.in[3], (bf16_t*)(ws + WS_H), (float*)(ws + WS_IW), (bf16_t*)(ws + WS_WINT), (bf16_t*)(ws + WS_WOUTT));
#if REP_PRO == 2
    __syncthreads();
    prologue_body(gw, ngw, lane, x, a.in[1], a.in[2], a.in[3], (bf16_t*)(ws + WS_H), (float*)(ws + WS_IW), (bf16_t*)(ws + WS_WINT), (bf16_t*)(ws + WS_WOUTT));
#endif
    xcd_barrier(bar);
    { pg8::Gemm g{(const bf16_t*)(ws + WS_H), (const bf16_t*)(ws + WS_WINT), MT, NPAD, DM}; pg8::StaticOrder S; S.init(MT, NPAD, G, (int)blockIdx.x);
      pg8::EpiProj E{(bf16_t*)(ws + WS_P)};
      pg8::gemm_phase<pg8::EpiProj, pg8::StaticOrder, true, true>((PG8_LAS unsigned char*)lds, g, S, E); }
#if REP_GEMM1 == 2
    __syncthreads();
    { pg8::Gemm g{(const bf16_t*)(ws + WS_H), (const bf16_t*)(ws + WS_WINT), MT, NPAD, DM}; pg8::StaticOrder S; S.init(MT, NPAD, G, (int)blockIdx.x);
      pg8::EpiProj E{(bf16_t*)(ws + WS_P)};
      pg8::gemm_phase<pg8::EpiProj, pg8::StaticOrder, true, true>((PG8_LAS unsigned char*)lds, g, S, E); }
#endif
    xcd_barrier(bar);
    for (int rep = 0; rep < REP_SEL; ++rep)
    sel::phase(lds, (int)blockIdx.x, G, (const bf16_t*)(ws + WS_P), (const float*)(ws + WS_IW), (unsigned*)(ws + WS_MASK));
    xcd_barrier(bar);
    for (int rep = 0; rep < REP_DSA; ++rep)
    dsa::phase(lds, (int)blockIdx.x, G, (const bf16_t*)(ws + WS_P), (const unsigned*)(ws + WS_MASK), (bf16_t*)(ws + WS_AOBO), rel_bias);
    __syncthreads();
    { const float lam = diff_lambda(lane, a.in[4], a.in[5], a.in[6], a.in[7]);
      for (int rep = 0; rep < REP_DFA; ++rep)
      dfa::phase(lds, (int)blockIdx.x, G, (const bf16_t*)(ws + WS_P), (bf16_t*)(ws + WS_AOBO), rel_bias, a.in[8], lam); }
    xcd_barrier(bar);
    { pg8::Gemm g{(const bf16_t*)(ws + WS_AOBO), (const bf16_t*)(ws + WS_WOUTT), MT, DM, DM}; pg8::StaticOrder S; S.init(MT, DM, G, (int)blockIdx.x);
      pg8::EpiOut E{x, (bf16_t*)(ws + WS_H)};
      pg8::gemm_phase<pg8::EpiOut, pg8::StaticOrder, true, true>((PG8_LAS unsigned char*)lds, g, S, E); }
#if REP_OUT == 2
    __syncthreads();
    { pg8::Gemm g{(const bf16_t*)(ws + WS_AOBO), (const bf16_t*)(ws + WS_WOUTT), MT, DM, DM}; pg8::StaticOrder S; S.init(MT, DM, G, (int)blockIdx.x);
      pg8::EpiOut E{x, (bf16_t*)(ws + WS_H)};
      pg8::gemm_phase<pg8::EpiOut, pg8::StaticOrder, true, true>((PG8_LAS unsigned char*)lds, g, S, E); }
#endif
    xcd_barrier(bar);
    final_norm_body(gw, ngw, lane, (const bf16_t*)(ws + WS_H), a.out, a.in[10]);
#ifdef DBG_ENCODE
    DBG_ENCODE
#endif
}

extern "C" void kernel_launch(void* const* d_in, const int* in_sizes, int n_in, void* d_out, int out_size, void* d_ws, size_t ws_size, hipStream_t stream) {
    static int grid = 0;
    if (grid == 0) {
        if (n_in != 11 || out_size != MT * DM || ws_size < WS_END) { fprintf(stderr, "kernel_launch: unexpected shapes (n_in %d out %d ws %zu need %zu)\n", n_in, out_size, ws_size, (size_t)WS_END); grid = -1; return; }
        int dev = 0, cus = 0, per_cu = 0;
        if (hipGetDevice(&dev) != hipSuccess || hipDeviceGetAttribute(&cus, hipDeviceAttributeMultiprocessorCount, dev) != hipSuccess) { grid = -1; return; }
        if (hipFuncSetAttribute((const void*)fwd, hipFuncAttributeMaxDynamicSharedMemorySize, LDS_BYTES) != hipSuccess) { fprintf(stderr, "kernel_launch: hipFuncSetAttribute failed\n"); grid = -1; return; }
        if (hipOccupancyMaxActiveBlocksPerMultiprocessor(&per_cu, (const void*)fwd, 512, LDS_BYTES) != hipSuccess || per_cu < 1) { fprintf(stderr, "kernel_launch: occupancy query says %d blocks per CU\n", per_cu); (void)hipGetLastError(); }
        grid = cus;
    }
    if (grid < 0) return;
    if (hipMemsetAsync(d_ws, 0, 16384, stream) != hipSuccess) { fprintf(stderr, "kernel_launch: memset failed\n"); return; }
    Args a; memset(&a, 0, sizeof(a));
    for (int i = 0; i < 11; ++i) a.in[i] = (const float*)d_in[i];
    a.out = (float*)d_out; a.ws = (unsigned char*)d_ws;
    hipLaunchKernelGGL(fwd, dim3(grid), dim3(512), LDS_BYTES, stream, a);
}
```

```cpp
#include <hip/hip_runtime.h>
#include <cstdio>
#include <cstdint>
#include <cstring>
#include <cmath>
#define LAS __attribute__((address_space(3)))
typedef unsigned short bf16_t;
typedef unsigned u32x4_t __attribute__((ext_vector_type(4)));
typedef unsigned u32x2_t __attribute__((ext_vector_type(2)));
typedef float f32x4_t __attribute__((ext_vector_type(4)));

constexpr int DM = 1024, NBATCH = 8, SEQ = 4096, MT = NBATCH * SEQ;
constexpr int D_IN = 4420, NPAD = 4608, NPLANES = 18;
constexpr float EPS = 1e-6f, LOG2E = 1.4426950408889634f;
constexpr float C2 = 0.125f * LOG2E;
constexpr float IDX_SCALE = 0.0625f;
constexpr float LAMBDA_INIT = 0.2f, ONE_M_LAMBDA = 0.8f;
constexpr size_t PLANE = (size_t)MT * 256;
constexpr int PL_AQ = 0, PL_AK = 2, PL_AV = 4, PL_AG = 6, PL_BQ = 8, PL_BK = 10, PL_BV = 12, PL_BG = 14, PL_IQ = 16, PL_IK = 17;

constexpr size_t WS_CTL = 0;
constexpr size_t WS_WINT = 65536;
constexpr size_t WS_WOUTT = WS_WINT + (size_t)NPAD * DM * 2;
constexpr size_t WS_H = WS_WOUTT + (size_t)DM * DM * 2;
constexpr size_t WS_P = WS_H + (size_t)MT * DM * 2;
constexpr size_t WS_IW = WS_P + (size_t)NPLANES * PLANE * 2;
constexpr size_t WS_THR = WS_IW + (size_t)MT * 16;
constexpr size_t WS_KCUT = WS_THR + (size_t)MT * 4;
constexpr size_t WS_SELCNT = WS_KCUT + (size_t)MT * 4;
constexpr size_t WS_AOBO = WS_SELCNT + (size_t)MT * 4;
constexpr size_t WS_SEL = WS_AOBO + (size_t)MT * DM * 2;
constexpr size_t WS_MASK = WS_SEL + (size_t)MT * 256 * 4;
constexpr size_t WS_END = WS_MASK + (size_t)NBATCH * 64 * 32 * 64 * 16;

__device__ __forceinline__ float bf2f(bf16_t v) { return __uint_as_float(((unsigned)v) << 16); }
__device__ __forceinline__ float bflo(unsigned w) { return __uint_as_float(w << 16); }
__device__ __forceinline__ float bfhi(unsigned w) { return __uint_as_float(w & 0xffff0000u); }
__device__ __forceinline__ unsigned pk2(float lo, float hi) {
    typedef float f2 __attribute__((ext_vector_type(2))); typedef __bf16 b2 __attribute__((ext_vector_type(2)));
    f2 v = {lo, hi}; b2 b = __builtin_convertvector(v, b2); return __builtin_bit_cast(unsigned, b); }
__device__ __forceinline__ float wave_sum(float v) {
#pragma unroll
    for (int o = 1; o < 64; o <<= 1) v += __shfl_xor(v, o);
    return v; }
__device__ __forceinline__ int wave_sum_i(int v) {
#pragma unroll
    for (int o = 1; o < 64; o <<= 1) v += __shfl_xor(v, o);
    return v; }
__device__ __forceinline__ float wave_max(float v) {
#pragma unroll
    for (int o = 1; o < 64; o <<= 1) v = fmaxf(v, __shfl_xor(v, o));
    return v; }
__device__ __forceinline__ int t5_bucket(int rel) {
    const int ret = rel > 0 ? 16 : 0; const int n = rel < 0 ? -rel : rel;
    if (n < 8) return ret + n;
    int large = 2 + (31 - __builtin_clz((unsigned)(n * n))); large = large > 15 ? 15 : large;
    return ret + large; }
__device__ __forceinline__ unsigned f2key(float f) { const unsigned u = __float_as_uint(f); return (u & 0x80000000u) ? ~u : (u | 0x80000000u); }
__device__ __forceinline__ float key2f(unsigned k) { return __uint_as_float((k & 0x80000000u) ? (k ^ 0x80000000u) : ~k); }
__device__ __forceinline__ float silu_f(float v) { return v * __builtin_amdgcn_rcpf(1.0f + __builtin_amdgcn_exp2f(-v * LOG2E)); }
namespace pg8 {
#define PG8_LAS __attribute__((address_space(3)))
typedef unsigned short bf16_t;
typedef short bf16x8 __attribute__((ext_vector_type(8)));
typedef float f32x4 __attribute__((ext_vector_type(4)));
typedef unsigned u32x4 __attribute__((ext_vector_type(4)));
constexpr int BM = 256, BK = 64, HALF = 128, HTB = HALF * BK * 2  , STAGE_BYTES = 8 * HTB, NXCD = 8, WGM = 8;

__host__ __device__ __forceinline__ int lds_byte(int r, int c) { const int st = (r >> 4) * 2 + (c >> 5), rr = r & 15, cc = c & 31, ob = rr * 64 + cc * 2; return st * 1024 + (ob ^ (((ob >> 9) & 1) << 5)); }
__host__ __device__ __forceinline__ void stage_rc(int b, int& R, int& C) { const int st = b / 1024, sb = b % 1024, swz = sb ^ (((sb >> 9) & 1) << 5); R = (st >> 1) * 16 + swz / 64; C = (st & 1) * 32 + (swz % 64) / 2; }
__host__ __device__ __forceinline__ int perm32(int rho) { const int n = rho >> 4, i = rho & 15; return 8 * (i >> 2) + 4 * n + (i & 3); }

struct Unit { int pm, pn; };
struct Gemm { const bf16_t* A; const bf16_t* Bt; int M, N, K; };

struct StaticOrder {
    int nM, nN, nwg, G, c;
    __host__ __device__ void init(int M, int N, int G_, int c_) { nM = M / BM; nN = N / BM; nwg = nM * nN; G = G_; c = c_; }
    __host__ __device__ bool next(int i, Unit& u) const {
        const long L = (long)i * G + c; if (L >= nwg) return false;
        int wgid = (int)L; { const int q = nwg / NXCD, r = nwg % NXCD, xcd = wgid % NXCD, off = wgid / NXCD; wgid = (xcd < r ? xcd * (q + 1) : r * (q + 1) + (xcd - r) * q) + off; }
        const int nig = WGM * nN, gid = wgid / nig, fm = gid * WGM, gsz = (nM - fm) < WGM ? (nM - fm) : WGM;
        u.pm = fm + ((wgid % nig) % gsz); u.pn = (wgid % nig) / gsz; return true;
    }
    __device__ __forceinline__ void a_ready(const Unit&) const {}
    __device__ __forceinline__ void done(const Unit&) const {}
};

__device__ __forceinline__ unsigned cvt_pk_bf16(float lo, float hi) { unsigned r; asm volatile("v_cvt_pk_bf16_f32 %0, %1, %2" : "=v"(r) : "v"(lo), "v"(hi)); return r; }
template <class Epi, class Sched, bool ALIGN_EPI = false, bool SP2 = false>
__device__ __forceinline__ void gemm_phase(PG8_LAS unsigned char* lds, const Gemm g, const Sched& S, const Epi& E) {
    const int tid = threadIdx.x, wid = __builtin_amdgcn_readfirstlane(tid >> 6), lane = tid & 63, wr = wid >> 2, wc = wid & 3, fr = lane & 15, fq = lane >> 4;
    const int K = g.K, nt = K / BK;
    unsigned voffA[2], voffB[2];
#pragma unroll
    for (int i = 0; i < 2; ++i) { int R, C; stage_rc(tid * 16 + i * 8192, R, C); const int Rb = Epi::PERM ? ((R & ~31) + perm32(R & 31)) : R;
        voffA[i] = (unsigned)(R * K + C) * 2u; voffB[i] = (unsigned)(Rb * K + C) * 2u; }
    const size_t kstep = (size_t)(BK * 2);
    const size_t hstep = (size_t)HALF * K * 2;
    const size_t tstep = 2 * hstep;
    const unsigned ldsw = (unsigned)wid * 1024u;
    const int aoff = lds_byte(wr * 64 + fr, fq * 8), boff = lds_byte(wc * 32 + fr, fq * 8);
#define PG8_SA(b, h) (((b) * 2 + (h)) * HTB)
#define PG8_SB(b, h) ((4 + (b) * 2 + (h)) * HTB)
#define PG8_STAGE(bufoff, gbase, voff) do { _Pragma("unroll") for (int _i = 0; _i < 2; ++_i) \
        __builtin_amdgcn_global_load_lds((const unsigned*)((const char*)(gbase) + (voff)[_i]), (PG8_LAS unsigned*)(lds + (bufoff) + ldsw + _i * 8192), 16, 0, 0); } while (0)
#define PG8_LDA(dst, b, h) do { _Pragma("unroll") for (int m = 0; m < 4; ++m) _Pragma("unroll") for (int k = 0; k < 2; ++k) dst[m][k] = *(const PG8_LAS bf16x8*)(lds + PG8_SA(b, h) + aoff + m * 2048 + k * 1024); } while (0)
#define PG8_LDB(dst, b, h) do { _Pragma("unroll") for (int n = 0; n < 2; ++n) _Pragma("unroll") for (int k = 0; k < 2; ++k) dst[n][k] = *(const PG8_LAS bf16x8*)(lds + PG8_SB(b, h) + boff + n * 2048 + k * 1024); } while (0)
#define PG8_MMA(ai, bj, At, Bt) do { __builtin_amdgcn_s_setprio(1); _Pragma("unroll") for (int m = 0; m < 4; ++m) _Pragma("unroll") for (int n = 0; n < 2; ++n) _Pragma("unroll") for (int k = 0; k < 2; ++k) \
        acc[ai][bj][m][n] = __builtin_amdgcn_mfma_f32_16x16x32_bf16(Bt[n][k], At[m][k], acc[ai][bj][m][n], 0, 0, 0); __builtin_amdgcn_s_setprio(0); } while (0)
#define PG8_WAIT_V(n) asm volatile("s_waitcnt vmcnt(" #n ")" ::: "memory")
#define PG8_WAIT_L(n) asm volatile("s_waitcnt lgkmcnt(" #n ")" ::: "memory")
#define PG8_BAR __builtin_amdgcn_s_barrier()
#define PG8_SCHED __builtin_amdgcn_sched_barrier(0)
    Unit cur, nxt; int ui = 0;
    if (!S.next(0, cur)) return;
    f32x4 acc[2][2][4][2];
#pragma unroll
    for (int a = 0; a < 2; ++a)
#pragma unroll
        for (int b = 0; b < 2; ++b)
#pragma unroll
            for (int m = 0; m < 4; ++m)
#pragma unroll
                for (int n = 0; n < 2; ++n) acc[a][b][m][n] = (f32x4){0.f, 0.f, 0.f, 0.f};
    bf16x8 At[4][2], B0[2][2], B1[2][2];
    const char* cA = (const char*)g.A + (size_t)cur.pm * tstep; const char* cB = (const char*)g.Bt + (size_t)cur.pn * tstep;
    S.a_ready(cur);
    if constexpr (SP2) {
        PG8_STAGE(PG8_SB(0, 0), cB, voffB); PG8_STAGE(PG8_SB(0, 1), cB + hstep, voffB); PG8_STAGE(PG8_SA(0, 0), cA, voffA); PG8_STAGE(PG8_SA(0, 1), cA + hstep, voffA);
        if (wr == 1) PG8_BAR;
        PG8_WAIT_V(2); PG8_BAR;
        PG8_STAGE(PG8_SB(1, 0), cB + kstep, voffB); PG8_STAGE(PG8_SA(1, 0), cA + kstep, voffA); PG8_STAGE(PG8_SB(1, 1), cB + hstep + kstep, voffB);
        PG8_WAIT_V(6); PG8_BAR;
    } else {
        PG8_STAGE(PG8_SB(0, 0), cB, voffB); PG8_STAGE(PG8_SA(0, 0), cA, voffA); PG8_STAGE(PG8_SB(0, 1), cB + hstep, voffB); PG8_STAGE(PG8_SA(0, 1), cA + hstep, voffA);
        if (wr == 1) PG8_BAR;
        PG8_WAIT_V(4); PG8_BAR;
        PG8_STAGE(PG8_SB(1, 0), cB + kstep, voffB); PG8_STAGE(PG8_SA(1, 0), cA + kstep, voffA); PG8_STAGE(PG8_SB(1, 1), cB + hstep + kstep, voffB);
        PG8_WAIT_V(6); PG8_BAR;
    }
    for (;;) {
        const bool has_next = S.next(ui + 1, nxt);
        const char* nA = has_next ? (const char*)g.A + (size_t)nxt.pm * tstep : cA; const char* nB = has_next ? (const char*)g.Bt + (size_t)nxt.pn * tstep : cB;
        for (int t = 0; t < nt; t += 2) {
            const bool last = (t == nt - 2);
            const char* a1 = cA + (size_t)(t + 1) * kstep;
            const char* a2 = last ? nA : cA + (size_t)(t + 2) * kstep; const char* b2 = last ? nB : cB + (size_t)(t + 2) * kstep;
            const char* a3 = a2 + kstep; const char* b3 = b2 + kstep;
            if (last && has_next) S.a_ready(nxt);
            if constexpr (SP2) {
            PG8_LDB(B0, 0, 0); PG8_LDB(B1, 0, 1); PG8_SCHED; PG8_LDA(At, 0, 0); PG8_STAGE(PG8_SA(1, 1), a1 + hstep, voffA);
            PG8_WAIT_V(8); PG8_WAIT_L(0); PG8_BAR; PG8_MMA(0, 0, At, B0); PG8_MMA(0, 1, At, B1); PG8_BAR; PG8_SCHED;
            PG8_LDA(At, 0, 1); PG8_STAGE(PG8_SB(0, 0), b2, voffB); PG8_STAGE(PG8_SB(0, 1), b2 + hstep, voffB); PG8_STAGE(PG8_SA(0, 0), a2, voffA);
            PG8_WAIT_V(8); PG8_WAIT_L(0); PG8_BAR; PG8_MMA(1, 0, At, B0); PG8_MMA(1, 1, At, B1); PG8_BAR; PG8_SCHED;
            PG8_LDB(B0, 1, 0); PG8_LDB(B1, 1, 1); PG8_SCHED; PG8_LDA(At, 1, 0); PG8_STAGE(PG8_SA(0, 1), a2 + hstep, voffA);
            PG8_WAIT_V(8); PG8_WAIT_L(0); PG8_BAR; PG8_MMA(0, 0, At, B0); PG8_MMA(0, 1, At, B1); PG8_BAR; PG8_SCHED;
            PG8_LDA(At, 1, 1); PG8_STAGE(PG8_SB(1, 0), b3, voffB); PG8_STAGE(PG8_SB(1, 1), b3 + hstep, voffB); PG8_STAGE(PG8_SA(1, 0), a3, voffA);
            PG8_WAIT_V(8); PG8_WAIT_L(0); PG8_BAR; PG8_MMA(1, 0, At, B0); PG8_MMA(1, 1, At, B1); PG8_BAR; PG8_SCHED;
            } else {
            PG8_LDB(B0, 0, 0); PG8_SCHED; PG8_LDA(At, 0, 0); PG8_STAGE(PG8_SA(1, 1), a1 + hstep, voffA);
            PG8_WAIT_L(8); PG8_BAR; PG8_WAIT_L(0); PG8_MMA(0, 0, At, B0); PG8_BAR; PG8_SCHED;
            PG8_LDB(B1, 0, 1); PG8_STAGE(PG8_SB(0, 0), b2, voffB);
            PG8_BAR; PG8_WAIT_L(0); PG8_MMA(0, 1, At, B1); PG8_BAR;
            PG8_LDA(At, 0, 1); PG8_STAGE(PG8_SA(0, 0), a2, voffA);
            PG8_BAR; PG8_WAIT_L(0); PG8_MMA(1, 0, At, B0); PG8_BAR; PG8_SCHED;
            PG8_STAGE(PG8_SB(0, 1), b2 + hstep, voffB);
            PG8_WAIT_V(6); PG8_BAR; PG8_MMA(1, 1, At, B1); PG8_BAR;
            PG8_LDB(B0, 1, 0); PG8_SCHED; PG8_LDA(At, 1, 0); PG8_STAGE(PG8_SA(0, 1), a2 + hstep, voffA);
            PG8_WAIT_L(8); PG8_BAR; PG8_WAIT_L(0); PG8_MMA(0, 0, At, B0); PG8_BAR; PG8_SCHED;
            PG8_LDB(B1, 1, 1); PG8_STAGE(PG8_SB(1, 0), b3, voffB);
            PG8_BAR; PG8_WAIT_L(0); PG8_MMA(0, 1, At, B1); PG8_BAR;
            PG8_LDA(At, 1, 1); PG8_STAGE(PG8_SA(1, 0), a3, voffA);
            PG8_BAR; PG8_WAIT_L(0); PG8_MMA(1, 0, At, B0); PG8_BAR; PG8_SCHED;
            PG8_STAGE(PG8_SB(1, 1), b3 + hstep, voffB);
            PG8_WAIT_V(6); PG8_BAR; PG8_MMA(1, 1, At, B1); PG8_BAR;
            }
        }
        if constexpr (ALIGN_EPI) { if (wr == 0) PG8_BAR; }
        if constexpr (!Epi::AFTER_DRAIN) { E(acc, cur, wr, wc, fr, fq); S.done(cur); }
        if (!has_next) break;
#pragma unroll
        for (int a = 0; a < 2; ++a)
#pragma unroll
            for (int b = 0; b < 2; ++b)
#pragma unroll
                for (int m = 0; m < 4; ++m)
#pragma unroll
                    for (int n = 0; n < 2; ++n) acc[a][b][m][n] = (f32x4){0.f, 0.f, 0.f, 0.f};
        cur = nxt; cA = nA; cB = nB; ++ui;
        if constexpr (ALIGN_EPI) { if (wr == 1) PG8_BAR; }
    }
    PG8_WAIT_V(0);
    if constexpr (!ALIGN_EPI) { if (wr == 0) PG8_BAR; }
    PG8_BAR;
    if constexpr (Epi::AFTER_DRAIN) { E.fused(acc, cur, wr, wc, fr, fq, lds, wid, lane); S.done(cur); }
#undef PG8_SA
#undef PG8_SB
#undef PG8_STAGE
#undef PG8_LDA
#undef PG8_LDB
#undef PG8_MMA
#undef PG8_WAIT_V
#undef PG8_WAIT_L
#undef PG8_BAR
#undef PG8_SCHED
}
}
namespace pg8 {
struct EpiProj {
    static constexpr bool PERM = true, AFTER_DRAIN = false;
    bf16_t* P;
    __device__ __forceinline__ void operator()(const f32x4 (&acc)[2][2][4][2], const Unit& u, int wr, int wc, int fr, int fq) const {
        const int row0 = u.pm * BM + wr * 64 + fr, col0 = wc * 32 + 8 * fq, pl = u.pn;
        bf16_t* base = P + (size_t)pl * ((size_t)MT * 256);
        const int mode = (pl < 2 || pl == 8 || pl == 9) ? 1 : ((pl == 6 || pl == 7 || pl == 14 || pl == 15) ? 2 : 0);
#pragma unroll
        for (int ai = 0; ai < 2; ++ai)
#pragma unroll
            for (int m = 0; m < 4; ++m) { bf16_t* rowp = base + (size_t)(row0 + ai * HALF + m * 16) * 256 + col0;
#pragma unroll
                for (int bj = 0; bj < 2; ++bj) { f32x4 v0 = acc[ai][bj][m][0], v1 = acc[ai][bj][m][1];
                    if (mode == 1) { v0 = v0 * C2; v1 = v1 * C2; }
                    if (mode == 2) {
#pragma unroll
                        for (int j = 0; j < 4; ++j) { v0[j] = silu_f(v0[j]); v1[j] = silu_f(v1[j]); } }
                    u32x4 w; w.x = cvt_pk_bf16(v0[0], v0[1]); w.y = cvt_pk_bf16(v0[2], v0[3]); w.z = cvt_pk_bf16(v1[0], v1[1]); w.w = cvt_pk_bf16(v1[2], v1[3]);
                    *(u32x4*)(rowp + bj * HALF) = w; } }
    }
};
struct EpiOut {
    static constexpr bool PERM = true, AFTER_DRAIN = false;
    const float* X; bf16_t* Z;
    __device__ __forceinline__ void operator()(const f32x4 (&acc)[2][2][4][2], const Unit& u, int wr, int wc, int fr, int fq) const {
        const int row0 = u.pm * BM + wr * 64 + fr, col0 = u.pn * BM + wc * 32 + 8 * fq;
#pragma unroll
        for (int ai = 0; ai < 2; ++ai)
#pragma unroll
            for (int m = 0; m < 4; ++m) { const size_t off = (size_t)(row0 + ai * HALF + m * 16) * DM + col0;
#pragma unroll
                for (int bj = 0; bj < 2; ++bj) { const f32x4 x0 = *(const f32x4*)(X + off + bj * HALF), x1 = *(const f32x4*)(X + off + bj * HALF + 4);
                    const f32x4 v0 = x0 + acc[ai][bj][m][0], v1 = x1 + acc[ai][bj][m][1];
                    u32x4 w; w.x = cvt_pk_bf16(v0[0], v0[1]); w.y = cvt_pk_bf16(v0[2], v0[3]); w.z = cvt_pk_bf16(v1[0], v1[1]); w.w = cvt_pk_bf16(v1[2], v1[3]);
                    *(u32x4*)(Z + off + bj * HALF) = w; } }
    }
};
}
#include <cstdlib>
#include <vector>

#define XB_TMO      128
#define XB_XCNT(j)  (256  + 64 * (j))
#define XB_XSUB(j)  (1280 + 64 * (j))
#define XB_XGEN(j)  (2304 + 64 * (j))
#define XB_TOP      3328
#define XB_TOPGEN   3392
#define XCD_BAR_WORDS 3456
#define XB_SPIN_CAP (1u << 18)
#define LAS __attribute__((address_space(3)))

__device__ __forceinline__ unsigned xb_ld(unsigned* p)              { return __hip_atomic_load(p, __ATOMIC_RELAXED, __HIP_MEMORY_SCOPE_AGENT); }
__device__ __forceinline__ unsigned xb_add(unsigned* p, unsigned v) { return __hip_atomic_fetch_add(p, v, __ATOMIC_RELAXED, __HIP_MEMORY_SCOPE_AGENT); }
__device__ __forceinline__ unsigned xb_xcc_id() { return (unsigned)__builtin_amdgcn_s_getreg((3 << 11) | 20) & 0xFu; }
#define XB_SPIN(cond, bar) do { unsigned _sp = 0; while (cond) { __builtin_amdgcn_s_sleep(1); \
    if ((++_sp & 255u) == 0u) { if (xb_ld(&(bar)[XB_TMO])) break; if (_sp > XB_SPIN_CAP) { atomicAdd(&(bar)[XB_TMO], 1u); break; } } } } while (0)

struct XcdBarrier {
    unsigned* bar; unsigned x;
    volatile LAS unsigned* st;
};

__device__ __forceinline__ XcdBarrier xcd_barrier_post(unsigned* bar, volatile LAS unsigned* st) {
    XcdBarrier b; b.bar = bar; b.x = xb_xcc_id(); b.st = st;
    if (threadIdx.x == 0) (void)xb_add(&bar[XB_XCNT(b.x)], 1u);
    return b;
}
__device__ __forceinline__ void xcd_barrier_complete(unsigned* bar, unsigned x, unsigned& nloc, unsigned& nx) {
    const unsigned G = gridDim.x * gridDim.y * gridDim.z;
    unsigned sum, cnt, mine, sp = 0u;
    for (;;) {
        sum = 0u; cnt = 0u; mine = 0u;
#pragma unroll
        for (unsigned j = 0; j < 16; ++j) { const unsigned c = xb_ld(&bar[XB_XCNT(j)]); sum += c; cnt += (c > 0u) ? 1u : 0u; mine = (j == x) ? c : mine; }
        if (sum == G) break;
        __builtin_amdgcn_s_sleep(1);
        if ((++sp & 255u) == 0u) { if (xb_ld(&bar[XB_TMO])) break; if (sp > XB_SPIN_CAP) { atomicAdd(&bar[XB_TMO], 1u); break; } }
    }
    nloc = mine > 0u ? mine : 1u; nx = cnt > 0u ? cnt : 1u;
}

__device__ __forceinline__ void xcd_barrier(const XcdBarrier& b) {
    asm volatile("s_waitcnt vmcnt(0)" ::: "memory");
    __syncthreads();
    if (threadIdx.x == 0) {
        unsigned* bar = b.bar;
        __builtin_amdgcn_s_waitcnt(0);
        unsigned nloc = b.st[0], nx = b.st[1];
        if (nloc == 0u) { xcd_barrier_complete(bar, b.x, nloc, nx); b.st[0] = nloc; b.st[1] = nx; }
        const unsigned old = xb_add(&bar[XB_XSUB(b.x)], 1u);
        const unsigned gen = old / nloc;
        if (old + 1u == (gen + 1u) * nloc) {
            __builtin_amdgcn_fence(__ATOMIC_RELEASE, "agent");
            asm volatile("s_waitcnt vmcnt(0)" ::: "memory");
            const unsigned og = xb_add(&bar[XB_TOP], 1u);
            const unsigned tg = og / nx;
            if (og + 1u == (tg + 1u) * nx) xb_add(&bar[XB_TOPGEN], 1u);
            else XB_SPIN(xb_ld(&bar[XB_TOPGEN]) == tg, bar);
            __builtin_amdgcn_fence(__ATOMIC_ACQUIRE, "agent");
            xb_add(&bar[XB_XGEN(b.x)], 1u);
            asm volatile("s_waitcnt vmcnt(0)" ::: "memory");
        } else {
            XB_SPIN(xb_ld(&bar[XB_XGEN(b.x)]) == gen, bar);
            __builtin_amdgcn_fence(__ATOMIC_ACQUIRE, "agent");
            asm volatile("s_waitcnt vmcnt(0)" ::: "memory");
        }
    }
    __syncthreads();
}
__device__ __forceinline__ void prologue_body(int gw, int ngw, int lane, const float* __restrict__ x, const float* __restrict__ norm_w, const float* __restrict__ w_in,
                                              const float* __restrict__ w_out, bf16_t* H, float* IW, bf16_t* WinT, bf16_t* WoutT) {
    for (int m = gw; m < MT; m += ngw) {
        const f32x4_t* xr = (const f32x4_t*)(x + (size_t)m * DM) + lane;
        f32x4_t v[4]; float s = 0.f;
#pragma unroll
        for (int j = 0; j < 4; ++j) { v[j] = xr[64 * j]; s += (v[j].x * v[j].x + v[j].y * v[j].y) + (v[j].z * v[j].z + v[j].w * v[j].w); }
        const float rstd = 1.0f / sqrtf(wave_sum(s) * (1.0f / DM) + EPS);
        float a0 = 0.f, a1 = 0.f, a2 = 0.f, a3 = 0.f;
        u32x2_t* o8 = (u32x2_t*)(H + (size_t)m * DM) + lane;
#pragma unroll
        for (int j = 0; j < 4; ++j) {
            const f32x4_t w = ((const f32x4_t*)norm_w)[64 * j + lane];
            f32x4_t hv; hv.x = v[j].x * rstd * w.x; hv.y = v[j].y * rstd * w.y; hv.z = v[j].z * rstd * w.z; hv.w = v[j].w * rstd * w.w;
            const int d = 256 * j + 4 * lane;
            const f32x4_t w0 = *(const f32x4_t*)(w_in + (size_t)(d + 0) * D_IN + 4416), w1 = *(const f32x4_t*)(w_in + (size_t)(d + 1) * D_IN + 4416);
            const f32x4_t w2 = *(const f32x4_t*)(w_in + (size_t)(d + 2) * D_IN + 4416), w3 = *(const f32x4_t*)(w_in + (size_t)(d + 3) * D_IN + 4416);
            a0 += hv.x * w0.x + hv.y * w1.x + hv.z * w2.x + hv.w * w3.x;
            a1 += hv.x * w0.y + hv.y * w1.y + hv.z * w2.y + hv.w * w3.y;
            a2 += hv.x * w0.z + hv.y * w1.z + hv.z * w2.z + hv.w * w3.z;
            a3 += hv.x * w0.w + hv.y * w1.w + hv.z * w2.w + hv.w * w3.w;
            u32x2_t o; o.x = pk2(hv.x, hv.y); o.y = pk2(hv.z, hv.w); o8[64 * j] = o;
        }
        a0 = wave_sum(a0); a1 = wave_sum(a1); a2 = wave_sum(a2); a3 = wave_sum(a3);
        if (lane == 0) { f32x4_t o = {a0, a1, a2, a3}; *(f32x4_t*)(IW + (size_t)m * 4) = o; }
    }
    const long tid = (long)gw * 64 + lane, nth = (long)ngw * 64;
    for (long i = tid; i < (long)NPAD * (DM / 8); i += nth) {
        const int n = (int)(i % NPAD), k8 = (int)(i / NPAD);
        float e[8];
#pragma unroll
        for (int q = 0; q < 8; ++q) e[q] = (n < D_IN) ? w_in[(size_t)(k8 * 8 + q) * D_IN + n] : 0.f;
        u32x4_t o; o.x = pk2(e[0], e[1]); o.y = pk2(e[2], e[3]); o.z = pk2(e[4], e[5]); o.w = pk2(e[6], e[7]);
        *(u32x4_t*)(WinT + (size_t)n * DM + k8 * 8) = o;
    }
    for (long i = tid; i < (long)DM * (DM / 8); i += nth) {
        const int n = (int)(i % DM), k8 = (int)(i / DM);
        float e[8];
#pragma unroll
        for (int q = 0; q < 8; ++q) e[q] = w_out[(size_t)(k8 * 8 + q) * DM + n];
        u32x4_t o; o.x = pk2(e[0], e[1]); o.y = pk2(e[2], e[3]); o.z = pk2(e[4], e[5]); o.w = pk2(e[6], e[7]);
        *(u32x4_t*)(WoutT + (size_t)n * DM + k8 * 8) = o;
    }
}
__device__ __forceinline__ void final_norm_body(int gw, int ngw, int lane, const bf16_t* Z, float* out, const float* __restrict__ fw) {
    for (int m = gw; m < MT; m += ngw) {
        const u32x2_t* zr = (const u32x2_t*)(Z + (size_t)m * DM) + lane;
        f32x4_t v[4]; float s = 0.f;
#pragma unroll
        for (int j = 0; j < 4; ++j) { const u32x2_t z = zr[64 * j]; v[j].x = bflo(z.x); v[j].y = bfhi(z.x); v[j].z = bflo(z.y); v[j].w = bfhi(z.y);
            s += (v[j].x * v[j].x + v[j].y * v[j].y) + (v[j].z * v[j].z + v[j].w * v[j].w); }
        const float rstd = 1.0f / sqrtf(wave_sum(s) * (1.0f / DM) + EPS);
        f32x4_t* xr = (f32x4_t*)(out + (size_t)m * DM) + lane;
#pragma unroll
        for (int j = 0; j < 4; ++j) { const f32x4_t w = ((const f32x4_t*)fw)[64 * j + lane]; f32x4_t o;
            o.x = v[j].x * rstd * w.x; o.y = v[j].y * rstd * w.y; o.z = v[j].z * rstd * w.z; o.w = v[j].w * rstd * w.w; xr[64 * j] = o; }
    }
}
#define WAVE_SYNC() asm volatile("s_waitcnt vmcnt(0) lgkmcnt(0)" ::: "memory")
__device__ __forceinline__ void sel_naive_one(int m, int lane, unsigned* skey, float* sq, unsigned char* ws) {
    const bf16_t* P = (const bf16_t*)(ws + WS_P); const float* IW = (const float*)(ws + WS_IW);
    float* THR = (float*)(ws + WS_THR); int* KCUT = (int*)(ws + WS_KCUT); int* SELCNT = (int*)(ws + WS_SELCNT); int* SEL = (int*)(ws + WS_SEL);
    const int b = m / SEQ, tpos = m % SEQ, N = ((tpos >> 6) + 1) << 6;
    int* sel = SEL + (size_t)m * 256;
    unsigned* MASKW = (unsigned*)(ws + WS_MASK) + ((size_t)(b * 64 + (tpos >> 6)) * 32 * 64 + (tpos & 63)) * 4;
    if (N <= 256) {
        for (int j = lane; j < N; j += 64) sel[j] = j;
        if (lane < N / 64) { u32x2_t o = {0xffffffffu, 0xffffffffu}; *(u32x2_t*)(MASKW + (size_t)(lane >> 1) * 256 + (lane & 1) * 2) = o; }
        if (lane == 0) { THR[m] = -INFINITY; KCUT[m] = 0x7fffffff; SELCNT[m] = N; }
        return;
    }
    { const u32x2_t q = *(const u32x2_t*)(P + PL_IQ * PLANE + (size_t)m * 256 + lane * 4);
      sq[lane * 4 + 0] = bflo(q.x); sq[lane * 4 + 1] = bfhi(q.x); sq[lane * 4 + 2] = bflo(q.y); sq[lane * 4 + 3] = bfhi(q.y); }
    const f32x4_t iw = *(const f32x4_t*)(IW + (size_t)m * 4);
    const float wg0 = iw.x * IDX_SCALE, wg1 = iw.y * IDX_SCALE, wg2 = iw.z * IDX_SCALE, wg3 = iw.w * IDX_SCALE;
    WAVE_SYNC();
    for (int i = 0; i < N / 64; ++i) {
        asm volatile("" ::: "memory");
        const int s = i * 64 + lane; const bf16_t* kr = P + PL_IK * PLANE + (size_t)(b * SEQ + s) * 256;
        float l0 = 0.f, l1 = 0.f, l2 = 0.f, l3 = 0.f;
#pragma unroll
        for (int c = 0; c < 8; ++c) { const u32x4_t kv = *(const u32x4_t*)(kr + c * 8);
            const float k[8] = {bflo(kv.x), bfhi(kv.x), bflo(kv.y), bfhi(kv.y), bflo(kv.z), bfhi(kv.z), bflo(kv.w), bfhi(kv.w)};
#pragma unroll
            for (int e = 0; e < 8; ++e) { const int d = c * 8 + e; l0 += sq[d] * k[e]; l1 += sq[64 + d] * k[e]; l2 += sq[128 + d] * k[e]; l3 += sq[192 + d] * k[e]; } }
        float sc = wg0 * fmaxf(l0, 0.f) + wg1 * fmaxf(l1, 0.f) + wg2 * fmaxf(l2, 0.f) + wg3 * fmaxf(l3, 0.f);
        sc += 0.0f;
        skey[s] = f2key(sc);
    }
    WAVE_SYNC();
    unsigned prefix = 0u;
    for (int bit = 31; bit >= 0; --bit) { const unsigned cand = prefix | (1u << bit); int c = 0;
        for (int i = 0; i < N / 64; ++i) c += (skey[i * 64 + lane] >= cand) ? 1 : 0;
        c = wave_sum_i(c); if (c >= 256) prefix = cand; }
    int cgt = 0; for (int i = 0; i < N / 64; ++i) cgt += (skey[i * 64 + lane] > prefix) ? 1 : 0;
    cgt = wave_sum_i(cgt);
    const int r = 256 - cgt;
    int run = 0, kcut = 0x7fffffff;
    for (int i = 0; i < N / 64; ++i) { const unsigned long long bm = __ballot(skey[i * 64 + lane] == prefix); const int c = __popcll(bm);
        if (run + c >= r) { unsigned long long t = bm; for (int q = 0; q < r - run - 1; ++q) t &= t - 1; kcut = i * 64 + (int)__builtin_ctzll(t); break; }
        run += c; }
    int base = 0;
    for (int i = 0; i < N / 64; ++i) { const unsigned k = skey[i * 64 + lane]; const int idx = i * 64 + lane; const bool f = (k > prefix) || (k == prefix && idx <= kcut);
        const unsigned long long bm = __ballot(f); const int pos = base + __popcll(bm & ((1ull << lane) - 1ull)); if (f && pos < 256) sel[pos] = idx; base += __popcll(bm);
        if (lane == 0) { u32x2_t o = {(unsigned)bm, (unsigned)(bm >> 32)}; *(u32x2_t*)(MASKW + (size_t)(i >> 1) * 256 + (i & 1) * 2) = o; } }
    if (lane == 0) { THR[m] = key2f(prefix); KCUT[m] = kcut; SELCNT[m] = 256; }
    WAVE_SYNC();
}
__device__ __forceinline__ void dsa_naive_one(int m, int lane, float* sq, float* sc, int* ssel, unsigned char* ws, const float* __restrict__ rel_bias) {
    const bf16_t* P = (const bf16_t*)(ws + WS_P); const int* SELCNT = (const int*)(ws + WS_SELCNT); const int* SEL = (const int*)(ws + WS_SEL);
    bf16_t* AOBO = (bf16_t*)(ws + WS_AOBO);
    const int b = m / SEQ, tpos = m % SEQ; const int cnt = SELCNT[m];
    { const int hc = lane * 8; const u32x4_t q = *(const u32x4_t*)(P + (PL_BQ + (hc >> 8)) * PLANE + (size_t)m * 256 + (hc & 255));
      sq[hc + 0] = bflo(q.x); sq[hc + 1] = bfhi(q.x); sq[hc + 2] = bflo(q.y); sq[hc + 3] = bfhi(q.y); sq[hc + 4] = bflo(q.z); sq[hc + 5] = bfhi(q.z); sq[hc + 6] = bflo(q.w); sq[hc + 7] = bfhi(q.w); }
    for (int j = lane; j < 256; j += 64) ssel[j] = (j < cnt) ? SEL[(size_t)m * 256 + j] : 0;
    WAVE_SYNC();
    for (int jj = 0; jj < 4; ++jj) { const int j = jj * 64 + lane;
        if (j < cnt) { const int s = ssel[j]; const size_t ms = (size_t)(b * SEQ + s); const int bk = t5_bucket(s - tpos);
            for (int h = 0; h < 8; ++h) { const bf16_t* kr = P + (PL_BK + (h >> 2)) * PLANE + ms * 256 + (h & 3) * 64; float a = 0.f;
#pragma unroll
                for (int c = 0; c < 8; ++c) { const u32x4_t kv = *(const u32x4_t*)(kr + c * 8); const float* q = &sq[h * 64 + c * 8];
                    a += q[0] * bflo(kv.x) + q[1] * bfhi(kv.x) + q[2] * bflo(kv.y) + q[3] * bfhi(kv.y) + q[4] * bflo(kv.z) + q[5] * bfhi(kv.z) + q[6] * bflo(kv.w) + q[7] * bfhi(kv.w); }
                sc[h * 256 + j] = a + rel_bias[bk * 12 + 4 + h] * LOG2E; }
        } else { for (int h = 0; h < 8; ++h) sc[h * 256 + j] = -INFINITY; }
    }
    WAVE_SYNC();
    for (int h = 0; h < 8; ++h) { float v0 = sc[h * 256 + lane], v1 = sc[h * 256 + 64 + lane], v2 = sc[h * 256 + 128 + lane], v3 = sc[h * 256 + 192 + lane];
        const float mx = wave_max(fmaxf(fmaxf(v0, v1), fmaxf(v2, v3)));
        v0 = __builtin_amdgcn_exp2f(v0 - mx); v1 = __builtin_amdgcn_exp2f(v1 - mx); v2 = __builtin_amdgcn_exp2f(v2 - mx); v3 = __builtin_amdgcn_exp2f(v3 - mx);
        const float inv = 1.0f / wave_sum((v0 + v1) + (v2 + v3));
        sc[h * 256 + lane] = v0 * inv; sc[h * 256 + 64 + lane] = v1 * inv; sc[h * 256 + 128 + lane] = v2 * inv; sc[h * 256 + 192 + lane] = v3 * inv; }
    WAVE_SYNC();
    { const int hc = lane * 8, h = lane >> 3; float acc[8];
#pragma unroll
      for (int e = 0; e < 8; ++e) acc[e] = 0.f;
      for (int j = 0; j < cnt; ++j) { const float p = sc[h * 256 + j]; const int s = ssel[j];
          const u32x4_t vv = *(const u32x4_t*)(P + (PL_BV + (hc >> 8)) * PLANE + (size_t)(b * SEQ + s) * 256 + (hc & 255));
          acc[0] += p * bflo(vv.x); acc[1] += p * bfhi(vv.x); acc[2] += p * bflo(vv.y); acc[3] += p * bfhi(vv.y); acc[4] += p * bflo(vv.z); acc[5] += p * bfhi(vv.z); acc[6] += p * bflo(vv.w); acc[7] += p * bfhi(vv.w); }
      const u32x4_t g = *(const u32x4_t*)(P + (PL_BG + (hc >> 8)) * PLANE + (size_t)m * 256 + (hc & 255));
      u32x4_t o; o.x = pk2(acc[0] * bflo(g.x), acc[1] * bfhi(g.x)); o.y = pk2(acc[2] * bflo(g.y), acc[3] * bfhi(g.y)); o.z = pk2(acc[4] * bflo(g.z), acc[5] * bfhi(g.z)); o.w = pk2(acc[6] * bflo(g.w), acc[7] * bfhi(g.w));
      *(u32x4_t*)(AOBO + (size_t)m * DM + 512 + hc) = o; }
    WAVE_SYNC();
}
__device__ __forceinline__ float diff_lambda(int lane, const float* lq1, const float* lk1, const float* lq2, const float* lk2) {
    return expf(wave_sum(lq1[lane] * lk1[lane])) - expf(wave_sum(lq2[lane] * lk2[lane])) + LAMBDA_INIT; }
__device__ __forceinline__ void diff_naive_one(int m, int h, int lane, float* s1, float* s2, float* sq, float lam, unsigned char* ws, const float* __restrict__ rel_bias, const float* __restrict__ subln_w) {
    const bf16_t* P = (const bf16_t*)(ws + WS_P); bf16_t* AOBO = (bf16_t*)(ws + WS_AOBO);
    const int b = m / SEQ, tpos = m % SEQ, N = ((tpos >> 6) + 1) << 6;
    const int pq = h >> 1, co = (h & 1) * 128;
    { const unsigned q = *(const unsigned*)(P + (PL_AQ + pq) * PLANE + (size_t)m * 256 + co + lane * 2); sq[lane * 2] = bflo(q); sq[lane * 2 + 1] = bfhi(q); }
    WAVE_SYNC();
    float mx1 = -INFINITY, mx2 = -INFINITY;
    for (int i = 0; i < N / 64; ++i) { asm volatile("" ::: "memory"); const int s = i * 64 + lane; const bf16_t* kr = P + (PL_AK + pq) * PLANE + (size_t)(b * SEQ + s) * 256 + co;
        float d1 = 0.f, d2 = 0.f;
#pragma unroll
        for (int c = 0; c < 8; ++c) { const u32x4_t kv = *(const u32x4_t*)(kr + c * 8); const float* q = &sq[c * 8];
            d1 += q[0] * bflo(kv.x) + q[1] * bfhi(kv.x) + q[2] * bflo(kv.y) + q[3] * bfhi(kv.y) + q[4] * bflo(kv.z) + q[5] * bfhi(kv.z) + q[6] * bflo(kv.w) + q[7] * bfhi(kv.w); }
#pragma unroll
        for (int c = 0; c < 8; ++c) { const u32x4_t kv = *(const u32x4_t*)(kr + 64 + c * 8); const float* q = &sq[64 + c * 8];
            d2 += q[0] * bflo(kv.x) + q[1] * bfhi(kv.x) + q[2] * bflo(kv.y) + q[3] * bfhi(kv.y) + q[4] * bflo(kv.z) + q[5] * bfhi(kv.z) + q[6] * bflo(kv.w) + q[7] * bfhi(kv.w); }
        const float bias = rel_bias[t5_bucket(s - tpos) * 12 + h] * LOG2E;
        d1 += bias; d2 += bias; s1[s] = d1; s2[s] = d2; mx1 = fmaxf(mx1, d1); mx2 = fmaxf(mx2, d2); }
    mx1 = wave_max(mx1); mx2 = wave_max(mx2);
    float l1 = 0.f, l2 = 0.f;
    for (int i = 0; i < N / 64; ++i) { const int s = i * 64 + lane; const float p1 = __builtin_amdgcn_exp2f(s1[s] - mx1), p2 = __builtin_amdgcn_exp2f(s2[s] - mx2); s1[s] = p1; s2[s] = p2; l1 += p1; l2 += p2; }
    l1 = wave_sum(l1); l2 = wave_sum(l2);
    const float i1 = 1.0f / l1, i2 = lam / l2;
    for (int i = 0; i < N / 64; ++i) { const int s = i * 64 + lane; s1[s] = s1[s] * i1 - s2[s] * i2; }
    WAVE_SYNC();
    float a0 = 0.f, a1 = 0.f;
    const bf16_t* vb = P + (PL_AV + pq) * PLANE + (size_t)(b * SEQ) * 256 + co + lane * 2;
    for (int s = 0; s < N; ++s) { const float wv = s1[s]; const unsigned vv = *(const unsigned*)(vb + (size_t)s * 256); a0 += wv * bflo(vv); a1 += wv * bfhi(vv); }
    const float rstd = 1.0f / sqrtf(wave_sum(a0 * a0 + a1 * a1) * (1.0f / 128.0f) + EPS);
    const unsigned g = *(const unsigned*)(P + (PL_AG + pq) * PLANE + (size_t)m * 256 + co + lane * 2);
    const float o0 = a0 * rstd * subln_w[lane * 2] * ONE_M_LAMBDA * bflo(g), o1 = a1 * rstd * subln_w[lane * 2 + 1] * ONE_M_LAMBDA * bfhi(g);
    *(unsigned*)(AOBO + (size_t)m * DM + h * 128 + lane * 2) = pk2(o0, o1);
    WAVE_SYNC();
}
namespace dfa {
typedef short bf16x8 __attribute__((ext_vector_type(8)));
typedef short s16x4 __attribute__((ext_vector_type(4)));
typedef float f32x16 __attribute__((ext_vector_type(16)));
typedef LAS const char* lds_cptr;
constexpr int KBUF = 16384, VBUF = 16384;
constexpr int OFF_K = 0, OFF_V = 3 * KBUF, OFF_LUT = OFF_V + 4 * VBUF, OFF_Q = OFF_LUT + 1024, OFF_X = 0, LDS_NEED = OFF_Q + 32768;
constexpr float THR = 8.0f;
__device__ __forceinline__ int crow(int r, int hi) { return (r & 3) + 8 * (r >> 2) + 4 * hi; }
__device__ __forceinline__ s16x4 vtr(lds_cptr p) { return __builtin_bit_cast(s16x4, __builtin_amdgcn_ds_read_tr16_b64_v4i16((LAS s16x4*)p)); }
__device__ __forceinline__ float swap_other_half(float v) { auto rr = __builtin_amdgcn_permlane32_swap(__float_as_uint(v), __float_as_uint(v), false, false); return __uint_as_float((threadIdx.x & 32) ? rr[0] : rr[1]); }

__device__ __forceinline__ float max3_asm(float a, float b, float c) { float r; asm("v_max3_f32 %0, %1, %2, %3" : "=v"(r) : "v"(a), "v"(b), "v"(c)); return r; }
__device__ __forceinline__ void unit(unsigned char* lds, int b, int h, int cc, const bf16_t* P, bf16_t* AOBO, const float* __restrict__ rel_bias, const float* __restrict__ subln_w, float lam) {
    const int tid = threadIdx.x, lane = tid & 63, r32 = lane & 31, hi = lane >> 5;
    const int w = __builtin_amdgcn_readfirstlane(tid >> 6), j = w & 1, qs = w >> 1;
    const int cw = 2 * cc + (qs >> 1);
    const int NT = 2 * cc + 2, NTw = cw + 1;
    const size_t rowb = (size_t)b * SEQ;
    const bf16_t* Kg = P + (size_t)(PL_AK + (h >> 1)) * PLANE + rowb * 256 + (h & 1) * 128;
    const bf16_t* Vg = P + (size_t)(PL_AV + (h >> 1)) * PLANE + rowb * 256 + (h & 1) * 128;
    const bf16_t* Qg = P + (size_t)(PL_AQ + (h >> 1)) * PLANE + rowb * 256 + (h & 1) * 128;
    const bf16_t* Gg = P + (size_t)(PL_AG + (h >> 1)) * PLANE + rowb * 256 + (h & 1) * 128;
    LAS unsigned char* L = (LAS unsigned char*)lds;
    LAS float* lut = (LAS float*)(L + OFF_LUT);
    if (tid < 256) { const int rel = tid - 192; const float far = rel_bias[15 * 12 + h]; lut[tid] = (rel_bias[t5_bucket(rel) * 12 + h] - far) * LOG2E; }
#define DFA_DMA_K(t, kbuf) do { \
        _Pragma("unroll") for (int i_ = 0; i_ < 2; ++i_) { const int p_ = 2 * w + i_, sub_ = p_ >> 3, row_ = 8 * (p_ & 7) + (lane >> 3); \
            __builtin_amdgcn_global_load_lds((const unsigned*)(Kg + (size_t)((t) * 64 + row_) * 256 + sub_ * 64 + (((lane & 7) ^ ((row_ >> 1) & 7)) * 8)), (LAS unsigned*)(L + OFF_K + (kbuf) * KBUF + p_ * 1024), 16, 0, 0); } \
    } while (0)
#define DFA_DMA_V(t, vbuf) do { \
        _Pragma("unroll") for (int i_ = 0; i_ < 2; ++i_) { const int ii_ = 2 * w + i_, dq_ = ii_ >> 2, g_ = ii_ & 3; \
            __builtin_amdgcn_global_load_lds((const unsigned*)(Vg + (size_t)((t) * 64 + 16 * g_ + (lane >> 2)) * 256 + dq_ * 32 + (lane & 3) * 8), (LAS unsigned*)(L + OFF_V + (vbuf) * VBUF + dq_ * 4096 + g_ * 1024), 16, 0, 0); } \
    } while (0)
    DFA_DMA_K(0, 0); DFA_DMA_V(0, 0); DFA_DMA_K(1, 1); DFA_DMA_V(1, 1);
    { const bf16_t* qp = Qg + (size_t)(128 * cc + 32 * qs + r32) * 256 + 64 * j + 8 * hi;
#pragma unroll
      for (int d0 = 0; d0 < 4; ++d0) *(LAS u32x4_t*)(L + OFF_Q + w * 4096 + d0 * 1024 + lane * 16) = *(const u32x4_t*)(qp + 16 * d0); }
    const lds_cptr qb = (lds_cptr)(L + OFF_Q + w * 4096 + lane * 16);
    f32x16 o[4];
#pragma unroll
    for (int dq = 0; dq < 4; ++dq)
#pragma unroll
        for (int r = 0; r < 16; ++r) o[dq][r] = 0.f;
    f32x16 negm;
#pragma unroll
    for (int r = 0; r < 16; ++r) negm[r] = 0.f;
    float mrun = 0.f, lsum = 0.f;
    bf16x8 pf[4];
#pragma unroll
    for (int ks = 0; ks < 4; ++ks) pf[ks] = (bf16x8){0, 0, 0, 0, 0, 0, 0, 0};
    f32x16 s0 = negm, s1 = negm;
    int koff[4];
#pragma unroll
    for (int d0 = 0; d0 < 4; ++d0) koff[d0] = j * 8192 + r32 * 128 + ((((hi << 4) ^ (((r32 >> 1) & 7) << 4))) ^ (d0 << 5));
    const int voff = ((lane >> 4) & 1) * 32 + (lane & 3) * 8 + (4 * hi + ((lane & 15) >> 2)) * 64;
#define DFA_QK(t, kbuf) do { \
        asm volatile("" ::: "memory"); \
        const lds_cptr kb = (lds_cptr)(L + OFF_K + (kbuf) * KBUF); \
        s0 = negm; s1 = negm; \
        _Pragma("unroll") for (int d0 = 0; d0 < 4; ++d0) { \
            const bf16x8 a0 = *(const LAS bf16x8*)(kb + koff[d0]), a1 = *(const LAS bf16x8*)(kb + koff[d0] + 4096), qfd = *(const LAS bf16x8*)(qb + d0 * 1024); \
            s0 = __builtin_amdgcn_mfma_f32_32x32x16_bf16(a0, qfd, s0, 0, 0, 0); \
            s1 = __builtin_amdgcn_mfma_f32_32x32x16_bf16(a1, qfd, s1, 0, 0, 0); } \
        if ((t) >= cw - 2) { \
            const int base = 192 + 64 * ((t) - cw) - 32 * (qs & 1) - r32 + 4 * hi; \
            _Pragma("unroll") for (int r = 0; r < 16; ++r) { const int kk = (r & 3) + 8 * (r >> 2); s0[r] += lut[base + kk]; s1[r] += lut[base + 32 + kk]; } } \
    } while (0)
#define DFA_SM(t) do { \
        asm volatile("s_nop 11" : "+v"(s0), "+v"(s1));        \
        float tm = max3_asm(s0[0], s1[0], s0[1]), tn = max3_asm(s1[1], s0[2], s1[2]); \
        _Pragma("unroll") for (int r = 3; r < 15; r += 3) { tm = max3_asm(tm, s0[r], s1[r]); tn = max3_asm(tn, s0[r + 1], s1[r + 1]); tm = max3_asm(tm, s0[r + 2], s1[r + 2]); } \
        tm = max3_asm(tm, tn, s0[15]); tm = max3_asm(tm, s1[15], swap_other_half(max3_asm(tm, s1[15], s1[15]))); \
        const bool first = ((t) == 0); \
        if (first || __any(tm > THR)) { \
            const float dl = first ? tm : fmaxf(tm, 0.f); \
            mrun += dl; \
            _Pragma("unroll") for (int r = 0; r < 16; ++r) { s0[r] -= dl; s1[r] -= dl; negm[r] = -mrun; } \
            const float al = __builtin_amdgcn_exp2f(-dl); \
            lsum *= al; \
            if (!first) { _Pragma("unroll") for (int dq = 0; dq < 4; ++dq) _Pragma("unroll") for (int r = 0; r < 16; ++r) o[dq][r] *= al; } } \
        float ps = 0.f; \
        _Pragma("unroll") for (int r = 0; r < 16; ++r) { s0[r] = __builtin_amdgcn_exp2f(s0[r]); s1[r] = __builtin_amdgcn_exp2f(s1[r]); ps += s0[r] + s1[r]; } \
        lsum += ps; \
        _Pragma("unroll") for (int ks = 0; ks < 2; ++ks) { u32x4_t a, c; \
            a.x = pk2(s0[8 * ks + 0], s0[8 * ks + 1]); a.y = pk2(s0[8 * ks + 2], s0[8 * ks + 3]); a.z = pk2(s0[8 * ks + 4], s0[8 * ks + 5]); a.w = pk2(s0[8 * ks + 6], s0[8 * ks + 7]); \
            c.x = pk2(s1[8 * ks + 0], s1[8 * ks + 1]); c.y = pk2(s1[8 * ks + 2], s1[8 * ks + 3]); c.z = pk2(s1[8 * ks + 4], s1[8 * ks + 5]); c.w = pk2(s1[8 * ks + 6], s1[8 * ks + 7]); \
            pf[ks] = __builtin_bit_cast(bf16x8, a); pf[2 + ks] = __builtin_bit_cast(bf16x8, c); } \
    } while (0)
#define DFA_PV(vbuf) do { \
        const lds_cptr vp = (lds_cptr)(L + OFF_V + (vbuf) * VBUF + voff); \
        _Pragma("unroll") for (int dq = 0; dq < 4; ++dq) _Pragma("unroll") for (int ks = 0; ks < 4; ++ks) { \
            const s16x4 lo = vtr(vp + dq * 4096 + ks * 1024), hh = vtr(vp + dq * 4096 + ks * 1024 + 512); \
            const bf16x8 vf = {lo[0], lo[1], lo[2], lo[3], hh[0], hh[1], hh[2], hh[3]}; \
            o[dq] = __builtin_amdgcn_mfma_f32_32x32x16_bf16(vf, pf[ks], o[dq], 0, 0, 0); } \
    } while (0)
    asm volatile("s_waitcnt vmcnt(0)" ::: "memory");
    __syncthreads();
#define DFA_STEP_END(t) do { if ((t) + 2 < NT) asm volatile("s_waitcnt vmcnt(2) lgkmcnt(0)" ::: "memory"); else asm volatile("s_waitcnt vmcnt(0) lgkmcnt(0)" ::: "memory"); \
        __builtin_amdgcn_s_barrier(); asm volatile("" ::: "memory"); } while (0)
    int k0 = 0, k1 = 1, k2 = 2;
    if (w < 4) {
        DFA_QK(0, 0);
        for (int t = 0; t < NT; ++t) {
            if (t + 2 < NT) { DFA_DMA_K(t + 2, k2); DFA_DMA_V(t + 2, (t + 2) & 3); }
            if (t < NTw) { DFA_SM(t); DFA_PV(t & 3); if (t + 1 < NTw) DFA_QK(t + 1, k1); }
            DFA_STEP_END(t);
            { const int kt_ = k0; k0 = k1; k1 = k2; k2 = kt_; }
        }
    } else {
        for (int t = 0; t < NT; ++t) {
            if (t + 2 < NT) { DFA_DMA_K(t + 2, k2); DFA_DMA_V(t + 2, (t + 2) & 3); }
            if (t >= 1 && t - 1 < NTw) DFA_PV((t - 1) & 3);
            if (t < NTw) { DFA_QK(t, k0); DFA_SM(t); }
            DFA_STEP_END(t);
            { const int kt_ = k0; k0 = k1; k1 = k2; k2 = kt_; }
        }
        if (NT - 1 < NTw) DFA_PV((NT - 1) & 3);
    }
#undef DFA_STEP_END
    __syncthreads();
#undef DFA_DMA_K
#undef DFA_DMA_V
#undef DFA_QK
#undef DFA_SM
#undef DFA_PV
    const float ltot = lsum + swap_other_half(lsum);
    LAS float* X = (LAS float*)(L + OFF_X) + qs * 4096;
    if (j == 1) {
        const float sc = lam / ltot;
#pragma unroll
        for (int dq = 0; dq < 4; ++dq)
#pragma unroll
            for (int r = 0; r < 16; ++r) X[(dq * 16 + r) * 64 + lane] = o[dq][r] * sc;
    }
    __syncthreads();
    if (j == 0) {
        const float inv = 1.0f / ltot; float ss = 0.f;
#pragma unroll
        for (int dq = 0; dq < 4; ++dq)
#pragma unroll
            for (int r = 0; r < 16; ++r) { const float v = o[dq][r] * inv - X[(dq * 16 + r) * 64 + lane]; o[dq][r] = v; ss += v * v; }
        ss += swap_other_half(ss);
        const float rstd = ONE_M_LAMBDA / sqrtf(ss * (1.0f / 128.0f) + EPS);
        const size_t m = rowb + (size_t)(128 * cc + 32 * qs + r32);
        const bf16_t* gp = Gg + (m - rowb) * 256;
        bf16_t* op = AOBO + m * DM + h * 128;
#pragma unroll
        for (int dq = 0; dq < 4; ++dq)
#pragma unroll
            for (int g = 0; g < 4; ++g) { const int dv = 32 * dq + 8 * g + 4 * hi;
                const u32x2_t gv = *(const u32x2_t*)(gp + dv); const f32x4_t sw = *(const f32x4_t*)(subln_w + dv);
                u32x2_t ov; ov.x = pk2(o[dq][4 * g + 0] * rstd * sw.x * bflo(gv.x), o[dq][4 * g + 1] * rstd * sw.y * bfhi(gv.x));
                ov.y = pk2(o[dq][4 * g + 2] * rstd * sw.z * bflo(gv.y), o[dq][4 * g + 3] * rstd * sw.w * bfhi(gv.y));
                *(u32x2_t*)(op + dv) = ov; }
    }
    __syncthreads();
}
__device__ __forceinline__ void phase(unsigned char* lds, int blk, int G, const bf16_t* P, bf16_t* AOBO, const float* rel_bias, const float* subln_w, float lam) {
    if (G == 256) {
        const int x = blk & 7, i = blk >> 3;
        for (int k = 0; k < 4; ++k) { const int id = 4 * x + k; unit(lds, id >> 2, id & 3, (k & 1) ? 31 - i : i, P, AOBO, rel_bias, subln_w, lam); }
    } else {
        for (int u = blk; u < 32 * 32; u += G) unit(lds, (u >> 5) >> 2, (u >> 5) & 3, u & 31, P, AOBO, rel_bias, subln_w, lam);
    }
}
}
namespace dsa {
typedef short bf16x8 __attribute__((ext_vector_type(8)));
typedef short s16x4 __attribute__((ext_vector_type(4)));
typedef float f32x16 __attribute__((ext_vector_type(16)));
typedef LAS const char* lds_cptr;
constexpr int KBUF = 16384, VBUF = 16384;
constexpr int OFF_K = 0, OFF_V = 2 * KBUF, OFF_LUT = OFF_V + 2 * VBUF, LDS_NEED = OFF_LUT + 2048;
constexpr float THR = 8.0f;
__device__ __forceinline__ s16x4 vtr(lds_cptr p) { return __builtin_bit_cast(s16x4, __builtin_amdgcn_ds_read_tr16_b64_v4i16((LAS s16x4*)p)); }
__device__ __forceinline__ float swap_other_half(float v) { auto rr = __builtin_amdgcn_permlane32_swap(__float_as_uint(v), __float_as_uint(v), false, false); return __uint_as_float((threadIdx.x & 32) ? rr[0] : rr[1]); }

typedef __bf16 bf2_t __attribute__((ext_vector_type(2)));
__device__ __forceinline__ float max3_asm(float a, float b, float c) { float r; asm("v_max3_f32 %0, %1, %2, %3" : "=v"(r) : "v"(a), "v"(b), "v"(c)); return r; }
__device__ __forceinline__ unsigned pair_mask(unsigned w, int p) { const unsigned t0 = (unsigned)__builtin_amdgcn_sbfe((int)w, p, 1), t1 = (unsigned)__builtin_amdgcn_sbfe((int)w, p + 1, 1); return (t0 & 0xffffu) | (t1 & 0xffff0000u); }
__device__ __forceinline__ void unit(unsigned char* lds, int b, int hg, int cc, const bf16_t* P, const unsigned* MASK, bf16_t* AOBO, const float* __restrict__ rel_bias) {
    const int tid = threadIdx.x, lane = tid & 63, r32 = lane & 31, hi = lane >> 5;
    const int w = __builtin_amdgcn_readfirstlane(tid >> 6), hl = w & 1, qs = w >> 1;
    const int cw = 2 * cc + (qs >> 1);
    const int NT = 2 * cc + 2, NTw = cw + 1;
    const int h = 2 * hg + hl;
    const size_t rowb = (size_t)b * SEQ;
    const int pl = hg >> 1, co = (hg & 1) * 128;
    const bf16_t* Kg = P + (size_t)(PL_BK + pl) * PLANE + rowb * 256 + co;
    const bf16_t* Vg = P + (size_t)(PL_BV + pl) * PLANE + rowb * 256 + co;
    const bf16_t* Qg = P + (size_t)(PL_BQ + pl) * PLANE + rowb * 256 + co;
    const bf16_t* Gg = P + (size_t)(PL_BG + pl) * PLANE + rowb * 256 + co;
    LAS unsigned char* L = (LAS unsigned char*)lds;
    LAS float* lut = (LAS float*)(L + OFF_LUT) + hl * 256;
    { const int hh = tid >> 8, rel = (tid & 255) - 192, hd = 4 + 2 * hg + hh; const float far = rel_bias[15 * 12 + hd];
      ((LAS float*)(L + OFF_LUT))[tid] = (rel_bias[t5_bucket(rel) * 12 + hd] - far) * LOG2E; }
#define DSA_DMA(t, buf) do { \
        _Pragma("unroll") for (int i_ = 0; i_ < 2; ++i_) { const int p_ = 2 * w + i_, sub_ = p_ >> 3, row_ = 8 * (p_ & 7) + (lane >> 3); \
            __builtin_amdgcn_global_load_lds((const unsigned*)(Kg + (size_t)((t) * 64 + row_) * 256 + sub_ * 64 + (((lane & 7) ^ ((row_ >> 1) & 7)) * 8)), (LAS unsigned*)(L + OFF_K + (buf) * KBUF + p_ * 1024), 16, 0, 0); } \
        _Pragma("unroll") for (int i_ = 0; i_ < 2; ++i_) { const int ii_ = 2 * w + i_, dq_ = ii_ >> 2, g_ = ii_ & 3; \
            __builtin_amdgcn_global_load_lds((const unsigned*)(Vg + (size_t)((t) * 64 + 16 * g_ + (lane >> 2)) * 256 + dq_ * 32 + (lane & 3) * 8), (LAS unsigned*)(L + OFF_V + (buf) * VBUF + dq_ * 4096 + g_ * 1024), 16, 0, 0); } \
    } while (0)
    DSA_DMA(0, 0);
    bf16x8 qf[4];
    { const bf16_t* qp = Qg + (size_t)(128 * cc + 32 * qs + r32) * 256 + 64 * hl + 8 * hi;
#pragma unroll
      for (int d0 = 0; d0 < 4; ++d0) qf[d0] = *(const bf16x8*)(qp + 16 * d0); }
    f32x16 o[2];
#pragma unroll
    for (int dq = 0; dq < 2; ++dq)
#pragma unroll
        for (int r = 0; r < 16; ++r) o[dq][r] = 0.f;
    f32x16 negm;
#pragma unroll
    for (int r = 0; r < 16; ++r) negm[r] = 0.f;
    float mrun = 0.f, lsum = 0.f;
    int koff[4];
#pragma unroll
    for (int d0 = 0; d0 < 4; ++d0) koff[d0] = hl * 8192 + r32 * 128 + ((((hi << 4) ^ (((r32 >> 1) & 7) << 4))) ^ (d0 << 5));
    const int voff = ((lane >> 4) & 1) * 32 + (lane & 3) * 8 + (4 * hi + ((lane & 15) >> 2)) * 64 + 2 * hl * 4096;
    const u32x4_t* mrow = (const u32x4_t*)MASK + ((size_t)(b * 64 + cw) * 32) * 64 + (32 * (qs & 1) + r32);
    asm volatile("s_waitcnt vmcnt(0)" ::: "memory");
    __syncthreads();
    u32x4_t mw = mrow[0], mwn = mw;
    for (int t = 0; t < NT; ++t) {
        const int buf = t & 1;
        if (t + 1 < NT) DSA_DMA(t + 1, buf ^ 1);
        if ((t & 1) == 0 && t + 2 < NTw) mwn = mrow[(size_t)((t >> 1) + 1) * 64];
        if (t < NTw) {
            const unsigned w0 = ((t & 1) ? mw.z : mw.x) >> (4 * hi), w1 = ((t & 1) ? mw.w : mw.y) >> (4 * hi);
            const lds_cptr kb = (lds_cptr)(L + OFF_K + buf * KBUF);
            f32x16 s0 = negm, s1 = negm;
#pragma unroll
            for (int d0 = 0; d0 < 4; ++d0) {
                const bf16x8 a0 = *(const LAS bf16x8*)(kb + koff[d0]), a1 = *(const LAS bf16x8*)(kb + koff[d0] + 4096);
                s0 = __builtin_amdgcn_mfma_f32_32x32x16_bf16(a0, qf[d0], s0, 0, 0, 0);
                s1 = __builtin_amdgcn_mfma_f32_32x32x16_bf16(a1, qf[d0], s1, 0, 0, 0);
            }
            if (t >= cw - 2) {
                const int base = 192 + 64 * (t - cw) - 32 * (qs & 1) - r32 + 4 * hi;
#pragma unroll
                for (int r = 0; r < 16; ++r) { const int kk = (r & 3) + 8 * (r >> 2); s0[r] += lut[base + kk]; s1[r] += lut[base + 32 + kk]; }
            }
            asm volatile("s_nop 11" : "+v"(s0), "+v"(s1));
            float tm = max3_asm(s0[0], s1[0], s0[1]), tn = max3_asm(s1[1], s0[2], s1[2]);
#pragma unroll
            for (int r = 3; r < 15; r += 3) { tm = max3_asm(tm, s0[r], s1[r]); tn = max3_asm(tn, s0[r + 1], s1[r + 1]); tm = max3_asm(tm, s0[r + 2], s1[r + 2]); }
            tm = max3_asm(tm, tn, s0[15]); tm = max3_asm(tm, s1[15], swap_other_half(max3_asm(tm, s1[15], s1[15])));
            const bool first = (t == 0);
            if (first || __any(tm > THR)) {
                const float dl = first ? tm : fmaxf(tm, 0.f);
                mrun += dl;
#pragma unroll
                for (int r = 0; r < 16; ++r) { s0[r] -= dl; s1[r] -= dl; negm[r] = -mrun; }
                const float al = __builtin_amdgcn_exp2f(-dl);
                lsum *= al;
                if (!first) {
#pragma unroll
                    for (int dq = 0; dq < 2; ++dq)
#pragma unroll
                        for (int r = 0; r < 16; ++r) o[dq][r] *= al;
                }
            }
#pragma unroll
            for (int r = 0; r < 16; ++r) { s0[r] = __builtin_amdgcn_exp2f(s0[r]); s1[r] = __builtin_amdgcn_exp2f(s1[r]); }
            bf16x8 pf[4]; float ps = 0.f; const unsigned ones = 0x3f803f80u;
#pragma unroll
            for (int ks = 0; ks < 2; ++ks) {
                u32x4_t a, c;
#pragma unroll
                for (int e = 0; e < 4; ++e) { const int r = 8 * ks + 2 * e, pos = (r & 3) + 8 * (r >> 2);
                    const unsigned pa = pk2(s0[r], s0[r + 1]) & pair_mask(w0, pos), pc = pk2(s1[r], s1[r + 1]) & pair_mask(w1, pos);
                    a[e] = pa; c[e] = pc;
                    ps = __builtin_amdgcn_fdot2_f32_bf16(__builtin_bit_cast(bf2_t, pa), __builtin_bit_cast(bf2_t, ones), ps, false);
                    ps = __builtin_amdgcn_fdot2_f32_bf16(__builtin_bit_cast(bf2_t, pc), __builtin_bit_cast(bf2_t, ones), ps, false); }
                pf[ks] = __builtin_bit_cast(bf16x8, a); pf[2 + ks] = __builtin_bit_cast(bf16x8, c);
            }
            lsum += ps;
            const lds_cptr vp = (lds_cptr)(L + OFF_V + buf * VBUF + voff);
#pragma unroll
            for (int dq = 0; dq < 2; ++dq)
#pragma unroll
                for (int ks = 0; ks < 4; ++ks) {
                    const s16x4 lo = vtr(vp + dq * 4096 + ks * 1024), hh = vtr(vp + dq * 4096 + ks * 1024 + 512);
                    const bf16x8 vf = {lo[0], lo[1], lo[2], lo[3], hh[0], hh[1], hh[2], hh[3]};
                    o[dq] = __builtin_amdgcn_mfma_f32_32x32x16_bf16(vf, pf[ks], o[dq], 0, 0, 0);
                }
        }
        asm volatile("s_waitcnt vmcnt(0)" ::: "memory");
        __syncthreads();
        if (t & 1) mw = mwn;
    }
#undef DSA_DMA
    {
        const float inv = 1.0f / (lsum + swap_other_half(lsum));
        const size_t m = rowb + (size_t)(128 * cc + 32 * qs + r32);
        const bf16_t* gp = Gg + (m - rowb) * 256 + 64 * hl;
        bf16_t* op = AOBO + m * DM + 512 + h * 64;
#pragma unroll
        for (int dq = 0; dq < 2; ++dq)
#pragma unroll
            for (int g = 0; g < 4; ++g) { const int dv = 32 * dq + 8 * g + 4 * hi;
                const u32x2_t gv = *(const u32x2_t*)(gp + dv);
                u32x2_t ov; ov.x = pk2(o[dq][4 * g + 0] * inv * bflo(gv.x), o[dq][4 * g + 1] * inv * bfhi(gv.x));
                ov.y = pk2(o[dq][4 * g + 2] * inv * bflo(gv.y), o[dq][4 * g + 3] * inv * bfhi(gv.y));
                *(u32x2_t*)(op + dv) = ov; }
    }
    __syncthreads();
}
__device__ __forceinline__ void phase(unsigned char* lds, int blk, int G, const bf16_t* P, const unsigned* MASK, bf16_t* AOBO, const float* rel_bias) {
    if (G == 256) {
        const int x = blk & 7, i = blk >> 3;
        for (int k = 0; k < 4; ++k) { const int id = 4 * x + k; unit(lds, id >> 2, id & 3, (k & 1) ? 31 - i : i, P, MASK, AOBO, rel_bias); }
    } else {
        for (int u = blk; u < 32 * 32; u += G) unit(lds, (u >> 5) >> 2, (u >> 5) & 3, u & 31, P, MASK, AOBO, rel_bias);
    }
}
}
#ifndef DBG_T
#define DBG_T(i) do {} while (0)
#endif
#ifndef DBG_COUNT
#define DBG_COUNT(i) do {} while (0)
#endif
#ifndef REP_SEL_HIST
#define REP_SEL_HIST 1
#endif
#ifndef REP_SEL_FINAL
#define REP_SEL_FINAL 1
#endif
#ifndef REP_SEL_RESOLVE
#define REP_SEL_RESOLVE 1
#endif
namespace sel {
typedef short bf16x8 __attribute__((ext_vector_type(8)));
typedef float f32x16 __attribute__((ext_vector_type(16)));
constexpr int B1 = 512, KNEG = 256, CAP = 128;
constexpr int OFF_HIST = 0, OFF_TW = 0, OFF_CLS = 16384, OFF_CLI = 32768, OFF_PAR = 66048, OFF_IQ = 70656, OFF_SLOW = 0, LDS_NEED = OFF_IQ + 16384;
constexpr int P_KMAX = 0, P_S0 = 32, P_EST = 64, P_R = 96, P_CC = 128, P_MODE = 160, P_SEG = 192;

__device__ __forceinline__ float other_half(float v) { auto rr = __builtin_amdgcn_permlane32_swap(__float_as_uint(v), __float_as_uint(v), false, false); return __uint_as_float((threadIdx.x & 32) ? rr[0] : rr[1]); }
__device__ __forceinline__ unsigned other_half_u(unsigned v) { auto rr = __builtin_amdgcn_permlane32_swap(v, v, false, false); return (threadIdx.x & 32) ? rr[0] : rr[1]; }

struct Tile { bf16x8 a[4]; };
__device__ __forceinline__ void load_tile(Tile& t, const bf16_t* ikrow) {
#pragma unroll
    for (int d0 = 0; d0 < 4; ++d0) t.a[d0] = *(const bf16x8*)(ikrow + 16 * d0);
}
__device__ __forceinline__ float relu_f(float x) { float r; asm("v_max_f32_e32 %0, 0, %1" : "=v"(r) : "v"(x)); return r; }
__device__ __forceinline__ f32x16 head_logits(const Tile& t, LAS const char* iqb, int h) {
    f32x16 l;
#pragma unroll
    for (int r = 0; r < 16; ++r) l[r] = 0.f;
#pragma unroll
    for (int d0 = 0; d0 < 4; ++d0) { const bf16x8 bqf = *(const LAS bf16x8*)(iqb + (8 * h + 2 * d0) * 512); l = __builtin_amdgcn_mfma_f32_32x32x16_bf16(t.a[d0], bqf, l, 0, 0, 0); }
    return l;
}
#define SEL_PIN(x) asm volatile("" : "+v"(x))
__device__ __forceinline__ void score_tile(f32x16& sc, Tile& t, LAS const char* iqb, const float (&wg)[4], const bf16_t* nxt) {
    asm volatile("" ::: "memory");
    f32x16 la = head_logits(t, iqb, 0);
    f32x16 lb = head_logits(t, iqb, 1);
    SEL_PIN(la); SEL_PIN(lb);
    __builtin_amdgcn_sched_barrier(0);
#pragma unroll
    for (int r = 0; r < 16; ++r) sc[r] = wg[0] * relu_f(la[r]);
    SEL_PIN(sc);
    __builtin_amdgcn_sched_barrier(0);
    la = head_logits(t, iqb, 2);
    SEL_PIN(la);
    __builtin_amdgcn_sched_barrier(0);
#pragma unroll
    for (int r = 0; r < 16; ++r) sc[r] = fmaf(wg[1], relu_f(lb[r]), sc[r]);
    SEL_PIN(sc);
    __builtin_amdgcn_sched_barrier(0);
    lb = head_logits(t, iqb, 3);
    SEL_PIN(lb);
    if (nxt) load_tile(t, nxt);
    __builtin_amdgcn_sched_barrier(0);
#pragma unroll
    for (int r = 0; r < 16; ++r) sc[r] = fmaf(wg[2], relu_f(la[r]), sc[r]);
    SEL_PIN(sc);
    __builtin_amdgcn_sched_barrier(0);
#pragma unroll
    for (int r = 0; r < 16; ++r) sc[r] = fmaf(wg[3], relu_f(lb[r]), sc[r]) + 0.0f;
    SEL_PIN(sc);
    __builtin_amdgcn_sched_barrier(0);
}
__device__ __forceinline__ int bin_of(float s, float s0, int s0b) {
    int fl = (__float_as_int(fabsf(s) + s0) - s0b) >> 19; fl = fl > 255 ? 255 : fl;
    return KNEG + (fl ^ (__float_as_int(s) >> 31));
}
__device__ __forceinline__ void sel_slow_one(int b, int c, int q, int lane, unsigned* skey, float* sq, const bf16_t* P, const float* IW, unsigned* MW) {
    const int m = b * SEQ + 64 * c + q, N = 64 * (c + 1);
    { const u32x2_t qv = *(const u32x2_t*)(P + PL_IQ * PLANE + (size_t)m * 256 + lane * 4);
      sq[lane * 4 + 0] = bflo(qv.x); sq[lane * 4 + 1] = bfhi(qv.x); sq[lane * 4 + 2] = bflo(qv.y); sq[lane * 4 + 3] = bfhi(qv.y); }
    const f32x4_t iw = *(const f32x4_t*)(IW + (size_t)m * 4);
    const float wg0 = iw.x * IDX_SCALE, wg1 = iw.y * IDX_SCALE, wg2 = iw.z * IDX_SCALE, wg3 = iw.w * IDX_SCALE;
    WAVE_SYNC();
    for (int i = 0; i < N / 64; ++i) {
        asm volatile("" ::: "memory");
        const int s = i * 64 + lane; const bf16_t* kr = P + PL_IK * PLANE + (size_t)(b * SEQ + s) * 256;
        float l0 = 0.f, l1 = 0.f, l2 = 0.f, l3 = 0.f;
#pragma unroll
        for (int cc = 0; cc < 8; ++cc) { const u32x4_t kv = *(const u32x4_t*)(kr + cc * 8);
            const float k[8] = {bflo(kv.x), bfhi(kv.x), bflo(kv.y), bfhi(kv.y), bflo(kv.z), bfhi(kv.z), bflo(kv.w), bfhi(kv.w)};
#pragma unroll
            for (int e = 0; e < 8; ++e) { const int d = cc * 8 + e; l0 += sq[d] * k[e]; l1 += sq[64 + d] * k[e]; l2 += sq[128 + d] * k[e]; l3 += sq[192 + d] * k[e]; } }
        float sc = wg0 * fmaxf(l0, 0.f); sc = fmaf(wg1, fmaxf(l1, 0.f), sc); sc = fmaf(wg2, fmaxf(l2, 0.f), sc); sc = fmaf(wg3, fmaxf(l3, 0.f), sc);
        sc += 0.0f;
        skey[s] = f2key(sc);
    }
    WAVE_SYNC();
    unsigned prefix = 0u;
    for (int bit = 31; bit >= 0; --bit) { const unsigned cand = prefix | (1u << bit); int cn = 0;
        for (int i = 0; i < N / 64; ++i) cn += (skey[i * 64 + lane] >= cand) ? 1 : 0;
        cn = wave_sum_i(cn); if (cn >= 256) prefix = cand; }
    int cgt = 0; for (int i = 0; i < N / 64; ++i) cgt += (skey[i * 64 + lane] > prefix) ? 1 : 0;
    cgt = wave_sum_i(cgt);
    const int r = 256 - cgt;
    int run = 0, kcut = 0x7fffffff;
    for (int i = 0; i < N / 64; ++i) { const unsigned long long bm = __ballot(skey[i * 64 + lane] == prefix); const int cn = __popcll(bm);
        if (run + cn >= r) { unsigned long long t = bm; for (int z = 0; z < r - run - 1; ++z) t &= t - 1; kcut = i * 64 + (int)__builtin_ctzll(t); break; }
        run += cn; }
    for (int i = 0; i < N / 64; ++i) { const unsigned k = skey[i * 64 + lane]; const int idx = i * 64 + lane; const bool f = (k > prefix) || (k == prefix && idx <= kcut);
        const unsigned long long bm = __ballot(f);
        if (lane == 0) { u32x2_t o = {(unsigned)bm, (unsigned)(bm >> 32)}; *(u32x2_t*)(MW + ((size_t)(i >> 1) * 64 + q) * 4 + (i & 1) * 2) = o; } }
    WAVE_SYNC();
}

__device__ __forceinline__ void unit(unsigned char* lds, int b, int c, int hq, const bf16_t* P, const float* IW, unsigned* MASK) {
    const int tid = threadIdx.x, lane = tid & 63, r32 = lane & 31, hi = lane >> 5;
    const int w = __builtin_amdgcn_readfirstlane(tid >> 6);
    const int N = 64 * (c + 1), NT32 = N / 32;
    unsigned* MW = MASK + ((size_t)(b * 64 + c) * 32 * 64) * 4;
    if (c < 4) {
        for (int idx = tid; idx < 32 * NT32; idx += 512) { const int q = 32 * hq + (idx & 31), kt = idx >> 5; MW[((size_t)(kt >> 2) * 64 + q) * 4 + (kt & 3)] = 0xffffffffu; }
        return;
    }
    DBG_T(0);
    LAS unsigned* hist = (LAS unsigned*)((LAS unsigned char*)lds + OFF_HIST);
    LAS unsigned* TW = (LAS unsigned*)((LAS unsigned char*)lds + OFF_TW);
    LAS float* CLS = (LAS float*)((LAS unsigned char*)lds + OFF_CLS);
    LAS unsigned* CLI = (LAS unsigned*)((LAS unsigned char*)lds + OFF_CLI);
    LAS unsigned* PAR = (LAS unsigned*)((LAS unsigned char*)lds + OFF_PAR);
    const int q = r32, qc = 32 * hq + r32;
    const size_t m = (size_t)b * SEQ + 64 * c + qc;
    {
        const bf16_t* qrow = P + (size_t)PL_IQ * PLANE + ((size_t)b * SEQ + 64 * c + 32 * hq) * 256;
#pragma unroll
        for (int i = 0; i < 2; ++i) { const int p = tid + 512 * i, qq = p >> 5, ch = p & 31;
            *(LAS u32x4_t*)((LAS unsigned char*)lds + OFF_IQ + ch * 512 + qq * 16) = *(const u32x4_t*)(qrow + (size_t)qq * 256 + ch * 8); }
    }
    LAS const char* iqb = (LAS const char*)((LAS unsigned char*)lds + OFF_IQ + hi * 512 + q * 16);
    float wg[4];
    { const f32x4_t iw = *(const f32x4_t*)(IW + m * 4); wg[0] = iw.x * IDX_SCALE; wg[1] = iw.y * IDX_SCALE; wg[2] = iw.z * IDX_SCALE; wg[3] = iw.w * IDX_SCALE; }
    const bf16_t* ikl = P + (size_t)PL_IK * PLANE + ((size_t)b * SEQ + r32) * 256 + 8 * hi;
    for (int i = tid; i < 513 * 32; i += 512) hist[i] = 0u;
    if (tid < 32) { PAR[P_KMAX + tid] = 0u; PAR[P_CC + tid] = 0u; }
    __syncthreads();
    {   float mx = 0.f;
        for (int kt = w; kt < NT32; kt += 64) { Tile t; load_tile(t, ikl + (size_t)kt * 32 * 256); f32x16 sc; score_tile(sc, t, iqb, wg, nullptr);
#pragma unroll
            for (int r = 0; r < 16; ++r) mx = fmaxf(mx, fabsf(sc[r])); }
        mx = fmaxf(mx, other_half(mx));
        if (hi == 0) atomicMax((unsigned*)&PAR[P_KMAX + q], __float_as_uint(mx));
    }
    __syncthreads();
    if (tid < 32) { const float R = __uint_as_float(PAR[P_KMAX + tid]) * 1.125f + 1e-30f; PAR[P_S0 + tid] = __float_as_uint(R * (1.0f / 65536.0f)); }
    __syncthreads();
    const float s0 = __uint_as_float(PAR[P_S0 + q]); const int s0b = (int)PAR[P_S0 + q];
    DBG_T(1);
    for (int rep_ = 0; rep_ < REP_SEL_HIST; ++rep_)
    {   Tile t; const unsigned one_ = rep_ == 0 ? 1u : 0u;
        if (w < NT32) load_tile(t, ikl + (size_t)w * 32 * 256);
        for (int kt = w; kt < NT32; kt += 8) {
            f32x16 sc; score_tile(sc, t, iqb, wg, (kt + 8 < NT32) ? ikl + (size_t)(kt + 8) * 32 * 256 : nullptr);
#pragma unroll
            for (int r = 0; r < 16; ++r) { int bn = bin_of(sc[r], s0, s0b); bn = (sc[r] != 0.f) ? bn : B1; atomicAdd((unsigned*)&hist[bn * 32 + q], one_); }
        }
    }
    __syncthreads();
    DBG_T(2);
    {   const int sq_ = tid & 31, seg = tid >> 5; unsigned ssum = 0u;
#pragma unroll 8
        for (int i = 0; i < 32; ++i) ssum += hist[(seg * 32 + i) * 32 + sq_];
        PAR[P_SEG + sq_ * 16 + seg] = ssum;
    }
    __syncthreads();
    if (tid < 32) {
        const int cntZ = (int)hist[B1 * 32 + tid];
        int sg[16];
#pragma unroll
        for (int i = 0; i < 16; ++i) sg[i] = (int)PAR[P_SEG + tid * 16 + i];
        int cum = 0, hit = -1;
#pragma unroll
        for (int step = 0; step < 17; ++step) {
            const int cnt_ = (step == 8) ? cntZ : sg[step < 8 ? 15 - step : 16 - step]; const int id_ = (step == 8) ? 16 : (step < 8 ? 15 - step : 16 - step);
            const bool take = (hit < 0) && (cum + cnt_ >= 256); hit = take ? id_ : hit; cum = (hit < 0) ? cum + cnt_ : cum;
        }
        int est = 1, mode = 2, R = 1, cnt = 0;
        if (hit == 16) { est = 2 * KNEG; R = 256 - cum; mode = 1; cnt = cntZ; }
        else if (hit >= 0) {
            int hb[32];
#pragma unroll
            for (int i = 0; i < 32; ++i) hb[i] = (int)hist[(hit * 32 + i) * 32 + tid];
            bool found = false;
#pragma unroll
            for (int i = 31; i >= 0; --i) { const bool take = !found && (cum + hb[i] >= 256); if (take) { est = 2 * (hit * 32 + i) + 1; R = 256 - cum; cnt = hb[i]; mode = 0; found = true; } cum = found ? cum : cum + hb[i]; }
        }
        if (mode == 0 && cnt > CAP) mode = 2;
        PAR[P_EST + tid] = (unsigned)est; PAR[P_R + tid] = (unsigned)R; PAR[P_MODE + tid] = (unsigned)mode;
    }
    __syncthreads();
    const int est = (int)PAR[P_EST + q]; const bool normal = (PAR[P_MODE + q] == 0u);
    DBG_T(3);
    for (int rep_ = 0; rep_ < REP_SEL_FINAL; ++rep_)
    {   Tile t;
        if (rep_ > 0) { __syncthreads(); if (tid < 32) PAR[P_CC + tid] = 0u; __syncthreads(); }
        if (w < NT32) load_tile(t, ikl + (size_t)w * 32 * 256);
#define SEL_FINAL_TILE(T, KT) do { f32x16 sc; score_tile(sc, T, iqb, wg, ((KT) + 8 < NT32) ? ikl + (size_t)((KT) + 8) * 32 * 256 : nullptr); unsigned gp = 0u, ep = 0u; \
            _Pragma("unroll") for (int r = 0; r < 16; ++r) { const int bn = bin_of(sc[r], s0, s0b); const int e = 2 * bn + (sc[r] != 0.f ? 1 : 0); const int pos = (r & 3) + 8 * (r >> 2); \
                gp |= (e > est ? 1u : 0u) << pos; ep |= (e == est ? 1u : 0u) << pos; } \
            unsigned cb = normal ? ep : 0u; \
            while (__any(cb != 0u)) { \
                if (cb != 0u) { const int pos = __builtin_ctz(cb); cb &= cb - 1u; const int rr = (pos & 3) + 4 * (pos >> 3); float val = sc[0]; \
                    _Pragma("unroll") for (int r = 1; r < 16; ++r) val = (rr == r) ? sc[r] : val; \
                    const unsigned slot = atomicAdd((unsigned*)&PAR[P_CC + q], 1u); \
                    if (slot < (unsigned)CAP) { CLS[q * CAP + slot] = val; CLI[q * CAP + slot] = (unsigned)((KT) * 32 + pos + 4 * hi); } } } \
            gp <<= 4 * hi; ep <<= 4 * hi; gp |= other_half_u(gp); ep |= other_half_u(ep); \
            if (hi == 0) { MW[((size_t)((KT) >> 2) * 64 + qc) * 4 + ((KT) & 3)] = gp; TW[q * 128 + (KT)] = ep; } } while (0)
        for (int kt = w; kt < NT32; kt += 8) SEL_FINAL_TILE(t, kt);
#undef SEL_FINAL_TILE
    }
    asm volatile("s_waitcnt vmcnt(0) lgkmcnt(0)" ::: "memory");
    __syncthreads();
    DBG_T(4);
    for (int rep_ = 0; rep_ < REP_SEL_RESOLVE; ++rep_)
    for (int qq = w; qq < 32; qq += 8) {
        const unsigned mode = PAR[P_MODE + qq]; const int R = (int)PAR[P_R + qq]; const int qqc = 32 * hq + qq;
        if (mode == 0u) {
            const int n = (int)PAR[P_CC + qq];
            if (n > CAP) { if (lane == 0) PAR[P_MODE + qq] = 2u; }
            else {
                const unsigned long long k_lo = lane < n ? (((unsigned long long)f2key(CLS[qq * CAP + lane]) << 32) | (0xffffffffu - CLI[qq * CAP + lane])) : 0ull;
                const unsigned long long k_hi = (lane + 64) < n ? (((unsigned long long)f2key(CLS[qq * CAP + 64 + lane]) << 32) | (0xffffffffu - CLI[qq * CAP + 64 + lane])) : 0ull;
                int rk_lo = 0, rk_hi = 0;
                const int n1 = n < 64 ? n : 64;
                for (int i = 0; i < n1; ++i) { const unsigned long long ki = ((unsigned long long)(unsigned)__builtin_amdgcn_readlane((unsigned)(k_lo >> 32), i) << 32) | (unsigned long long)(unsigned)__builtin_amdgcn_readlane((unsigned)k_lo, i);
                    rk_lo += (ki > k_lo) ? 1 : 0; rk_hi += (ki > k_hi) ? 1 : 0; }
                for (int i = 64; i < n; ++i) { const unsigned long long ki = ((unsigned long long)(unsigned)__builtin_amdgcn_readlane((unsigned)(k_hi >> 32), i - 64) << 32) | (unsigned long long)(unsigned)__builtin_amdgcn_readlane((unsigned)k_hi, i - 64);
                    rk_lo += (ki > k_lo) ? 1 : 0; rk_hi += (ki > k_hi) ? 1 : 0; }
                const unsigned i_lo = 0xffffffffu - (unsigned)k_lo, i_hi = 0xffffffffu - (unsigned)k_hi;
                if (lane < n && rk_lo < R) atomicOr(&MW[((size_t)(i_lo >> 7) * 64 + qqc) * 4 + ((i_lo >> 5) & 3)], 1u << (i_lo & 31));
                if ((lane + 64) < n && rk_hi < R) atomicOr(&MW[((size_t)(i_hi >> 7) * 64 + qqc) * 4 + ((i_hi >> 5) & 3)], 1u << (i_hi & 31));
            }
        } else if (mode == 1u) {
            const unsigned w0 = lane < NT32 ? TW[qq * 128 + lane] : 0u, w1 = (lane + 64) < NT32 ? TW[qq * 128 + 64 + lane] : 0u;
            const int c0 = __popc(w0), c1 = __popc(w1);
            int p0 = c0, p1 = c1;
#pragma unroll
            for (int o = 1; o < 64; o <<= 1) { const int t0 = __shfl_up(p0, o), t1 = __shfl_up(p1, o); if (lane >= o) { p0 += t0; p1 += t1; } }
            const int tot0 = __shfl(p0, 63);
            const int before0 = p0 - c0, before1 = tot0 + p1 - c1;
#pragma unroll
            for (int half = 0; half < 2; ++half) {
                unsigned wv = half ? w1 : w0; const int cnt = half ? c1 : c0; const int before = half ? before1 : before0; const int kt = lane + 64 * half;
                int take = R - before; take = take < 0 ? 0 : (take > cnt ? cnt : take);
                if (take > 0) { unsigned res = 0u; for (int z = 0; z < take; ++z) { const unsigned low = wv & (0u - wv); res |= low; wv ^= low; }
                    atomicOr(&MW[((size_t)(kt >> 2) * 64 + qqc) * 4 + (kt & 3)], res); }
            }
        }
    }
    asm volatile("s_waitcnt vmcnt(0) lgkmcnt(0)" ::: "memory");
    __syncthreads();
    DBG_T(5);
    if (w < 3) {
        unsigned* skey = (unsigned*)(lds + OFF_SLOW + w * 17408); float* sq = (float*)(lds + OFF_SLOW + w * 17408 + 16384);
        int seen = 0;
        for (int qq = 0; qq < 32; ++qq) if (PAR[P_MODE + qq] == 2u) { if ((seen % 3) == w) { sel_slow_one(b, c, 32 * hq + qq, lane, skey, sq, P, IW, MW); DBG_COUNT(0); } ++seen; }
    }
    asm volatile("s_waitcnt vmcnt(0) lgkmcnt(0)" ::: "memory");
    __syncthreads();
    DBG_T(6);
}
__device__ __forceinline__ void phase(unsigned char* lds, int blk, int G, const bf16_t* P, const float* IW, unsigned* MASK) {
    DBG_T(7);
    if (G == 256) { const int b = blk & 7, i = blk >> 3;
        for (int k = 0; k < 4; ++k) unit(lds, b, (k & 2) ? 63 - i : i, k & 1, P, IW, MASK); }
    else { for (int u = blk; u < NBATCH * 128; u += G) unit(lds, u >> 7, (u >> 1) & 63, u & 1, P, IW, MASK); }
}
}
constexpr int LDS_MAIN = 150528;
constexpr int MISC_OFF = LDS_MAIN, LDS_BYTES = LDS_MAIN + 64;
constexpr size_t BAR_BYTES = (size_t)XCD_BAR_WORDS * 4;
#ifndef REP_PRO
#define REP_PRO 1
#endif
#ifndef REP_GEMM1
#define REP_GEMM1 1
#endif
#ifndef REP_SEL
#define REP_SEL 1
#endif
#ifndef REP_DSA
#define REP_DSA 1
#endif
#ifndef REP_DFA
#define REP_DFA 1
#endif
#ifndef REP_OUT
#define REP_OUT 1
#endif
struct Args { const float* in[11]; float* out; unsigned char* ws; };

__global__ void __launch_bounds__(512, 2) fwd(Args a) {
    extern __shared__ __attribute__((aligned(16))) unsigned char lds[];
    const int tid = threadIdx.x, lane = tid & 63, wave = __builtin_amdgcn_readfirstlane(tid >> 6);
    volatile LAS unsigned* misc = (volatile LAS unsigned*)((LAS unsigned char*)lds + MISC_OFF);
    if (tid < 16) misc[tid] = 0u;
    __syncthreads();
    XcdBarrier bar = xcd_barrier_post((unsigned*)a.ws, misc);
    const int G = gridDim.x, gw = blockIdx.x * 8 + wave, ngw = G * 8;
    unsigned char* ws = a.ws;
    const float* x = a.in[0]; const float* rel_bias = a.in[9];
    prologue_body(gw, ngw, lane, x, a.in[1], a.in[2], a.in[3], (bf16_t*)(ws + WS_H), (float*)(ws + WS_IW), (bf16_t*)(ws + WS_WINT), (bf16_t*)(ws + WS_WOUTT));
#if REP_PRO == 2
    __syncthreads();
    prologue_body(gw, ngw, lane, x, a.in[1], a.in[2], a.in[3], (bf16_t*)(ws + WS_H), (float*)(ws + WS_IW), (bf16_t*)(ws + WS_WINT), (bf16_t*)(ws + WS_WOUTT));
#endif
    xcd_barrier(bar);
    { pg8::Gemm g{(const bf16_t*)(ws + WS_H), (const bf16_t*)(ws + WS_WINT), MT, NPAD, DM}; pg8::StaticOrder S; S.init(MT, NPAD, G, (int)blockIdx.x);
      pg8::EpiProj E{(bf16_t*)(ws + WS_P)};
      pg8::gemm_phase<pg8::EpiProj, pg8::StaticOrder, true, true>((PG8_LAS unsigned char*)lds, g, S, E); }
#if REP_GEMM1 == 2
    __syncthreads();
    { pg8::Gemm g{(const bf16_t*)(ws + WS_H), (const bf16_t*)(ws + WS_WINT), MT, NPAD, DM}; pg8::StaticOrder S; S.init(MT, NPAD, G, (int)blockIdx.x);
      pg8::EpiProj E{(bf16_t*)(ws + WS_P)};
      pg8::gemm_phase<pg8::EpiProj, pg8::StaticOrder, true, true>((PG8_LAS unsigned char*)lds, g, S, E); }
#endif
    xcd_barrier(bar);
    for (int rep = 0; rep < REP_SEL; ++rep)
    sel::phase(lds, (int)blockIdx.x, G, (const bf16_t*)(ws + WS_P), (const float*)(ws + WS_IW), (unsigned*)(ws + WS_MASK));
    xcd_barrier(bar);
    for (int rep = 0; rep < REP_DSA; ++rep)
    dsa::phase(lds, (int)blockIdx.x, G, (const bf16_t*)(ws + WS_P), (const unsigned*)(ws + WS_MASK), (bf16_t*)(ws + WS_AOBO), rel_bias);
    __syncthreads();
    { const float lam = diff_lambda(lane, a.in[4], a.in[5], a.in[6], a.in[7]);
      for (int rep = 0; rep < REP_DFA; ++rep)
      dfa::phase(lds, (int)blockIdx.x, G, (const bf16_t*)(ws + WS_P), (bf16_t*)(ws + WS_AOBO), rel_bias, a.in[8], lam); }
    xcd_barrier(bar);
    { pg8::Gemm g{(const bf16_t*)(ws + WS_AOBO), (const bf16_t*)(ws + WS_WOUTT), MT, DM, DM}; pg8::StaticOrder S; S.init(MT, DM, G, (int)blockIdx.x);
      pg8::EpiOut E{x, (bf16_t*)(ws + WS_H)};
      pg8::gemm_phase<pg8::EpiOut, pg8::StaticOrder, true, true>((PG8_LAS unsigned char*)lds, g, S, E); }
#if REP_OUT == 2
    __syncthreads();
    { pg8::Gemm g{(const bf16_t*)(ws + WS_AOBO), (const bf16_t*)(ws + WS_WOUTT), MT, DM, DM}; pg8::StaticOrder S; S.init(MT, DM, G, (int)blockIdx.x);
      pg8::EpiOut E{x, (bf16_t*)(ws + WS_H)};
      pg8::gemm_phase<pg8::EpiOut, pg8::StaticOrder, true, true>((PG8_LAS unsigned char*)lds, g, S, E); }
#endif
    xcd_barrier(bar);
    final_norm_body(gw, ngw, lane, (const bf16_t*)(ws + WS_H), a.out, a.in[10]);
#ifdef DBG_ENCODE
    DBG_ENCODE
#endif
}

extern "C" void kernel_launch(void* const* d_in, const int* in_sizes, int n_in, void* d_out, int out_size, void* d_ws, size_t ws_size, hipStream_t stream) {
    static int grid = 0;
    if (grid == 0) {
        if (n_in != 11 || out_size != MT * DM || ws_size < WS_END) { fprintf(stderr, "kernel_launch: unexpected shapes (n_in %d out %d ws %zu need %zu)\n", n_in, out_size, ws_size, (size_t)WS_END); grid = -1; return; }
        int dev = 0, cus = 0, per_cu = 0;
        if (hipGetDevice(&dev) != hipSuccess || hipDeviceGetAttribute(&cus, hipDeviceAttributeMultiprocessorCount, dev) != hipSuccess) { grid = -1; return; }
        if (hipFuncSetAttribute((const void*)fwd, hipFuncAttributeMaxDynamicSharedMemorySize, LDS_BYTES) != hipSuccess) { fprintf(stderr, "kernel_launch: hipFuncSetAttribute failed\n"); grid = -1; return; }
        if (hipOccupancyMaxActiveBlocksPerMultiprocessor(&per_cu, (const void*)fwd, 512, LDS_BYTES) != hipSuccess || per_cu < 1) { fprintf(stderr, "kernel_launch: occupancy query says %d blocks per CU\n", per_cu); (void)hipGetLastError(); }
        grid = cus;
    }
    if (grid < 0) return;
    if (hipMemsetAsync(d_ws, 0, 16384, stream) != hipSuccess) { fprintf(stderr, "kernel_launch: memset failed\n"); return; }
    Args a; memset(&a, 0, sizeof(a));
    for (int i = 0; i < 11; ++i) a.in[i] = (const float*)d_in[i];
    a.out = (float*)d_out; a.ws = (unsigned char*)d_ws;
    hipLaunchKernelGGL(fwd, dim3(grid), dim3(512), LDS_BYTES, stream, a);
}
```
